# Optimizing an MI355X kernel written in HIP

```python
import math
import jax, jax.numpy as jnp
from jax import lax
import numpy as np

D_MODEL = 1024
BATCH = 4
SEQ = 4096
DEPTH = 2

GRID_W = 64
CTX_LEN = 256
N_MIXERS = 2
MIXER_GDN = 0
MIXER_POOL = 1
N_DIRS = 2

GDN_HEADS = 8
GDN_HEAD_DIM = 128
GDN_KEY_DIM = GDN_HEADS * GDN_HEAD_DIM
GDN_VALUE_DIM = GDN_HEADS * GDN_HEAD_DIM
GDN_QKV_DIM = 2 * GDN_KEY_DIM + GDN_VALUE_DIM
GDN_AB_DIM = N_DIRS * 2 * GDN_HEADS
GDN_PROJ_DIM = GDN_QKV_DIM + GDN_VALUE_DIM + GDN_AB_DIM
CONV_W = 5
CHUNK = 64

POOL_WINDOWS = (2, 4, 8, 16)
POOL_GROUPS = len(POOL_WINDOWS)
POOL_GROUP_DIM = D_MODEL // POOL_GROUPS

N_EXPERTS = 16
EC_CAPACITY_FACTOR = 2
D_EXPERT = 2048

N_MOD = 6
RMS_EPS = 1e-6

kernel_name = 'bidir_gdn_pool_ec_moe_dit'


def rmsnorm(x, g):
    xf = x.astype(jnp.float32)
    y = xf * lax.rsqrt(jnp.mean(xf * xf, axis=-1, keepdims=True) + RMS_EPS)
    return (y * g.astype(jnp.float32)).astype(x.dtype)


def l2norm(x):
    xf = x.astype(jnp.float32)
    return xf * lax.rsqrt(jnp.sum(xf * xf, axis=-1, keepdims=True) + RMS_EPS)


def modulate(xn, shift, scale):
    return xn * (1 + scale) + shift


def short_conv(x, w):
    pad = CONV_W // 2
    return lax.conv_general_dilated(x, w[:, None, :], window_strides=(1,), padding=[(pad, pad)],
                                    dimension_numbers=('NWC', 'WIO', 'NWC'),
                                    feature_group_count=x.shape[-1])


def chunk_gated_delta(q, k, v, g, beta, s0):
    f32 = jnp.float32
    B, H, T, DK = q.shape
    DV = v.shape[-1]
    n = T // CHUNK
    q = q.astype(f32).reshape(B, H, n, CHUNK, DK)
    k = k.astype(f32).reshape(B, H, n, CHUNK, DK)
    v = v.astype(f32).reshape(B, H, n, CHUNK, DV)
    g = g.astype(f32).reshape(B, H, n, CHUNK)
    beta = beta.astype(f32).reshape(B, H, n, CHUNK)
    gcum = jnp.cumsum(g, axis=-1)
    incl = jnp.tril(jnp.ones((CHUNK, CHUNK), dtype=bool))
    strict = jnp.tril(jnp.ones((CHUNK, CHUNK), dtype=bool), -1)
    diff = gcum[..., :, None] - gcum[..., None, :]
    decay = jnp.where(incl, jnp.exp(jnp.where(incl, diff, 0.0)), 0.0)
    k_beta = k * beta[..., None]
    v_beta = v * beta[..., None]
    a_low = jnp.where(strict, jnp.einsum('bhnid,bhnjd->bhnij', k_beta, k) * decay, 0.0)
    lmat = a_low + jnp.eye(CHUNK, dtype=f32)
    rhs = jnp.concatenate([v_beta, k_beta * jnp.exp(gcum)[..., None]], axis=-1)
    sol = lax.linalg.triangular_solve(lmat, rhs, left_side=True, lower=True, unit_diagonal=True)
    u_vals, w_keys = sol[..., :DV], sol[..., DV:]
    att = jnp.einsum('bhnid,bhnjd->bhnij', q, k) * decay
    q_dec = q * jnp.exp(gcum)[..., None]
    k_tail = k * jnp.exp(gcum[..., -1:] - gcum)[..., None]
    g_tail = jnp.exp(gcum[..., -1])
    xs = tuple(jnp.moveaxis(t, 2, 0) for t in (u_vals, w_keys, q_dec, att, k_tail, g_tail))

    def step(S, inp):
        u_n, w_n, qd_n, att_n, kt_n, gt_n = inp
        v_new = u_n - jnp.einsum('bhck,bhkv->bhcv', w_n, S)
        o_n = jnp.einsum('bhck,bhkv->bhcv', qd_n, S) + jnp.einsum('bhij,bhjv->bhiv', att_n, v_new)
        S = S * gt_n[..., None, None] + jnp.einsum('bhck,bhcv->bhkv', kt_n, v_new)
        return S, o_n

    s_fin, o = lax.scan(step, s0.astype(f32), xs)
    o = jnp.moveaxis(o, 0, 2).reshape(B, H, T, DV)
    return o, s_fin


def gdn_project(u, w_in, conv_w, a_log, dt_bias):
    B, T, _ = u.shape
    p = u @ w_in
    qkv = jax.nn.silu(short_conv(p[..., :GDN_QKV_DIM], conv_w))
    z = p[..., GDN_QKV_DIM:GDN_QKV_DIM + GDN_VALUE_DIM]
    ab = p[..., GDN_QKV_DIM + GDN_VALUE_DIM:].astype(jnp.float32).reshape(B, T, N_DIRS, 2, GDN_HEADS)
    q = qkv[..., :GDN_KEY_DIM]
    k = qkv[..., GDN_KEY_DIM:2 * GDN_KEY_DIM]
    v = qkv[..., 2 * GDN_KEY_DIM:]
    heads = lambda t: t.reshape(B, T, GDN_HEADS, GDN_HEAD_DIM).transpose(0, 2, 1, 3)
    q = l2norm(heads(q)) * (GDN_HEAD_DIM ** -0.5)
    k = l2norm(heads(k))
    v = heads(v)
    a = ab[:, :, :, 0, :].transpose(2, 0, 3, 1)
    b = ab[:, :, :, 1, :].transpose(2, 0, 3, 1)
    g = -jnp.exp(a_log.astype(jnp.float32))[:, None, :, None] * jax.nn.softplus(
        a + dt_bias.astype(jnp.float32)[:, None, :, None])
    beta = jax.nn.sigmoid(b)
    return q, k, v, z, g, beta


def gdn_out(o, z, o_gain, w_out):
    B, H, T, DV = o.shape
    o = o.transpose(0, 2, 1, 3)
    zf = z.reshape(B, T, H, DV).astype(jnp.float32)
    o = o * lax.rsqrt(jnp.mean(o * o, axis=-1, keepdims=True) + RMS_EPS) * o_gain.astype(jnp.float32) * jax.nn.silu(zf)
    return o.reshape(B, T, H * DV).astype(z.dtype) @ w_out


def gated_deltanet(u, uc, w_in, conv_w, a_log, dt_bias, o_gain, w_out, with_ctx_out):
    ql, kl, vl, zl, gl, bl = gdn_project(u, w_in, conv_w, a_log, dt_bias)
    qc, kc, vc, zc, gc, bc = gdn_project(uc, w_in, conv_w, a_log, dt_bias)
    B = u.shape[0]
    o_lat = 0.0
    o_ctx = 0.0
    for d in range(N_DIRS):
        flip = (lambda t: jnp.flip(t, axis=2)) if d == 1 else (lambda t: t)
        s0 = jnp.zeros((B, GDN_HEADS, GDN_HEAD_DIM, GDN_HEAD_DIM), jnp.float32)
        oc, s_ctx = chunk_gated_delta(flip(qc), flip(kc), flip(vc), flip(gc[d]), flip(bc[d]), s0)
        ol, _ = chunk_gated_delta(flip(ql), flip(kl), flip(vl), flip(gl[d]), flip(bl[d]), s_ctx)
        o_lat = o_lat + flip(ol)
        if with_ctx_out:
            o_ctx = o_ctx + flip(oc)
    y = gdn_out(o_lat, zl, o_gain, w_out)
    yc = gdn_out(o_ctx, zc, o_gain, w_out) if with_ctx_out else None
    return y, yc


def window_mean(x, w, axis):
    n = x.shape[axis]
    cs = jnp.cumsum(x.astype(jnp.float32), axis=axis)
    pad_width = [(0, 0)] * x.ndim
    pad_width[axis] = (1, 0)
    cs = jnp.pad(cs, pad_width)
    pos = jnp.arange(n)
    lo = jnp.clip(pos - w // 2, 0, n)
    hi = jnp.clip(pos + (w - w // 2), 0, n)
    total = jnp.take(cs, hi, axis=axis) - jnp.take(cs, lo, axis=axis)
    shape = [1] * x.ndim
    shape[axis] = n
    count = (hi - lo).astype(jnp.float32).reshape(shape)
    return (total / count).astype(x.dtype)


def pool_mixer(u, w_grp, scale, on_grid):
    B, T, D = u.shape
    if on_grid:
        rows = T // GRID_W
        xg = u.reshape(B, rows, GRID_W, POOL_GROUPS, POOL_GROUP_DIM)
        axes = (2, 1)
    else:
        xg = u.reshape(B, T, POOL_GROUPS, POOL_GROUP_DIM)
        axes = (1,)
    diffs = []
    for gi, w in enumerate(POOL_WINDOWS):
        xi = xg[..., gi, :]
        m = xi
        for ax in axes:
            m = window_mean(m, w, ax)
        diffs.append(m - xi)
    p = jnp.stack(diffs, axis=-2)
    y = jnp.einsum('...gc,gce->...ge', p, w_grp).reshape(B, T, D)
    return y * scale


def ec_moe(u, w_router, w_gate, w_up, w_down):
    B, T, D = u.shape
    cap = (EC_CAPACITY_FACTOR * T) // N_EXPERTS
    aff = jax.nn.softmax((u @ w_router).astype(jnp.float32), axis=-1)
    gates, idx = lax.top_k(jnp.swapaxes(aff, 1, 2), cap)
    bidx = jnp.arange(B)[:, None, None]
    xs = u[bidx, idx]
    hid = jax.nn.silu(jnp.einsum('becd,edf->becf', xs, w_gate)) * jnp.einsum('becd,edf->becf', xs, w_up)
    ys = jnp.einsum('becf,efd->becd', hid, w_down) * gates[..., None].astype(u.dtype)
    return jnp.zeros_like(u).at[bidx, idx].add(ys)


def setup_inputs(seed: int = 0) -> dict:
    key = jax.random.key(seed)
    ks = jax.random.split(key, 24)
    f32 = jnp.float32
    n_gdn = len(range(MIXER_GDN, DEPTH, N_MIXERS))
    n_pool = len(range(MIXER_POOL, DEPTH, N_MIXERS))
    nrm = lambda k, shape, s: jax.random.normal(k, shape, f32) * s
    dt = jnp.exp(jax.random.uniform(ks[10], (n_gdn, N_DIRS, GDN_HEADS), f32,
                                    minval=math.log(1e-3), maxval=math.log(1e-1)))
    return {
        'x': nrm(ks[0], (BATCH, SEQ, D_MODEL), 1.0),
        'c': nrm(ks[1], (BATCH, D_MODEL), 1.0),
        'ctx': nrm(ks[2], (BATCH, CTX_LEN, D_MODEL), 1.0),
        'c_ctx': nrm(ks[3], (D_MODEL,), 1.0),
        'w_mod': nrm(ks[4], (DEPTH, D_MODEL, N_MOD * D_MODEL), 0.3 * D_MODEL ** -0.5),
        'b_mod': nrm(ks[5], (DEPTH, N_MOD * D_MODEL), 0.02),
        'norm_mix_g': 1.0 + nrm(ks[6], (DEPTH, D_MODEL), 0.02),
        'norm_ffn_g': 1.0 + nrm(ks[7], (DEPTH, D_MODEL), 0.02),
        'gdn_w_in': nrm(ks[8], (n_gdn, D_MODEL, GDN_PROJ_DIM), D_MODEL ** -0.5),
        'gdn_conv_w': nrm(ks[9], (n_gdn, CONV_W, GDN_QKV_DIM), CONV_W ** -0.5),
        'gdn_a_log': jnp.log(jax.random.uniform(ks[11], (n_gdn, N_DIRS, GDN_HEADS), f32, minval=1.0, maxval=16.0)),
        'gdn_dt_bias': dt + jnp.log(-jnp.expm1(-dt)),
        'gdn_o_gain': 1.0 + nrm(ks[12], (n_gdn, GDN_HEAD_DIM), 0.02),
        'gdn_w_out': nrm(ks[13], (n_gdn, GDN_VALUE_DIM, D_MODEL), GDN_VALUE_DIM ** -0.5),
        'pool_w': nrm(ks[14], (n_pool, POOL_GROUPS, POOL_GROUP_DIM, POOL_GROUP_DIM), POOL_GROUP_DIM ** -0.5),
        'pool_scale': 1.0 + nrm(ks[15], (n_pool, D_MODEL), 0.05),
        'moe_w_router': nrm(ks[16], (DEPTH, D_MODEL, N_EXPERTS), D_MODEL ** -0.5),
        'moe_w_gate': nrm(ks[17], (DEPTH, N_EXPERTS, D_MODEL, D_EXPERT), D_MODEL ** -0.5),
        'moe_w_up': nrm(ks[18], (DEPTH, N_EXPERTS, D_MODEL, D_EXPERT), D_MODEL ** -0.5),
        'moe_w_down': nrm(ks[19], (DEPTH, N_EXPERTS, D_EXPERT, D_MODEL), D_EXPERT ** -0.5),
        'final_g': 1.0 + nrm(ks[20], (D_MODEL,), 0.02),
    }


def reference(x, c, ctx, c_ctx, w_mod, b_mod, norm_mix_g, norm_ffn_g,
              gdn_w_in, gdn_conv_w, gdn_a_log, gdn_dt_bias, gdn_o_gain, gdn_w_out,
              pool_w, pool_scale, moe_w_router, moe_w_gate, moe_w_up, moe_w_down, final_g):
    h, hc = x, ctx
    c_act = jax.nn.silu(c)
    cc_act = jax.nn.silu(c_ctx)
    for i in range(DEPTH):
        kind = i % N_MIXERS
        j = i // N_MIXERS
        ctx_carry = any(l % N_MIXERS == MIXER_GDN for l in range(i + 1, DEPTH))
        mod = c_act @ w_mod[i] + b_mod[i]
        sh_m, sc_m, gt_m, sh_f, sc_f, gt_f = [t[:, None, :] for t in jnp.split(mod, N_MOD, axis=-1)]
        u = modulate(rmsnorm(h, norm_mix_g[i]), sh_m, sc_m)
        uc = None
        mod_c = None
        if kind == MIXER_GDN or ctx_carry:
            mod_c = jnp.split(cc_act @ w_mod[i] + b_mod[i], N_MOD, axis=-1)
            uc = modulate(rmsnorm(hc, norm_mix_g[i]), mod_c[0], mod_c[1])
        if kind == MIXER_GDN:
            y, yc = gated_deltanet(u, uc, gdn_w_in[j], gdn_conv_w[j], gdn_a_log[j], gdn_dt_bias[j],
                                   gdn_o_gain[j], gdn_w_out[j], ctx_carry)
        else:
            y = pool_mixer(u, pool_w[j], pool_scale[j], True)
            yc = pool_mixer(uc, pool_w[j], pool_scale[j], False) if ctx_carry else None
        h = h + gt_m * y
        h = h + gt_f * ec_moe(modulate(rmsnorm(h, norm_ffn_g[i]), sh_f, sc_f),
                              moe_w_router[i], moe_w_gate[i], moe_w_up[i], moe_w_down[i])
        if ctx_carry:
            hc = hc + mod_c[2] * yc
            hc = hc + mod_c[5] * ec_moe(modulate(rmsnorm(hc, norm_ffn_g[i]), mod_c[3], mod_c[4]),
                                        moe_w_router[i], moe_w_gate[i], moe_w_up[i], moe_w_down[i])
    return rmsnorm(h, final_g)
```

```cpp
#include <hip/hip_runtime.h>
#include <hip/hip_cooperative_groups.h>
#include <cstdio>
namespace cg = cooperative_groups;

#ifndef MK_N_LAUNCHES
#define MK_N_LAUNCHES 1
#endif

#define LAS __attribute__((address_space(3)))
typedef unsigned short bf16_t;
typedef short bf16x8 __attribute__((ext_vector_type(8)));
typedef float f32x4 __attribute__((ext_vector_type(4)));
typedef float f32x2 __attribute__((ext_vector_type(2)));
typedef unsigned u32x4 __attribute__((ext_vector_type(4)));
typedef unsigned u32x2 __attribute__((ext_vector_type(2)));

constexpr int NB = 4, T = 4096, D = 1024, TC = 256, NH = 8, DH = 128, NE = 16, CAP = 512, DF = 2048;
constexpr int ML = NB * T;
constexpr int MC = NB * TC;
constexpr int MA = ML + MC;
constexpr int NPROJ = 4128, NPROJ_PAD = 4352, NQKV = 3072, NP = 4096;
constexpr int NCHUNK = MA / 64;
constexpr int MX = NB * NE * CAP;
constexpr float EPS = 1e-6f;
constexpr int NTHR = 512, NWAVE = 8;

constexpr size_t MiB = 1u << 20;
constexpr size_t WS_CTL = 0;
constexpr size_t WS_MOD = 1 * MiB;
constexpr size_t WS_AB = 2 * MiB;
constexpr size_t WS_GCB = 5 * MiB;
constexpr size_t WS_AFF = 5 * MiB;
constexpr size_t WS_SLOT = 6 * MiB;
constexpr size_t WS_IDX = 7 * MiB;
constexpr size_t WS_GATE = 7 * MiB + 256 * 1024;
constexpr size_t WS_WIN = 8 * MiB;
constexpr size_t WS_WOUT = 17 * MiB;
constexpr size_t WS_POOLW = 19 * MiB;
constexpr size_t WS_WMOE = 20 * MiB;
constexpr size_t WS_W2T = WS_WMOE + 128 * MiB;
constexpr size_t WS_H = 212 * MiB;
constexpr size_t WS_U = 276 * MiB;
constexpr size_t WS_ON = 310 * MiB;
constexpr size_t WS_G = 342 * MiB;
constexpr size_t WS_P = WS_G;
constexpr size_t WS_QKV = WS_G + 136 * MiB;
constexpr size_t WS_KT = WS_G + 238 * MiB;
constexpr size_t WS_VT = WS_G + 272 * MiB;
constexpr size_t WS_W = WS_G + 306 * MiB;
constexpr size_t WS_UT = WS_G + 374 * MiB;
constexpr size_t WS_ATT = WS_G + 442 * MiB;
constexpr size_t WS_O = WS_G + 476 * MiB;
constexpr size_t WS_XS = WS_G;
constexpr size_t WS_HID = WS_G + 64 * MiB;
constexpr size_t WS_YS = WS_G + 192 * MiB;
constexpr size_t WS_END = WS_G + 604 * MiB;

constexpr int LDS_BYTES = 163840;

typedef __bf16 bf16v2 __attribute__((ext_vector_type(2)));
__device__ __forceinline__ unsigned pk2(float lo, float hi) { const f32x2 v = {lo, hi}; return __builtin_bit_cast(unsigned, __builtin_convertvector(v, bf16v2)); }
__device__ __forceinline__ unsigned f2bf(float f) { return pk2(f, 0.f) & 0xffffu; }
__device__ __forceinline__ float bflo(unsigned w) { return __uint_as_float(w << 16); }
__device__ __forceinline__ float bfhi(unsigned w) { return __uint_as_float(w & 0xffff0000u); }
__device__ __forceinline__ float bf1(bf16_t b) { return __uint_as_float(((unsigned)b) << 16); }
#define DPP_ADD(v, ctrl) ((v) + __builtin_bit_cast(float, __builtin_amdgcn_update_dpp(0, __builtin_bit_cast(int, (v)), (ctrl), 0xf, 0xf, true)))
__device__ __forceinline__ float row16_sum(float v) {
    v = DPP_ADD(v, 0xB1); v = DPP_ADD(v, 0x4E); v = DPP_ADD(v, 0x141); v = DPP_ADD(v, 0x140); return v;
}
__device__ __forceinline__ float wave_sum(float v) { v = row16_sum(v); v += __shfl_xor(v, 16); v += __shfl_xor(v, 32); return v; }
__device__ __forceinline__ float siluf(float x) { return x * __builtin_amdgcn_rcpf(1.f + __expf(-x)); }
__device__ __forceinline__ float sigmoidf(float x) { return __builtin_amdgcn_rcpf(1.f + __expf(-x)); }
__device__ __forceinline__ float softplusf(float x) { return fmaxf(x, 0.f) + log1pf(__expf(-fabsf(x))); }
#define LDS_WAIT() asm volatile("s_waitcnt lgkmcnt(0)" ::: "memory")

namespace pg8 {
constexpr int BM = 256, BK = 64, HALF = 128, HTB = HALF * BK * 2, STAGE_BYTES = 8 * HTB;
__device__ __forceinline__ int lds_byte(int r, int c) { const int st = (r >> 4) * 2 + (c >> 5), rr = r & 15, cc = c & 31, ob = rr * 64 + cc * 2; return st * 1024 + (ob ^ (((ob >> 9) & 1) << 5)); }
__device__ __forceinline__ void stage_rc(int b, int& R, int& C) { const int st = b / 1024, sb = b % 1024, swz = sb ^ (((sb >> 9) & 1) << 5); R = (st >> 1) * 16 + swz / 64; C = (st & 1) * 32 + (swz % 64) / 2; }

struct Unit { int pm, pn, pb, ak; };
struct Gemm { const bf16_t* A; const bf16_t* Bt; int lda, K; };

#ifndef PG8_SP2
#define PG8_SP2 true
#endif
#ifndef PG8_ALIGN
#define PG8_ALIGN true
#endif
template <class Epi, class Sched, bool ALIGN_EPI = PG8_ALIGN, bool SP2 = PG8_SP2>
__device__ __forceinline__ void gemm_phase(LAS unsigned char* lds, const Gemm g, const Sched& S, const Epi& E) {
    int tid = threadIdx.x; asm volatile("" : "+v"(tid));
    const int wid = __builtin_amdgcn_readfirstlane(tid >> 6), lane = tid & 63, wr = wid >> 2, wc = wid & 3, fr = lane & 15, fq = lane >> 4;
    int K = g.K, lda = g.lda; asm volatile("" : "+s"(K), "+s"(lda));
    const int nt = K / BK;
    unsigned voffA[2], voffB[2];
#pragma unroll
    for (int i = 0; i < 2; ++i) { int R, C; stage_rc(tid * 16 + i * 8192, R, C); voffA[i] = (unsigned)(R * lda + C) * 2u; voffB[i] = (unsigned)(R * K + C) * 2u; }
    const size_t kstep = (size_t)(BK * 2);
    const size_t hsA = (size_t)HALF * lda * 2, hsB = (size_t)HALF * K * 2;
    const unsigned ldsw = (unsigned)wid * 1024u;
    const int aoff = lds_byte(wr * 64 + fr, fq * 8), boff = lds_byte(wc * 32 + fr, fq * 8);
#define PG8_SA(b, h) (((b) * 2 + (h)) * HTB)
#define PG8_SB(b, h) ((4 + (b) * 2 + (h)) * HTB)
#define PG8_STAGE(bufoff, gbase, voff) do { _Pragma("unroll") for (int _i = 0; _i < 2; ++_i) \
        __builtin_amdgcn_global_load_lds((const unsigned*)((const char*)(gbase) + (voff)[_i]), (LAS unsigned*)(lds + (bufoff) + ldsw + _i * 8192), 16, 0, 0); } while (0)
#define PG8_LDA(dst, b, h) do { _Pragma("unroll") for (int m = 0; m < 4; ++m) _Pragma("unroll") for (int k = 0; k < 2; ++k) dst[m][k] = *(const LAS bf16x8*)(lds + PG8_SA(b, h) + aoff + m * 2048 + k * 1024); } while (0)
#define PG8_LDB(dst, b, h) do { _Pragma("unroll") for (int n = 0; n < 2; ++n) _Pragma("unroll") for (int k = 0; k < 2; ++k) dst[n][k] = *(const LAS bf16x8*)(lds + PG8_SB(b, h) + boff + n * 2048 + k * 1024); } while (0)
#define PG8_MMA(ai, bj, At, Bt) do { __builtin_amdgcn_s_setprio(1); _Pragma("unroll") for (int m = 0; m < 4; ++m) _Pragma("unroll") for (int n = 0; n < 2; ++n) _Pragma("unroll") for (int k = 0; k < 2; ++k) \
        acc[ai][bj][m][n] = __builtin_amdgcn_mfma_f32_16x16x32_bf16(Bt[n][k], At[m][k], acc[ai][bj][m][n], 0, 0, 0); __builtin_amdgcn_s_setprio(0); } while (0)
#define PG8_WAIT_V(n) asm volatile("s_waitcnt vmcnt(" #n ")" ::: "memory")
#define PG8_WAIT_L(n) asm volatile("s_waitcnt lgkmcnt(" #n ")" ::: "memory")
#define PG8_BAR __builtin_amdgcn_s_barrier()
#define PG8_SCHED __builtin_amdgcn_sched_barrier(0)
    Unit cur, nxt; int ui = 0;
    if (!S.next(0, cur)) return;
    f32x4 acc[2][2][4][2];
#pragma unroll
    for (int a = 0; a < 2; ++a)
#pragma unroll
        for (int b = 0; b < 2; ++b)
#pragma unroll
            for (int m = 0; m < 4; ++m)
#pragma unroll
                for (int n = 0; n < 2; ++n) acc[a][b][m][n] = (f32x4){0.f, 0.f, 0.f, 0.f};
    bf16x8 At[4][2], B0[2][2], B1[2][2];
    const char* cA = (const char*)g.A + ((size_t)cur.pm * BM * lda + cur.ak) * 2; const char* cB = (const char*)g.Bt + (size_t)cur.pb * BM * K * 2;
    if constexpr (SP2) {
        PG8_STAGE(PG8_SB(0, 0), cB, voffB); PG8_STAGE(PG8_SB(0, 1), cB + hsB, voffB); PG8_STAGE(PG8_SA(0, 0), cA, voffA); PG8_STAGE(PG8_SA(0, 1), cA + hsA, voffA);
        if (wr == 1) PG8_BAR;
        PG8_WAIT_V(2); PG8_BAR;
        PG8_STAGE(PG8_SB(1, 0), cB + kstep, voffB); PG8_STAGE(PG8_SA(1, 0), cA + kstep, voffA); PG8_STAGE(PG8_SB(1, 1), cB + hsB + kstep, voffB);
        PG8_WAIT_V(6); PG8_BAR;
    } else {
        PG8_STAGE(PG8_SB(0, 0), cB, voffB); PG8_STAGE(PG8_SA(0, 0), cA, voffA); PG8_STAGE(PG8_SB(0, 1), cB + hsB, voffB); PG8_STAGE(PG8_SA(0, 1), cA + hsA, voffA);
        if (wr == 1) PG8_BAR;
        PG8_WAIT_V(4); PG8_BAR;
        PG8_STAGE(PG8_SB(1, 0), cB + kstep, voffB); PG8_STAGE(PG8_SA(1, 0), cA + kstep, voffA); PG8_STAGE(PG8_SB(1, 1), cB + hsB + kstep, voffB);
        PG8_WAIT_V(6); PG8_BAR;
    }
    for (;;) {
        const bool has_next = S.next(ui + 1, nxt);
        const char* nA = has_next ? (const char*)g.A + ((size_t)nxt.pm * BM * lda + nxt.ak) * 2 : cA; const char* nB = has_next ? (const char*)g.Bt + (size_t)nxt.pb * BM * K * 2 : cB;
#pragma unroll 1
        for (int t = 0; t < nt; t += 2) {
            const bool last = (t == nt - 2);
            const char* a1 = cA + (size_t)(t + 1) * kstep;
            const char* a2 = last ? nA : cA + (size_t)(t + 2) * kstep; const char* b2 = last ? nB : cB + (size_t)(t + 2) * kstep;
            const char* a3 = a2 + kstep; const char* b3 = b2 + kstep;
            if constexpr (SP2) {
            PG8_LDB(B0, 0, 0); PG8_LDB(B1, 0, 1); PG8_SCHED; PG8_LDA(At, 0, 0); PG8_STAGE(PG8_SA(1, 1), a1 + hsA, voffA);
            PG8_WAIT_V(8); PG8_WAIT_L(0); PG8_BAR; PG8_MMA(0, 0, At, B0); PG8_MMA(0, 1, At, B1); PG8_BAR; PG8_SCHED;
            PG8_LDA(At, 0, 1); PG8_STAGE(PG8_SB(0, 0), b2, voffB); PG8_STAGE(PG8_SB(0, 1), b2 + hsB, voffB); PG8_STAGE(PG8_SA(0, 0), a2, voffA);
            PG8_WAIT_V(8); PG8_WAIT_L(0); PG8_BAR; PG8_MMA(1, 0, At, B0); PG8_MMA(1, 1, At, B1); PG8_BAR; PG8_SCHED;
            PG8_LDB(B0, 1, 0); PG8_LDB(B1, 1, 1); PG8_SCHED; PG8_LDA(At, 1, 0); PG8_STAGE(PG8_SA(0, 1), a2 + hsA, voffA);
            PG8_WAIT_V(8); PG8_WAIT_L(0); PG8_BAR; PG8_MMA(0, 0, At, B0); PG8_MMA(0, 1, At, B1); PG8_BAR; PG8_SCHED;
            PG8_LDA(At, 1, 1); PG8_STAGE(PG8_SB(1, 0), b3, voffB); PG8_STAGE(PG8_SB(1, 1), b3 + hsB, voffB); PG8_STAGE(PG8_SA(1, 0), a3, voffA);
            PG8_WAIT_V(8); PG8_WAIT_L(0); PG8_BAR; PG8_MMA(1, 0, At, B0); PG8_MMA(1, 1, At, B1); PG8_BAR; PG8_SCHED;
            } else {
            PG8_LDB(B0, 0, 0); PG8_SCHED; PG8_LDA(At, 0, 0); PG8_STAGE(PG8_SA(1, 1), a1 + hsA, voffA);
            PG8_WAIT_L(8); PG8_BAR; PG8_WAIT_L(0); PG8_MMA(0, 0, At, B0); PG8_BAR; PG8_SCHED;
            PG8_LDB(B1, 0, 1); PG8_STAGE(PG8_SB(0, 0), b2, voffB);
            PG8_BAR; PG8_WAIT_L(0); PG8_MMA(0, 1, At, B1); PG8_BAR;
            PG8_LDA(At, 0, 1); PG8_STAGE(PG8_SA(0, 0), a2, voffA);
            PG8_BAR; PG8_WAIT_L(0); PG8_MMA(1, 0, At, B0); PG8_BAR; PG8_SCHED;
            PG8_STAGE(PG8_SB(0, 1), b2 + hsB, voffB);
            PG8_WAIT_V(6); PG8_BAR; PG8_MMA(1, 1, At, B1); PG8_BAR;
            PG8_LDB(B0, 1, 0); PG8_SCHED; PG8_LDA(At, 1, 0); PG8_STAGE(PG8_SA(0, 1), a2 + hsA, voffA);
            PG8_WAIT_L(8); PG8_BAR; PG8_WAIT_L(0); PG8_MMA(0, 0, At, B0); PG8_BAR; PG8_SCHED;
            PG8_LDB(B1, 1, 1); PG8_STAGE(PG8_SB(1, 0), b3, voffB);
            PG8_BAR; PG8_WAIT_L(0); PG8_MMA(0, 1, At, B1); PG8_BAR;
            PG8_LDA(At, 1, 1); PG8_STAGE(PG8_SA(1, 0), a3, voffA);
            PG8_BAR; PG8_WAIT_L(0); PG8_MMA(1, 0, At, B0); PG8_BAR; PG8_SCHED;
            PG8_STAGE(PG8_SB(1, 1), b3 + hsB, voffB);
            PG8_WAIT_V(6); PG8_BAR; PG8_MMA(1, 1, At, B1); PG8_BAR;
            }
        }
        if constexpr (ALIGN_EPI) { if (wr == 0) PG8_BAR; }
        E(acc, cur, wr, wc, fr, fq);
        if (!has_next) break;
#pragma unroll
        for (int a = 0; a < 2; ++a)
#pragma unroll
            for (int b = 0; b < 2; ++b)
#pragma unroll
                for (int m = 0; m < 4; ++m)
#pragma unroll
                    for (int n = 0; n < 2; ++n) acc[a][b][m][n] = (f32x4){0.f, 0.f, 0.f, 0.f};
        cur = nxt; cA = nA; cB = nB; ++ui;
        if constexpr (ALIGN_EPI) { if (wr == 1) PG8_BAR; }
    }
    PG8_WAIT_V(0);
    if constexpr (!ALIGN_EPI) { if (wr == 0) PG8_BAR; }
    PG8_BAR;
#undef PG8_SA
#undef PG8_SB
#undef PG8_STAGE
#undef PG8_LDA
#undef PG8_LDB
#undef PG8_MMA
#undef PG8_WAIT_V
#undef PG8_WAIT_L
#undef PG8_BAR
#undef PG8_SCHED
}

struct DenseOrder {
    int nM, nN, nwg, G, c;
    __device__ __forceinline__ void init(int nM_, int nN_, int G_, int c_) { nM = nM_; nN = nN_; nwg = nM * nN; G = G_; c = c_; }
    __device__ __forceinline__ bool next(int i, Unit& u) const {
        const long L = (long)i * G + c; if (L >= nwg) return false;
        int wgid = (int)L; { const int q = nwg / 8, r = nwg % 8, xcd = wgid % 8, off = wgid / 8; wgid = (xcd < r ? xcd * (q + 1) : r * (q + 1) + (xcd - r) * q) + off; }
        const int nig = 8 * nN, gid = wgid / nig, fm = gid * 8, gsz = (nM - fm) < 8 ? (nM - fm) : 8;
        u.pm = fm + ((wgid % nig) % gsz); u.pn = (wgid % nig) / gsz; u.pb = u.pn; u.ak = 0; return true;
    }
};
struct MoeUpOrder {
    int G, c;
    __device__ __forceinline__ bool next(int i, Unit& u) const {
        const int L = i * G + c; if (L >= 2048) return false;
        const int r = L / 256, cc = L % 256, x = cc % 8, j = cc / 8;
        const int e = 2 * x + (r >> 2); u.pm = e * 8 + (j & 7); u.pn = 4 * (r & 3) + (j >> 3); u.pb = e * 16 + u.pn; u.ak = 0; return true;
    }
};
struct MoeDownOrder {
    int G, c;
    __device__ __forceinline__ bool next(int i, Unit& u) const {
        const int L = i * G + c; if (L >= 512) return false;
        const int r = L / 256, cc = L % 256, x = cc % 8, j = cc / 8;
        const int e = 8 * r + x; u.pm = e * 8 + (j & 7); u.pn = j >> 3; u.pb = e * 4 + u.pn; u.ak = 0; return true;
    }
};
struct PoolOrder {
    int G, c;
    __device__ __forceinline__ bool next(int i, Unit& u) const {
        const int L = i * G + c; if (L >= 256) return false;
        const int x = L % 8, j = L / 8; u.pm = x * 8 + (j & 7); u.pn = j >> 3; u.pb = u.pn; u.ak = u.pn * 256; return true;
    }
};

struct EpiInProj {
    bf16_t* P; float* AB;
    __device__ __forceinline__ void operator()(const f32x4 (&acc)[2][2][4][2], const Unit& u, int wr, int wc, int fr, int fq) const {
        const int row0 = u.pm * BM + wr * 64 + fr;
        if (u.pn < 16) {
            const int col0 = u.pn * BM + wc * 32 + 4 * fq;
#pragma unroll
            for (int ai = 0; ai < 2; ++ai)
#pragma unroll
                for (int m = 0; m < 4; ++m) { bf16_t* rowp = P + (size_t)(row0 + ai * HALF + m * 16) * NP + col0;
#pragma unroll
                    for (int bj = 0; bj < 2; ++bj)
#pragma unroll
                        for (int n = 0; n < 2; ++n) { const f32x4 v = acc[ai][bj][m][n]; u32x2 w; w.x = pk2(v[0], v[1]); w.y = pk2(v[2], v[3]); *(u32x2*)(rowp + bj * HALF + n * 16) = w; } }
        } else if (wc == 0) {
#pragma unroll
            for (int ai = 0; ai < 2; ++ai)
#pragma unroll
                for (int m = 0; m < 4; ++m) { float* rowp = AB + (size_t)(row0 + ai * HALF + m * 16) * 32 + 4 * fq;
#pragma unroll
                    for (int n = 0; n < 2; ++n) *(f32x4*)(rowp + n * 16) = acc[ai][0][m][n]; }
        }
    }
};
struct EpiOutProj {
    const float* X; float* H; const float* gate;
    __device__ __forceinline__ void operator()(const f32x4 (&acc)[2][2][4][2], const Unit& u, int wr, int wc, int fr, int fq) const {
        const int row0 = u.pm * BM + wr * 64 + fr, col0 = u.pn * BM + wc * 32 + 4 * fq;
        const float* gp = gate + (size_t)(u.pm * BM / T) * 6144 + col0;
        f32x4 gv[2][2];
#pragma unroll
        for (int bj = 0; bj < 2; ++bj)
#pragma unroll
            for (int n = 0; n < 2; ++n) gv[bj][n] = *(const f32x4*)(gp + bj * HALF + n * 16);
#pragma unroll
        for (int ai = 0; ai < 2; ++ai)
#pragma unroll
            for (int m = 0; m < 4; ++m) { const size_t off = (size_t)(row0 + ai * HALF + m * 16) * D + col0;
#pragma unroll
                for (int bj = 0; bj < 2; ++bj)
#pragma unroll
                    for (int n = 0; n < 2; ++n) { const f32x4 xv = *(const f32x4*)(X + off + bj * HALF + n * 16); *(f32x4*)(H + off + bj * HALF + n * 16) = xv + gv[bj][n] * acc[ai][bj][m][n]; }
                asm volatile("" ::: "memory"); }
    }
};
struct EpiSwiglu {
    bf16_t* HID;
    __device__ __forceinline__ void operator()(const f32x4 (&acc)[2][2][4][2], const Unit& u, int wr, int wc, int fr, int fq) const {
        const int row0 = u.pm * BM + wr * 64 + fr, col0 = u.pn * HALF + wc * 32 + 4 * fq;
#pragma unroll
        for (int ai = 0; ai < 2; ++ai)
#pragma unroll
            for (int m = 0; m < 4; ++m) { bf16_t* rowp = HID + (size_t)(row0 + ai * HALF + m * 16) * DF + col0;
#pragma unroll
                for (int n = 0; n < 2; ++n) { const f32x4 g = acc[ai][0][m][n], up = acc[ai][1][m][n]; float h[4];
#pragma unroll
                    for (int j = 0; j < 4; ++j) h[j] = siluf(g[j]) * up[j];
                    u32x2 w; w.x = pk2(h[0], h[1]); w.y = pk2(h[2], h[3]); *(u32x2*)(rowp + n * 16) = w; } }
    }
};
struct EpiDown {
    bf16_t* YS; const float* gates;
    __device__ __forceinline__ void operator()(const f32x4 (&acc)[2][2][4][2], const Unit& u, int wr, int wc, int fr, int fq) const {
        const int row0 = u.pm * BM + wr * 64 + fr, col0 = u.pn * BM + wc * 32 + 4 * fq;
#pragma unroll
        for (int ai = 0; ai < 2; ++ai)
#pragma unroll
            for (int m = 0; m < 4; ++m) { const int row = row0 + ai * HALF + m * 16; const float gt = gates[row]; bf16_t* rowp = YS + (size_t)row * D + col0;
#pragma unroll
                for (int bj = 0; bj < 2; ++bj)
#pragma unroll
                    for (int n = 0; n < 2; ++n) { const f32x4 v = acc[ai][bj][m][n] * gt; u32x2 w; w.x = pk2(v[0], v[1]); w.y = pk2(v[2], v[3]); *(u32x2*)(rowp + bj * HALF + n * 16) = w; } }
    }
};
struct EpiPool {
    float* H; const float* gate; const float* scale;
    __device__ __forceinline__ void operator()(const f32x4 (&acc)[2][2][4][2], const Unit& u, int wr, int wc, int fr, int fq) const {
        const int row0 = u.pm * BM + wr * 64 + fr, col0 = u.pn * BM + wc * 32 + 4 * fq;
        const float* gp = gate + (size_t)(u.pm * BM / T) * 6144 + col0;
        f32x4 gv[2][2];
#pragma unroll
        for (int bj = 0; bj < 2; ++bj)
#pragma unroll
            for (int n = 0; n < 2; ++n) gv[bj][n] = *(const f32x4*)(gp + bj * HALF + n * 16) * *(const f32x4*)(scale + col0 + bj * HALF + n * 16);
#pragma unroll
        for (int ai = 0; ai < 2; ++ai)
#pragma unroll
            for (int m = 0; m < 4; ++m) { const size_t off = (size_t)(row0 + ai * HALF + m * 16) * D + col0;
#pragma unroll
                for (int bj = 0; bj < 2; ++bj)
#pragma unroll
                    for (int n = 0; n < 2; ++n) { float* p = H + off + bj * HALF + n * 16; const f32x4 hv = *(const f32x4*)p; *(f32x4*)p = hv + gv[bj][n] * acc[ai][bj][m][n]; }
                asm volatile("" ::: "memory"); }
    }
};
}


#define XB_TMO      128
#define XB_XCNT(j)  (256  + 64 * (j))
#define XB_XSUB(j)  (1280 + 64 * (j))
#define XB_XGEN(j)  (2304 + 64 * (j))
#define XB_TOP      3328
#define XB_TOPGEN   3392
#define XCD_BAR_WORDS 3456
#define XB_SPIN_CAP (1u << 20)
__device__ __forceinline__ unsigned xb_ld(unsigned* p)              { return __hip_atomic_load(p, __ATOMIC_RELAXED, __HIP_MEMORY_SCOPE_AGENT); }
__device__ __forceinline__ unsigned xb_add(unsigned* p, unsigned v) { return __hip_atomic_fetch_add(p, v, __ATOMIC_RELAXED, __HIP_MEMORY_SCOPE_AGENT); }
__device__ __forceinline__ unsigned xb_xcc_id() { return (unsigned)__builtin_amdgcn_s_getreg((3 << 11) | 20) & 0xFu; }
#define XB_SPIN(cond, bar) do { unsigned _sp = 0; while (cond) { __builtin_amdgcn_s_sleep(1); \
    if ((++_sp & 255u) == 0u) { if (xb_ld(&(bar)[XB_TMO])) break; if (_sp > XB_SPIN_CAP) { atomicAdd(&(bar)[XB_TMO], 1u); break; } } } } while (0)
struct XcdBarrier { unsigned* bar; unsigned x; volatile LAS unsigned* st; };
__device__ __forceinline__ XcdBarrier xcd_barrier_post(unsigned* bar, volatile LAS unsigned* st) {
    XcdBarrier b; b.bar = bar; b.x = xb_xcc_id(); b.st = st;
    if (threadIdx.x == 0) (void)xb_add(&bar[XB_XCNT(b.x)], 1u);
    return b;
}
__device__ __forceinline__ void xcd_barrier_complete(unsigned* bar, unsigned x, unsigned& nloc, unsigned& nx) {
    const unsigned G = gridDim.x * gridDim.y * gridDim.z;
    unsigned sum, cnt, mine, sp = 0u;
    for (;;) {
        sum = 0u; cnt = 0u; mine = 0u;
#pragma unroll
        for (unsigned j = 0; j < 16; ++j) { const unsigned c = xb_ld(&bar[XB_XCNT(j)]); sum += c; cnt += (c > 0u) ? 1u : 0u; mine = (j == x) ? c : mine; }
        if (sum == G) break;
        __builtin_amdgcn_s_sleep(1);
        if ((++sp & 255u) == 0u) { if (xb_ld(&bar[XB_TMO])) break; if (sp > XB_SPIN_CAP) { atomicAdd(&bar[XB_TMO], 1u); break; } }
    }
    nloc = mine > 0u ? mine : 1u; nx = cnt > 0u ? cnt : 1u;
}
__device__ __forceinline__ void xcd_barrier(const XcdBarrier& b) {
    asm volatile("s_waitcnt vmcnt(0)" ::: "memory");
    __syncthreads();
    if (threadIdx.x == 0) {
        unsigned* bar = b.bar;
        __builtin_amdgcn_s_waitcnt(0);
        unsigned nloc = b.st[0], nx = b.st[1];
        if (nloc == 0u) { xcd_barrier_complete(bar, b.x, nloc, nx); b.st[0] = nloc; b.st[1] = nx; }
        const unsigned old = xb_add(&bar[XB_XSUB(b.x)], 1u);
        const unsigned gen = old / nloc;
        if (old + 1u == (gen + 1u) * nloc) {
            __builtin_amdgcn_fence(__ATOMIC_RELEASE, "agent");
            asm volatile("s_waitcnt vmcnt(0)" ::: "memory");
            const unsigned og = xb_add(&bar[XB_TOP], 1u);
            const unsigned tg = og / nx;
            if (og + 1u == (tg + 1u) * nx) xb_add(&bar[XB_TOPGEN], 1u);
            else XB_SPIN(xb_ld(&bar[XB_TOPGEN]) == tg, bar);
            __builtin_amdgcn_fence(__ATOMIC_ACQUIRE, "agent");
            xb_add(&bar[XB_XGEN(b.x)], 1u);
            asm volatile("s_waitcnt vmcnt(0)" ::: "memory");
        } else {
            XB_SPIN(xb_ld(&bar[XB_XGEN(b.x)]) == gen, bar);
            __builtin_amdgcn_fence(__ATOMIC_ACQUIRE, "agent");
            asm volatile("s_waitcnt vmcnt(0)" ::: "memory");
        }
    }
    __syncthreads();
}
constexpr int MISC_OFF = LDS_BYTES - 128;

struct Args { const float* in[21]; float* out; unsigned char* ws; int ph_lo, ph_hi; };
enum { I_X = 0, I_C, I_CTX, I_CCTX, I_WMOD, I_BMOD, I_GMIX, I_GFFN, I_WIN, I_CONVW, I_ALOG, I_DTB, I_OGAIN, I_WOUT, I_POOLW, I_POOLS, I_WR, I_WG, I_WU, I_WD, I_FING };

struct Frame {
    LAS unsigned char* lds;
    int tid, lane, wave, G, vcu;
    const float* in[21]; float* out; unsigned char* ws;
};

__device__ __forceinline__ void tr_tile(const float* __restrict__ src, int ld_src, int n_valid, bf16_t* dst_row0, int ld_dst, int k0, LAS unsigned char* scr, int lane) {
    const int nq = lane & 15, g = lane >> 4;
    f32x4 v[2][8];
    const bool ok = 4 * nq < n_valid;
#pragma unroll
    for (int i1 = 0; i1 < 2; ++i1)
#pragma unroll
        for (int i2 = 0; i2 < 8; ++i2) { const int k = 32 * i1 + 8 * g + i2;
            v[i1][i2] = ok ? *(const f32x4*)(src + (size_t)(k0 + k) * ld_src + 4 * nq) : (f32x4){0.f, 0.f, 0.f, 0.f}; }
#pragma unroll
    for (int j = 0; j < 4; ++j)
#pragma unroll
        for (int i1 = 0; i1 < 2; ++i1) {
            u32x4 w; w.x = pk2(v[i1][0][j], v[i1][1][j]); w.y = pk2(v[i1][2][j], v[i1][3][j]); w.z = pk2(v[i1][4][j], v[i1][5][j]); w.w = pk2(v[i1][6][j], v[i1][7][j]);
            const int n = 4 * nq + j, c = 4 * i1 + g;
            *(LAS u32x4*)(scr + n * 128 + ((c ^ (nq & 7)) * 16)) = w; }
    LDS_WAIT();
#pragma unroll
    for (int it = 0; it < 8; ++it) { const int n = (lane >> 3) + 8 * it, c = lane & 7;
        const u32x4 w = *(const LAS u32x4*)(scr + n * 128 + ((c ^ ((n >> 2) & 7)) * 16));
        *(u32x4*)(dst_row0 + (size_t)n * ld_dst + k0 + 8 * c) = w; }
    LDS_WAIT();
}

constexpr int TR_SMALL = 16 * 68 + 256 + 64;
__device__ __forceinline__ void tr_small_job(Frame& F, int t, LAS unsigned char* scr) {
    if (t < 1088) { const int nt = t / 16, kt = t % 16; int nv = NPROJ - 64 * nt; nv = nv < 0 ? 0 : (nv > 64 ? 64 : nv);
        tr_tile(F.in[I_WIN] + 64 * nt, NPROJ, nv, (bf16_t*)(F.ws + WS_WIN) + (size_t)64 * nt * D, D, 64 * kt, scr, F.lane); return; }
    t -= 1088;
    if (t < 256) { const int nt = t / 16, kt = t % 16;
        tr_tile(F.in[I_WOUT] + 64 * nt, D, 64, (bf16_t*)(F.ws + WS_WOUT) + (size_t)64 * nt * D, D, 64 * kt, scr, F.lane); return; }
    t -= 256;
    { const int gi = t / 16, nt = (t % 16) / 4, kt = t % 4;
        tr_tile(F.in[I_POOLW] + (size_t)gi * 65536 + 64 * nt, 256, 64, (bf16_t*)(F.ws + WS_POOLW) + (size_t)gi * 65536 + (size_t)64 * nt * 256, 256, 64 * kt, scr, F.lane); }
}
constexpr int TR_MOE = 24576;
__device__ __forceinline__ void tr_moe_job(Frame& F, int l, int t, LAS unsigned char* scr) {
    if (t < 16384) { const int e = t / 1024, r = t % 1024, which = r / 512, r2 = r % 512, nt = r2 / 16, kt = r2 % 16;
        const float* src = F.in[which ? I_WU : I_WG] + (size_t)(l * NE + e) * D * DF + 64 * nt;
        bf16_t* dst = (bf16_t*)(F.ws + WS_WMOE) + ((size_t)e * 4096 + (nt >> 1) * 256 + which * 128 + (nt & 1) * 64) * D;
        tr_tile(src, DF, 64, dst, D, 64 * kt, scr, F.lane); return; }
    t -= 16384;
    { const int e = t / 512, r = t % 512, nt = r / 32, kt = r % 32;
        const float* src = F.in[I_WD] + (size_t)(l * NE + e) * DF * D + 64 * nt;
        bf16_t* dst = (bf16_t*)(F.ws + WS_W2T) + ((size_t)e * D + 64 * nt) * DF;
        tr_tile(src, D, 64, dst, DF, 64 * kt, scr, F.lane); }
}

__device__ __forceinline__ void mod_item(Frame& F, int item) {
    LAS float* act = (LAS float*)(F.lds + 65536);
    LAS float* part = (LAS float*)(F.lds + 65536 + 20480);
    const int l = item / 96, cgp = item % 96;
    for (int i = F.tid; i < 5 * D; i += NTHR) { const int r = i >> 10, k = i & 1023; const float x = r < 4 ? F.in[I_C][r * D + k] : F.in[I_CCTX][k]; act[i] = siluf(x); }
    __syncthreads();
    const int j = cgp * 64 + F.lane;
    const float* w = F.in[I_WMOD] + (size_t)l * D * 6144 + j;
    float a0 = 0.f, a1 = 0.f, a2 = 0.f, a3 = 0.f, a4 = 0.f;
    const int kb = F.wave * 128;
#pragma unroll 8
    for (int k = 0; k < 128; ++k) { const float wv = w[(size_t)(kb + k) * 6144];
        a0 += act[kb + k] * wv; a1 += act[D + kb + k] * wv; a2 += act[2 * D + kb + k] * wv; a3 += act[3 * D + kb + k] * wv; a4 += act[4 * D + kb + k] * wv; }
    LAS float* pp = part + F.wave * 320 + F.lane;
    pp[0] = a0; pp[64] = a1; pp[128] = a2; pp[192] = a3; pp[256] = a4;
    __syncthreads();
    if (F.tid < 320) { const int r = F.tid >> 6, ln = F.tid & 63; float s = 0.f;
#pragma unroll
        for (int w8 = 0; w8 < 8; ++w8) s += part[w8 * 320 + r * 64 + ln];
        const int jj = cgp * 64 + ln;
        ((float*)(F.ws + WS_MOD))[(size_t)(l * 5 + r) * 6144 + jj] = s + F.in[I_BMOD][l * 6144 + jj]; }
    __syncthreads();
}

__device__ __forceinline__ void load_row(const float* p, int lane, f32x4 (&v)[4]) {
#pragma unroll
    for (int j = 0; j < 4; ++j) v[j] = ((const f32x4*)p)[lane + 64 * j];
}
__device__ __forceinline__ float row_rstd(const f32x4 (&v)[4]) {
    float s = 0.f;
#pragma unroll
    for (int j = 0; j < 4; ++j) s += (v[j][0] * v[j][0] + v[j][1] * v[j][1]) + (v[j][2] * v[j][2] + v[j][3] * v[j][3]);
    return rsqrtf(wave_sum(s) * (1.f / D) + EPS);
}
__device__ __forceinline__ void norm_mod(const f32x4 (&v)[4], float rstd, const float* g, const float* sh, const float* sc, int lane, f32x4 (&y)[4]) {
#pragma unroll
    for (int j = 0; j < 4; ++j) { const f32x4 gv = ((const f32x4*)g)[lane + 64 * j], shv = ((const f32x4*)sh)[lane + 64 * j], scv = ((const f32x4*)sc)[lane + 64 * j];
        y[j] = v[j] * rstd * gv * (1.f + scv) + shv; }
}
__device__ __forceinline__ void store_row_bf16(bf16_t* p, int lane, const f32x4 (&y)[4]) {
#pragma unroll
    for (int j = 0; j < 4; ++j) { u32x2 w; w.x = pk2(y[j][0], y[j][1]); w.y = pk2(y[j][2], y[j][3]); ((u32x2*)p)[lane + 64 * j] = w; }
}

__device__ __forceinline__ void phase_norm0(Frame& F) {
    const float* MOD = (const float*)(F.ws + WS_MOD);
    bf16_t* U = (bf16_t*)(F.ws + WS_U);
    for (int row = F.vcu * NWAVE + F.wave; row < MA; row += F.G * NWAVE) {
        const float* src; int mr;
        if (row < ML) { src = F.in[I_X] + (size_t)row * D; mr = row / T; } else { src = F.in[I_CTX] + (size_t)(row - ML) * D; mr = 4; }
        f32x4 v[4], y[4]; load_row(src, F.lane, v);
        const float rstd = row_rstd(v);
        const float* m = MOD + (size_t)mr * 6144;
        norm_mod(v, rstd, F.in[I_GMIX], m, m + D, F.lane, y);
        store_row_bf16(U + (size_t)row * D, F.lane, y);
    }
}

__device__ __forceinline__ void chunk_rows(int ci, int& row0, int& t0, int& slen) {
    if (ci < 256) { row0 = ci * 64; t0 = (ci & 63) * 64; slen = T; } else { const int cc = ci - 256; row0 = ML + cc * 64; t0 = (cc & 3) * 64; slen = TC; }
}
__device__ __forceinline__ void phase_conv(Frame& F) {
    const bf16_t* P = (const bf16_t*)(F.ws + WS_P);
    bf16_t* QKV = (bf16_t*)(F.ws + WS_QKV);
    bf16_t* KT = (bf16_t*)(F.ws + WS_KT);
    bf16_t* VT = (bf16_t*)(F.ws + WS_VT);
    LAS unsigned* kts = (LAS unsigned*)(F.lds + F.wave * 16896);
    LAS bf16_t* kts16 = (LAS bf16_t*)kts;
    const int lane = F.lane;
    for (int item = F.vcu * NWAVE + F.wave; item < NCHUNK * 24; item += F.G * NWAVE) {
        const int ci = item / 24, slab = item % 24;
        int row0, t0, slen; chunk_rows(ci, row0, t0, slen);
        const int col = slab * 128 + 2 * lane;
        float w0[5], w1[5];
#pragma unroll
        for (int j = 0; j < 5; ++j) { const f32x2 wv = *(const f32x2*)(F.in[I_CONVW] + (size_t)j * NQKV + col); w0[j] = wv[0]; w1[j] = wv[1]; }
        const bf16_t* src = P + (size_t)row0 * NP + col;
        unsigned rowsv[68];
#pragma unroll
        for (int j = 0; j < 68; ++j) { const int tt = j - 2; rowsv[j] = (t0 + tt >= 0 && t0 + tt < slen) ? *(const unsigned*)(src + (long)tt * NP) : 0u; }
        const int kind = slab >> 3;
#pragma unroll
        for (int tt = 0; tt < 64; ++tt) {
            float y0 = 0.f, y1 = 0.f;
#pragma unroll
            for (int j = 0; j < 5; ++j) { y0 += w0[j] * bflo(rowsv[tt + j]); y1 += w1[j] * bfhi(rowsv[tt + j]); }
            y0 = siluf(y0); y1 = siluf(y1);
            if (kind < 2) { const float ss = wave_sum(y0 * y0 + y1 * y1); float sc = rsqrtf(ss + EPS); if (kind == 0) sc *= 0.08838834764831845f; y0 *= sc; y1 *= sc; }
            const unsigned pk = pk2(y0, y1);
            *(unsigned*)(QKV + (size_t)(row0 + tt) * NQKV + col) = pk;
            if (kind >= 1) { kts16[(2 * lane) * 66 + tt] = (bf16_t)(pk & 0xffffu); kts16[(2 * lane + 1) * 66 + tt] = (bf16_t)(pk >> 16); }
        }
        if (kind >= 1) {
            LDS_WAIT();
            unsigned* dst = (unsigned*)((kind == 1 ? KT : VT) + ((size_t)ci * NH + (slab & 7)) * 128 * 64);
#pragma unroll 8
            for (int it = 0; it < 64; ++it) { const int dk = 2 * it + (lane >> 5), dw = lane & 31; dst[dk * 32 + dw] = kts[dk * 33 + dw]; }
            LDS_WAIT();
        }
    }
}

__device__ __forceinline__ void chunk_gates(Frame& F, int row0, int h, int dir, int lane, float& gc, float& beta, float& gtot) {
    const float* ab = (const float*)(F.ws + WS_AB) + (size_t)(row0 + lane) * 32 + dir * 16 + h;
    const float a = ab[0], bb = ab[8];
    const float g = -__expf(F.in[I_ALOG][dir * NH + h]) * softplusf(a + F.in[I_DTB][dir * NH + h]);
    beta = sigmoidf(bb);
    float s = g;
#pragma unroll
    for (int o = 1; o < 64; o <<= 1) { const float t = __builtin_bit_cast(float, __builtin_amdgcn_ds_bpermute((lane - o) << 2, __builtin_bit_cast(int, s))); if (lane >= o) s += t; }
    gtot = __builtin_bit_cast(float, __builtin_amdgcn_readlane(__builtin_bit_cast(int, s), 63));
    gc = dir ? (gtot - s + g) : s;
}

template <int V> __device__ __forceinline__ void phase_prep(Frame& F) {
    const bf16_t* QKV = (const bf16_t*)(F.ws + WS_QKV);
    LAS float* As = (LAS float*)(F.lds + F.wave * 17408);
    LAS float* gs = (LAS float*)(F.lds + F.wave * 17408 + 16384);
#pragma unroll 1
    for (int item = F.vcu * NWAVE + F.wave; item < NCHUNK * NH * 2; item += F.G * NWAVE) {
        const int ci = item >> 4, h = (item >> 1) & 7, dir = item & 1;
        int row0, t0, slen; chunk_rows(ci, row0, t0, slen);
        asm volatile("" ::: "memory");
        int lane_v; asm volatile("v_mbcnt_lo_u32_b32 %0, -1, 0\n\tv_mbcnt_hi_u32_b32 %0, -1, %0" : "=v"(lane_v));
        const int lane = lane_v, fr = lane & 15, fq = lane >> 4;
        const int d4 = 4 * (lane_v >> 4) - (lane_v & 15);
        const size_t dt = (size_t)(dir * NCHUNK + ci) * NH + h;
        const bf16_t* KTg = (const bf16_t*)(F.ws + WS_KT) + ((size_t)ci * NH + h) * 8192; const bf16_t* VTg = (const bf16_t*)(F.ws + WS_VT) + ((size_t)ci * NH + h) * 8192;
        {
            bf16x8 kf[4][4], qf[4][4];
#pragma unroll
            for (int mt = 0; mt < 4; ++mt)
#pragma unroll
                for (int ks = 0; ks < 4; ++ks) { const bf16_t* rp = QKV + (size_t)(row0 + 16 * mt + fr) * NQKV + h * 128 + 32 * ks + 8 * fq; kf[mt][ks] = *(const bf16x8*)(rp + 1024); qf[mt][ks] = *(const bf16x8*)rp; }
            float gc, beta, gtot; chunk_gates(F, row0, h, dir, lane, gc, beta, gtot);
            gs[lane] = gc; gs[64 + lane] = beta;
            { float* gcb = (float*)(F.ws + WS_GCB) + dt * 128; gcb[lane] = gc; gcb[64 + lane] = beta; }
            LDS_WAIT();
#pragma unroll
            for (int mi = 0; mi < (V == 3 ? 0 : 4); ++mi)
#pragma unroll
                for (int nj = 0; nj < 4; ++nj) {
                    if (dir == 0 ? (mi < nj) : (mi > nj)) continue;
                    f32x4 acc = {0.f, 0.f, 0.f, 0.f};
#pragma unroll
                    for (int ks = 0; ks < 4; ++ks) acc = __builtin_amdgcn_mfma_f32_16x16x32_bf16(kf[mi][ks], kf[nj][ks], acc, 0, 0, 0);
                    const int j = 16 * nj + fr; const float gj = gs[j];
#pragma unroll
                    for (int r = 0; r < 4; ++r) { const int i = 16 * mi + 4 * fq + r; const float gi = gs[i], bi = gs[64 + i];
                        const bool keep = (mi != nj) || (dir == 0 ? (d4 + r > 0) : (d4 + r < 0));
                        const float val = keep ? bi * acc[r] * __expf(gi - gj) : 0.f;
                        const int il = dir ? 63 - i : i, jl = dir ? 63 - j : j;
                        As[il * 64 + jl] = val; }
                }
            bf16_t* AT = (bf16_t*)(F.ws + WS_ATT) + dt * 4096;
#pragma unroll
            for (int mi = 0; mi < (V == 3 ? 0 : 4); ++mi) {
#pragma unroll
                for (int nj = 0; nj < 4; ++nj) {
                    const bool none = dir == 0 ? (mi < nj) : (mi > nj);
                    f32x4 acc = {0.f, 0.f, 0.f, 0.f};
                    if (!none) {
#pragma unroll
                        for (int ks = 0; ks < 4; ++ks) acc = __builtin_amdgcn_mfma_f32_16x16x32_bf16(kf[nj][ks], qf[mi][ks], acc, 0, 0, 0);
                    }
                    const int i = 16 * mi + fr; const float gi = gs[i];
                    float val[4];
#pragma unroll
                    for (int r = 0; r < 4; ++r) { const int j = 16 * nj + 4 * fq + r; const float gj = gs[j];
                        const bool keep = !none && ((mi != nj) || (dir == 0 ? (d4 + r <= 0) : (d4 + r >= 0)));
                        val[r] = keep ? acc[r] * __expf(gi - gj) : 0.f; }
                    u32x2 w; w.x = pk2(val[0], val[1]); w.y = pk2(val[2], val[3]);
                    *(u32x2*)(AT + i * 64 + 16 * nj + 4 * fq) = w;
                }
            }
        }
        bf16x8 ktf[8][2];
#pragma unroll
        for (int m8 = 0; m8 < 8; ++m8)
#pragma unroll
            for (int ks = 0; ks < 2; ++ks) ktf[m8][ks] = *(const bf16x8*)(KTg + (16 * m8 + fr) * 64 + 32 * ks + 8 * fq);
        LDS_WAIT();
        asm volatile("" ::: "memory");
        float t[64];
        const float lanef = (float)lane_v;
#pragma unroll
        for (int i = 0; i < 64; ++i) { float s0 = fmaxf(0.f, 1.f - fabsf(lanef - (float)i)), s1 = 0.f, s2 = 0.f, s3 = 0.f;
            asm volatile("" ::: "memory");
#pragma unroll
            for (int j = 0; j < (V == 1 ? 0 : i); ++j) { if (j == 32) asm volatile("" ::: "memory"); const float av = As[i * 64 + j];
                if ((j & 3) == 0) s0 -= av * t[j]; else if ((j & 3) == 1) s1 -= av * t[j]; else if ((j & 3) == 2) s2 -= av * t[j]; else s3 -= av * t[j]; }
            t[i] = (s0 + s1) + (s2 + s3); }
        bf16x8 vtf[8][2];
#pragma unroll
        for (int m8 = 0; m8 < 8; ++m8)
#pragma unroll
            for (int ks = 0; ks < 2; ++ks) vtf[m8][ks] = *(const bf16x8*)(VTg + (16 * m8 + fr) * 64 + 32 * ks + 8 * fq);
        {
            const int co = dir ? 63 - lane : lane;
            const float bco = gs[64 + co], sW = bco * __expf(gs[co]);
            LDS_WAIT();
            asm volatile("" ::: "memory");
            LAS unsigned char* Tl = (LAS unsigned char*)As;
#pragma unroll
            for (int i = 0; i < 64; ++i) { const int io = dir ? 63 - i : i;
                const int off = io * 128 + ((((co >> 3) ^ ((io >> 1) & 7))) << 4) + (co & 7) * 2;
                *(LAS bf16_t*)(Tl + off) = (bf16_t)f2bf(t[i] * sW); *(LAS bf16_t*)(Tl + 8192 + off) = (bf16_t)f2bf(t[i] * bco); }
            LDS_WAIT();
            asm volatile("" ::: "memory");
            bf16_t* Wg = (bf16_t*)(F.ws + WS_W) + dt * 8192; bf16_t* UTg = (bf16_t*)(F.ws + WS_UT) + dt * 8192;
            bf16x8 tf[4][2];
#pragma unroll
            for (int nt = 0; nt < 4; ++nt)
#pragma unroll
                for (int ks = 0; ks < 2; ++ks) { const int row = 16 * nt + fr, c = 4 * ks + fq; tf[nt][ks] = *(const LAS bf16x8*)(Tl + row * 128 + ((c ^ ((row >> 1) & 7)) << 4)); }
#pragma unroll
            for (int mtd = 0; mtd < (V == 2 ? 0 : 8); ++mtd) {
                const bf16x8 a0 = ktf[mtd][0], a1 = ktf[mtd][1];
#pragma unroll
                for (int nt = 0; nt < 4; ++nt) { f32x4 acc = {0.f, 0.f, 0.f, 0.f};
                    acc = __builtin_amdgcn_mfma_f32_16x16x32_bf16(a0, tf[nt][0], acc, 0, 0, 0); acc = __builtin_amdgcn_mfma_f32_16x16x32_bf16(a1, tf[nt][1], acc, 0, 0, 0);
                    u32x2 w; w.x = pk2(acc[0], acc[1]); w.y = pk2(acc[2], acc[3]);
                    if (V == 4) asm volatile("" :: "v"(w)); else *(u32x2*)(Wg + (16 * nt + fr) * 128 + 16 * mtd + 4 * fq) = w; }
            }
#pragma unroll
            for (int nt = 0; nt < 4; ++nt)
#pragma unroll
                for (int ks = 0; ks < 2; ++ks) { const int row = 16 * nt + fr, c = 4 * ks + fq; tf[nt][ks] = *(const LAS bf16x8*)(Tl + 8192 + row * 128 + ((c ^ ((row >> 1) & 7)) << 4)); }
#pragma unroll
            for (int ntd = 0; ntd < (V == 2 ? 0 : 8); ++ntd) {
                const bf16x8 b0 = vtf[ntd][0], b1 = vtf[ntd][1];
#pragma unroll
                for (int mt = 0; mt < 4; ++mt) { f32x4 acc = {0.f, 0.f, 0.f, 0.f};
                    acc = __builtin_amdgcn_mfma_f32_16x16x32_bf16(tf[mt][0], b0, acc, 0, 0, 0); acc = __builtin_amdgcn_mfma_f32_16x16x32_bf16(tf[mt][1], b1, acc, 0, 0, 0);
                    u32x2 w; w.x = pk2(acc[0], acc[1]); w.y = pk2(acc[2], acc[3]);
                    if (V == 4) asm volatile("" :: "v"(w)); else *(u32x2*)(UTg + (16 * ntd + fr) * 64 + 16 * mt + 4 * fq) = w; }
            }
        }
        LDS_WAIT();
    }
}

constexpr int SC_W = 0, SC_Q = 16384, SC_KT = 32768, SC_AT = 49152, SC_UT = 57344, SC_GC = 65536, SC_SLOT = 65792;
constexpr int SC_ST = 2 * SC_SLOT, ST_ROW = 272, SC_VN = SC_ST + 64 * ST_ROW, RT_ROW = 144, SC_END = SC_VN + 64 * RT_ROW;
static_assert(SC_END <= LDS_BYTES - 128, "scan LDS map");
#define SC_WAIT_V(n) asm volatile("s_waitcnt vmcnt(" #n ")" ::: "memory")
#define SC_BAR() do { asm volatile("s_waitcnt lgkmcnt(0)" ::: "memory"); __builtin_amdgcn_s_barrier(); asm volatile("" ::: "memory"); } while (0)
struct ScanCtx { int b, h, dir, half, mt, np, fr, fq, w, lane; unsigned offW[2], offQ[2], offK[2], offA; };
__device__ __forceinline__ int sc_chunk(const ScanCtx& c, int n) { return n < 4 ? 256 + c.b * 4 + (c.dir ? 3 - n : n) : c.b * 64 + (c.dir ? 67 - n : n - 4); }
__device__ __forceinline__ void sc_dma(Frame& F, const ScanCtx& c, int n, int slotoff) {
    const int ci = sc_chunk(c, n); int row0, t0, sl; chunk_rows(ci, row0, t0, sl);
    const size_t dt = ((size_t)(c.dir * NCHUNK + ci) * NH + c.h);
    const char* gW = (const char*)(F.ws + WS_W) + dt * 16384; const char* gQ = (const char*)(F.ws + WS_QKV) + ((size_t)row0 * NQKV + c.h * 128) * 2;
    const char* gK = (const char*)(F.ws + WS_KT) + ((size_t)ci * NH + c.h) * 16384; const char* gA = (const char*)(F.ws + WS_ATT) + dt * 8192;
    const char* gU = (const char*)(F.ws + WS_UT) + dt * 16384 + c.half * 8192; const char* gG = (const char*)(F.ws + WS_GCB) + dt * 512;
    LAS unsigned char* lds = F.lds + slotoff;
#pragma unroll
    for (int i = 0; i < 2; ++i) {
        __builtin_amdgcn_global_load_lds((const unsigned*)(gW + c.offW[i]), (LAS unsigned*)(lds + SC_W + (2 * c.w + i) * 1024), 16, 0, 0);
        __builtin_amdgcn_global_load_lds((const unsigned*)(gQ + c.offQ[i]), (LAS unsigned*)(lds + SC_Q + (2 * c.w + i) * 1024), 16, 0, 0);
        __builtin_amdgcn_global_load_lds((const unsigned*)(gK + c.offK[i]), (LAS unsigned*)(lds + SC_KT + (2 * c.w + i) * 1024), 16, 0, 0); }
    __builtin_amdgcn_global_load_lds((const unsigned*)(gA + c.offA), (LAS unsigned*)(lds + SC_AT + c.w * 1024), 16, 0, 0);
    __builtin_amdgcn_global_load_lds((const unsigned*)(gU + c.offA), (LAS unsigned*)(lds + SC_UT + c.w * 1024), 16, 0, 0);
    __builtin_amdgcn_global_load_lds((const unsigned*)(gG + c.lane * 4), (LAS unsigned*)(lds + SC_GC), 4, 0, 0);
}
__device__ __forceinline__ void sc_store_o(Frame& F, const ScanCtx& c, int n, const f32x4 (&o)[2]) {
    const int lc = c.dir ? 67 - n : n - 4;
    float* Obase = (float*)(F.ws + WS_O);
#pragma unroll
    for (int u = 0; u < 2; ++u) { float* op_ = Obase + ((size_t)c.dir * ML + (size_t)c.b * T + lc * 64 + 16 * c.mt + 4 * c.fq) * D + c.h * 128 + c.half * 64 + 16 * (2 * c.np + u) + c.fr;
#pragma unroll
        for (int r = 0; r < 4; ++r) op_[(size_t)r * D] = o[u][r]; }
}
__device__ __forceinline__ void phase_scan(Frame& F) {
    const int xcd = F.vcu >> 5, jcu = F.vcu & 31;
    if (F.G != 256 || jcu >= 16) {
        const int cw = (F.G == 256) ? xcd * 16 + (jcu - 16) : F.vcu, ncw = (F.G == 256) ? 128 : F.G;
        LAS unsigned char* scr = F.lds + F.wave * 8192;
        for (int t = cw * NWAVE + F.wave; t < TR_MOE; t += ncw * NWAVE) tr_moe_job(F, 0, t, scr);
        if (F.G == 256) return;
        __syncthreads();
    }
    ScanCtx c;
    c.lane = F.lane; c.fr = c.lane & 15; c.fq = c.lane >> 4; c.w = F.wave; c.mt = c.w >> 1; c.np = c.w & 1;
#pragma unroll
    for (int i = 0; i < 2; ++i) {
        { const int I = 2 * c.w + i, row = 4 * I + (c.lane >> 4), cc = (c.lane & 15) ^ (row & 15); c.offW[i] = (unsigned)(row * 256 + cc * 16); c.offQ[i] = (unsigned)(row * (NQKV * 2) + cc * 16); }
        { const int I = 2 * c.w + i, row = 8 * I + (c.lane >> 3), cc = (c.lane & 7) ^ ((row >> 1) & 7); c.offK[i] = (unsigned)(row * 128 + cc * 16); }
    }
    { const int row = 8 * c.w + (c.lane >> 3), cc = (c.lane & 7) ^ ((row >> 1) & 7); c.offA = (unsigned)(row * 128 + cc * 16); }
    const int lane = c.lane, fr = c.fr, fq = c.fq, mt = c.mt, np = c.np;
    LAS unsigned char* const lds = F.lds;
    const int item0 = (F.G == 256) ? xcd * 16 + jcu : F.vcu, nitem = (F.G == 256) ? 128 : F.G;
    for (int item = item0; item < 128; item += nitem) {
        c.half = item & 1; c.dir = (item >> 1) & 1; c.h = (item >> 2) & 7; c.b = item >> 5;
        for (int i = F.tid; i < 64 * ST_ROW / 4; i += NTHR) ((LAS unsigned*)(lds + SC_ST))[i] = 0u;
        f32x4 Sacc[2][2];
#pragma unroll
        for (int ud = 0; ud < 2; ++ud)
#pragma unroll
            for (int uv = 0; uv < 2; ++uv) Sacc[ud][uv] = (f32x4){0.f, 0.f, 0.f, 0.f};
        f32x4 Oprev[2] = {{0.f, 0.f, 0.f, 0.f}, {0.f, 0.f, 0.f, 0.f}};
        sc_dma(F, c, 0, 0);
        SC_WAIT_V(0);
        SC_BAR();
        sc_dma(F, c, 1, SC_SLOT);
#pragma unroll 1
        for (int n = 0; n < 68; ++n) {
            const bool latent = n >= 4;
            const int so = (n & 1) * SC_SLOT;
            LAS unsigned char* const slot = lds + so;
            LAS unsigned char* const St = lds + SC_ST;
            f32x4 xacc[2], oacc[2];
#pragma unroll
            for (int u = 0; u < 2; ++u) { xacc[u] = (f32x4){0.f, 0.f, 0.f, 0.f}; oacc[u] = (f32x4){0.f, 0.f, 0.f, 0.f}; }
            const int arow = 16 * mt + fr;
#pragma unroll
            for (int ks = 0; ks < 4; ++ks) {
                const int co = (((4 * ks + fq) ^ fr) << 4);
                const bf16x8 aW = *(const LAS bf16x8*)(slot + SC_W + arow * 256 + co), aQ = *(const LAS bf16x8*)(slot + SC_Q + arow * 256 + co);
#pragma unroll
                for (int u = 0; u < 2; ++u) { const bf16x8 bS = *(const LAS bf16x8*)(St + (16 * (2 * np + u) + fr) * ST_ROW + (32 * ks + 8 * fq) * 2);
                    xacc[u] = __builtin_amdgcn_mfma_f32_16x16x32_bf16(aW, bS, xacc[u], 0, 0, 0);
                    oacc[u] = __builtin_amdgcn_mfma_f32_16x16x32_bf16(aQ, bS, oacc[u], 0, 0, 0); } }
            const f32x4 gc4 = *(const LAS f32x4*)(slot + SC_GC + (16 * mt + 4 * fq) * 4);
            const float gtot = *(const LAS float*)(slot + SC_GC + (c.dir ? 0 : 63) * 4);
#pragma unroll
            for (int u = 0; u < 2; ++u) { const int urow = 16 * (2 * np + u) + fr, uc = 2 * mt + (fq >> 1);
              const u32x2 uw = *(const LAS u32x2*)(slot + SC_UT + urow * 128 + ((uc ^ ((urow >> 1) & 7)) << 4) + 8 * (fq & 1));
              u32x2 pw; pw.x = pk2(bflo(uw.x) - xacc[u][0], bfhi(uw.x) - xacc[u][1]); pw.y = pk2(bflo(uw.y) - xacc[u][2], bfhi(uw.y) - xacc[u][3]);
              *(LAS u32x2*)(lds + SC_VN + urow * RT_ROW + (16 * mt + 4 * fq) * 2) = pw; }
            bf16x8 aK[2][2], aA[2];
#pragma unroll
            for (int ks = 0; ks < 2; ++ks) {
                aA[ks] = *(const LAS bf16x8*)(slot + SC_AT + arow * 128 + ((((4 * ks + fq) ^ ((arow >> 1) & 7))) << 4));
                const f32x4 g0 = *(const LAS f32x4*)(slot + SC_GC + (32 * ks + 8 * fq) * 4), g1 = *(const LAS f32x4*)(slot + SC_GC + (32 * ks + 8 * fq + 4) * 4);
                float e[8];
#pragma unroll
                for (int j = 0; j < 4; ++j) { e[j] = __expf(gtot - g0[j]); e[4 + j] = __expf(gtot - g1[j]); }
#pragma unroll
                for (int ud = 0; ud < 2; ++ud) { const int krow = 16 * (2 * mt + ud) + fr;
                    const u32x4 kw = *(const LAS u32x4*)(slot + SC_KT + krow * 128 + ((((4 * ks + fq) ^ ((krow >> 1) & 7))) << 4));
                    u32x4 o; o.x = pk2(bflo(kw.x) * e[0], bfhi(kw.x) * e[1]); o.y = pk2(bflo(kw.y) * e[2], bfhi(kw.y) * e[3]); o.z = pk2(bflo(kw.z) * e[4], bfhi(kw.z) * e[5]); o.w = pk2(bflo(kw.w) * e[6], bfhi(kw.w) * e[7]);
                    aK[ud][ks] = __builtin_bit_cast(bf16x8, o); } }
            SC_BAR();
            if (n - 1 >= 4) sc_store_o(F, c, n - 1, Oprev);
            if (n + 2 < 68) sc_dma(F, c, n + 2, so);
            bf16x8 bV[2][2];
#pragma unroll
            for (int u = 0; u < 2; ++u)
#pragma unroll
                for (int ks = 0; ks < 2; ++ks) bV[u][ks] = *(const LAS bf16x8*)(lds + SC_VN + (16 * (2 * np + u) + fr) * RT_ROW + (32 * ks + 8 * fq) * 2);
            if (latent) {
#pragma unroll
                for (int u = 0; u < 2; ++u) {
#pragma unroll
                    for (int r = 0; r < 4; ++r) oacc[u][r] *= __expf(gc4[r]);
#pragma unroll
                    for (int ks = 0; ks < 2; ++ks) oacc[u] = __builtin_amdgcn_mfma_f32_16x16x32_bf16(aA[ks], bV[u][ks], oacc[u], 0, 0, 0);
                    Oprev[u] = oacc[u];
                }
            }
            const float egt = __expf(gtot);
#pragma unroll
            for (int ud = 0; ud < 2; ++ud)
#pragma unroll
                for (int uv = 0; uv < 2; ++uv) {
                    Sacc[ud][uv] *= egt;
#pragma unroll
                    for (int ks = 0; ks < 2; ++ks) Sacc[ud][uv] = __builtin_amdgcn_mfma_f32_16x16x32_bf16(aK[ud][ks], bV[uv][ks], Sacc[ud][uv], 0, 0, 0);
                    u32x2 pw; pw.x = pk2(Sacc[ud][uv][0], Sacc[ud][uv][1]); pw.y = pk2(Sacc[ud][uv][2], Sacc[ud][uv][3]);
                    *(LAS u32x2*)(St + (16 * (2 * np + uv) + fr) * ST_ROW + (16 * (2 * mt + ud) + 4 * fq) * 2) = pw;
                }
            if (n + 2 < 68) SC_WAIT_V(9); else SC_WAIT_V(0);
            SC_BAR();
        }
        sc_store_o(F, c, 67, Oprev);
        SC_WAIT_V(0);
        SC_BAR();
    }
}

__device__ __forceinline__ void phase_gdn_out(Frame& F) {
    const float* O0 = (const float*)(F.ws + WS_O); const float* O1 = O0 + (size_t)ML * D;
    const bf16_t* P = (const bf16_t*)(F.ws + WS_P);
    bf16_t* ON = (bf16_t*)(F.ws + WS_ON);
    const int lane = F.lane;
    const f32x4 gain = *(const f32x4*)(F.in[I_OGAIN] + ((4 * lane) & 127));
    for (int row = F.vcu * NWAVE + F.wave; row < ML; row += F.G * NWAVE) {
        f32x4 a[4], b[4]; load_row(O0 + (size_t)row * D, lane, a); load_row(O1 + (size_t)row * D, lane, b);
        f32x4 y[4];
#pragma unroll
        for (int j = 0; j < 4; ++j) { const f32x4 o = a[j] + b[j];
            float ss = (o[0] * o[0] + o[1] * o[1]) + (o[2] * o[2] + o[3] * o[3]);
            ss = row16_sum(ss); ss += __shfl_xor(ss, 16);
            const float rs = rsqrtf(ss * (1.f / DH) + EPS);
            const u32x2 zw = ((const u32x2*)(P + (size_t)row * NP + NQKV))[lane + 64 * j];
            const float z0 = bflo(zw.x), z1 = bfhi(zw.x), z2 = bflo(zw.y), z3 = bfhi(zw.y);
            y[j][0] = o[0] * rs * gain[0] * siluf(z0); y[j][1] = o[1] * rs * gain[1] * siluf(z1); y[j][2] = o[2] * rs * gain[2] * siluf(z2); y[j][3] = o[3] * rs * gain[3] * siluf(z3); }
        store_row_bf16(ON + (size_t)row * D, lane, y);
    }
}

__device__ __forceinline__ void phase_moe_pre(Frame& F, int l) {
    const float* MOD = (const float*)(F.ws + WS_MOD) + (size_t)l * 5 * 6144;
    const float* H = (const float*)(F.ws + WS_H);
    bf16_t* U = (bf16_t*)(F.ws + WS_U);
    float* AFF = (float*)(F.ws + WS_AFF);
    LAS float* wr = (LAS float*)F.lds;
    const float* wsrc = F.in[I_WR] + (size_t)l * D * NE;
    for (int i = F.tid; i < D * NE / 4; i += NTHR) { const int c = i >> 2, q = i & 3; *(LAS f32x4*)(wr + c * 16 + 4 * q + (c >> 2) * 4) = ((const f32x4*)wsrc)[i]; }
    __syncthreads();
    const int lane = F.lane;
    for (int row = F.vcu * NWAVE + F.wave; row < ML; row += F.G * NWAVE) {
        const int b = row / T, t = row % T;
        f32x4 v[4], y[4]; load_row(H + (size_t)row * D, lane, v);
        const float rstd = row_rstd(v);
        const float* m = MOD + (size_t)b * 6144;
        norm_mod(v, rstd, F.in[I_GFFN] + l * D, m + 3 * D, m + 4 * D, lane, y);
        store_row_bf16(U + (size_t)row * D, lane, y);
        float lg[16];
#pragma unroll
        for (int e = 0; e < 16; ++e) lg[e] = 0.f;
#pragma unroll
        for (int j = 0; j < 4; ++j) {
            asm volatile("" ::: "memory");
#pragma unroll
            for (int i = 0; i < 4; ++i) { const int c = 4 * lane + 256 * j + i; const float yv = y[j][i];
#pragma unroll
                for (int q = 0; q < 4; ++q) { const f32x4 wv = *(const LAS f32x4*)(wr + c * 16 + 4 * q + (c >> 2) * 4);
                    lg[4 * q] += yv * wv[0]; lg[4 * q + 1] += yv * wv[1]; lg[4 * q + 2] += yv * wv[2]; lg[4 * q + 3] += yv * wv[3]; } } }
        float mx = -1e30f;
#pragma unroll
        for (int e = 0; e < 16; ++e) { lg[e] = wave_sum(lg[e]); mx = fmaxf(mx, lg[e]); }
        float den = 0.f;
#pragma unroll
        for (int e = 0; e < 16; ++e) { lg[e] = __expf(lg[e] - mx); den += lg[e]; }
        const float inv = 1.f / den;
        float mine = 0.f;
#pragma unroll
        for (int e = 0; e < 16; ++e) mine = (lane == e) ? lg[e] * inv : mine;
        if (lane < 16) AFF[((size_t)b * NE + lane) * T + t] = mine;
    }
    __syncthreads();
}

__device__ __forceinline__ void phase_topk(Frame& F) {
    LAS unsigned* cnt = (LAS unsigned*)F.lds;
    const float* AFF = (const float*)(F.ws + WS_AFF);
    int* SLOT = (int*)(F.ws + WS_SLOT); int* IDX = (int*)(F.ws + WS_IDX); float* GATE = (float*)(F.ws + WS_GATE);
    for (int item = F.vcu; item < NB * NE; item += F.G) {
        const int b = item / NE, e = item % NE;
        unsigned key[8];
        { const u32x4* p = (const u32x4*)(AFF + (size_t)item * T + F.tid * 8); const u32x4 k0 = p[0], k1 = p[1];
          key[0] = k0.x; key[1] = k0.y; key[2] = k0.z; key[3] = k0.w; key[4] = k1.x; key[5] = k1.y; key[6] = k1.z; key[7] = k1.w; }
        unsigned thr = 0u;
        int par = 0;
        for (int bit = 30; bit >= 0; --bit) {
            const unsigned cand = thr | (1u << bit);
            int c = 0;
#pragma unroll
            for (int i = 0; i < 8; ++i) c += (key[i] >= cand) ? 1 : 0;
#pragma unroll
            for (int o = 1; o < 64; o <<= 1) c += __shfl_xor(c, o);
            if (F.lane == 0) cnt[par * 8 + F.wave] = (unsigned)c;
            __syncthreads();
            unsigned tot = 0;
#pragma unroll
            for (int w8 = 0; w8 < 8; ++w8) tot += cnt[par * 8 + w8];
            if (tot >= (unsigned)CAP) thr = cand;
            par ^= 1;
        }
        __syncthreads();
        int cg_ = 0, ce_ = 0;
#pragma unroll
        for (int i = 0; i < 8; ++i) { cg_ += key[i] > thr; ce_ += key[i] == thr; }
        unsigned pk = (unsigned)cg_ | ((unsigned)ce_ << 16), inc = pk;
#pragma unroll
        for (int o = 1; o < 64; o <<= 1) { const unsigned t = __shfl_up(inc, o); if (F.lane >= o) inc += t; }
        LAS unsigned* wtot = cnt + 64;
        if (F.lane == 63) wtot[F.wave] = inc;
        __syncthreads();
        unsigned base = 0, total = 0;
#pragma unroll
        for (int w8 = 0; w8 < 8; ++w8) { const unsigned v = wtot[w8]; if (w8 < F.wave) base += v; total += v; }
        const unsigned excl = base + inc - pk;
        int gt_before = excl & 0xffffu, eq_before = excl >> 16;
        const int need_eq = CAP - (int)(total & 0xffffu);
#pragma unroll
        for (int i = 0; i < 8; ++i) {
            const int t = F.tid * 8 + i;
            const bool isg = key[i] > thr, ise = key[i] == thr;
            const bool sel = isg || (ise && eq_before < need_eq);
            const int slot = gt_before + (eq_before < need_eq ? eq_before : need_eq);
            SLOT[(size_t)item * T + t] = sel ? slot : -1;
            if (sel) { IDX[item * CAP + slot] = t; GATE[(size_t)e * 2048 + b * CAP + slot] = __uint_as_float(key[i]); }
            gt_before += isg; eq_before += ise;
        }
        __syncthreads();
    }
}

__device__ __forceinline__ void phase_gather(Frame& F) {
    const bf16_t* U = (const bf16_t*)(F.ws + WS_U); bf16_t* XS = (bf16_t*)(F.ws + WS_XS); const int* IDX = (const int*)(F.ws + WS_IDX);
    for (int r = F.vcu * NWAVE + F.wave; r < MX; r += F.G * NWAVE) {
        const int e = r / 2048, b = (r % 2048) / CAP, s = r % CAP;
        const int t = IDX[(b * NE + e) * CAP + s];
        const u32x4* src = (const u32x4*)(U + ((size_t)b * T + t) * D); u32x4* dst = (u32x4*)(XS + (size_t)r * D);
        const u32x4 v0 = src[F.lane], v1 = src[F.lane + 64];
        dst[F.lane] = v0; dst[F.lane + 64] = v1;
    }
}

__device__ __forceinline__ void phase_combine(Frame& F, int l) {
    const float* MOD = (const float*)(F.ws + WS_MOD);
    float* H = (float*)(F.ws + WS_H); const bf16_t* YS = (const bf16_t*)(F.ws + WS_YS); const int* SLOT = (const int*)(F.ws + WS_SLOT);
    bf16_t* U = (bf16_t*)(F.ws + WS_U);
    const int lane = F.lane;
    for (int row = F.vcu * NWAVE + F.wave; row < ML; row += F.G * NWAVE) {
        const int b = row / T, t = row % T;
        f32x4 v[4]; load_row(H + (size_t)row * D, lane, v);
        const int myslot = lane < NE ? SLOT[((size_t)b * NE + lane) * T + t] : -1;
        f32x4 acc[4];
#pragma unroll
        for (int j = 0; j < 4; ++j) acc[j] = (f32x4){0.f, 0.f, 0.f, 0.f};
        for (int e = 0; e < NE; ++e) { const int sl = __shfl(myslot, e);
            if (sl >= 0) { const u32x2* yp = (const u32x2*)(YS + ((size_t)e * 2048 + b * CAP + sl) * D);
#pragma unroll
                for (int j = 0; j < 4; ++j) { const u32x2 w = yp[lane + 64 * j]; acc[j][0] += bflo(w.x); acc[j][1] += bfhi(w.x); acc[j][2] += bflo(w.y); acc[j][3] += bfhi(w.y); } } }
        const float* gtf = MOD + ((size_t)l * 5 + b) * 6144 + 5 * D;
#pragma unroll
        for (int j = 0; j < 4; ++j) v[j] += ((const f32x4*)gtf)[lane + 64 * j] * acc[j];
        const float rstd = row_rstd(v);
        if (l == 0) {
#pragma unroll
            for (int j = 0; j < 4; ++j) ((f32x4*)(H + (size_t)row * D))[lane + 64 * j] = v[j];
            const float* m = MOD + ((size_t)5 + b) * 6144; f32x4 y[4];
            norm_mod(v, rstd, F.in[I_GMIX] + D, m, m + D, lane, y);
            store_row_bf16(U + (size_t)row * D, lane, y);
        } else {
#pragma unroll
            for (int j = 0; j < 4; ++j) ((f32x4*)(F.out + (size_t)row * D))[lane + 64 * j] = v[j] * rstd * ((const f32x4*)F.in[I_FING])[lane + 64 * j];
        }
    }
}

__device__ __forceinline__ void phase_pool(Frame& F) {
    const bf16_t* U = (const bf16_t*)(F.ws + WS_U); bf16_t* PD = (bf16_t*)(F.ws + WS_ON);
    LAS float* Vs = (LAS float*)F.lds;
    const int cp = F.tid & 127, cgp = F.tid >> 7;
    for (int item = F.vcu; item < 1024; item += F.G) {
        const int gi = item >> 8, b = (item >> 6) & 3, r = item & 63;
        const int w = 2 << gi, lo = w >> 1, hi = w - lo;
        const int r_lo = r - lo < 0 ? 0 : r - lo, r_hi = r + hi > 64 ? 64 : r + hi;
        float s0[16], s1[16]; unsigned self[16];
#pragma unroll
        for (int i = 0; i < 16; ++i) { s0[i] = 0.f; s1[i] = 0.f; }
        const bf16_t* base = U + ((size_t)b * T + cgp * 16) * D + gi * 256 + 2 * cp;
        for (int rr = r_lo; rr < r_hi; ++rr) {
#pragma unroll
            for (int i = 0; i < 16; ++i) { const unsigned x = *(const unsigned*)(base + ((size_t)rr * 64 + i) * D); s0[i] += bflo(x); s1[i] += bfhi(x); }
        }
#pragma unroll
        for (int i = 0; i < 16; ++i) { self[i] = *(const unsigned*)(base + ((size_t)r * 64 + i) * D); *(LAS f32x2*)(Vs + (cgp * 16 + i) * 256 + 2 * cp) = (f32x2){s0[i], s1[i]}; }
        __syncthreads();
        const float inv_r = 1.f / (float)(r_hi - r_lo);
#pragma unroll
        for (int i = 0; i < 16; ++i) { const int c = cgp * 16 + i;
            const int c_lo = c - lo < 0 ? 0 : c - lo, c_hi = c + hi > 64 ? 64 : c + hi;
            float a0 = 0.f, a1 = 0.f;
            for (int cc = c_lo; cc < c_hi; ++cc) { const f32x2 x = *(const LAS f32x2*)(Vs + cc * 256 + 2 * cp); a0 += x[0]; a1 += x[1]; }
            const float sc = inv_r / (float)(c_hi - c_lo);
            *(unsigned*)(PD + ((size_t)b * T + r * 64 + c) * D + gi * 256 + 2 * cp) = pk2(a0 * sc - bflo(self[i]), a1 * sc - bfhi(self[i])); }
        __syncthreads();
    }
}

constexpr int NPHASE = 22;
__global__ void __launch_bounds__(NTHR, 2) mega_fwd(Args args) {
    extern __shared__ __attribute__((aligned(16))) unsigned char lds_raw[];
    cg::grid_group grid = cg::this_grid();
    Frame F;
    F.lds = (LAS unsigned char*)lds_raw;
    F.tid = threadIdx.x; F.lane = F.tid & 63; F.wave = __builtin_amdgcn_readfirstlane(F.tid >> 6);
    F.G = gridDim.x; { const int bx = blockIdx.x; F.vcu = (F.G % 8 == 0) ? (bx % 8) * (F.G / 8) + bx / 8 : bx; }
#pragma unroll
    for (int i = 0; i < 21; ++i) F.in[i] = args.in[i];
    F.out = args.out; F.ws = args.ws;
    const int lo = args.ph_lo, hi = args.ph_hi;
    if (F.tid < 32) ((LAS unsigned*)(F.lds + MISC_OFF))[F.tid] = 0u;
    __syncthreads();
    XcdBarrier bar = xcd_barrier_post((unsigned*)(F.ws + WS_CTL) + 4096, (volatile LAS unsigned*)(F.lds + MISC_OFF));
#ifndef PHMASK
#define PHMASK 0x3fffff
#endif
#define IN(k) ((((PHMASK) >> (k)) & 1) && lo <= (k) && (k) < hi)
#define SEAM(k) do { if (IN(k) && IN((k) + 1)) { if ((k) == 0) grid.sync(); else xcd_barrier(bar); } F.tid = threadIdx.x; asm volatile("" : "+v"(F.tid)); F.lane = F.tid & 63; F.wave = __builtin_amdgcn_readfirstlane(F.tid >> 6); } while (0)
    const int c = (int)blockIdx.x;

#ifndef REP_PHASE
#define REP_PHASE (-1)
#endif
#ifndef REP_N
#define REP_N 2
#endif
#define RUN(k, ...) for (int _r = 0; _r < ((k) == REP_PHASE ? 1 + REP_N : 1); ++_r) { if (IN(k)) { __VA_ARGS__ } SEAM(k); }
    RUN(0, {
        if (F.vcu < 192) mod_item(F, F.vcu);
        LAS unsigned char* scr = F.lds + F.wave * 8192;
        const int gw = F.vcu * NWAVE + F.wave, NGW = F.G * NWAVE;
        for (int t = gw; t < TR_SMALL; t += NGW) tr_small_job(F, t, scr);
    })
    RUN(1, phase_norm0(F);)
    RUN(2, {
        pg8::Gemm g{(const bf16_t*)(F.ws + WS_U), (const bf16_t*)(F.ws + WS_WIN), D, D};
        pg8::DenseOrder S; S.init(MA / 256, NPROJ_PAD / 256, F.G, c);
        pg8::EpiInProj E{(bf16_t*)(F.ws + WS_P), (float*)(F.ws + WS_AB)};
        pg8::gemm_phase(F.lds, g, S, E);
    })
    RUN(3, phase_conv(F);)
#ifndef PREPV
    RUN(4, phase_prep<0>(F);)
#else
    RUN(4, phase_prep<PREPV>(F); __syncthreads(); phase_prep<PREPV>(F); __syncthreads(); phase_prep<0>(F);)
#endif
    RUN(5, phase_scan(F);)
    RUN(6, phase_gdn_out(F);)
    RUN(7, {
        pg8::Gemm g{(const bf16_t*)(F.ws + WS_ON), (const bf16_t*)(F.ws + WS_WOUT), D, D};
        pg8::DenseOrder S; S.init(ML / 256, D / 256, F.G, c);
        pg8::EpiOutProj E{F.in[I_X], (float*)(F.ws + WS_H), (const float*)(F.ws + WS_MOD) + 2 * D};
        pg8::gemm_phase(F.lds, g, S, E);
    })
#pragma unroll
    for (int l = 0; l < 2; ++l) {
        if (l == 1) {
            RUN(14, phase_pool(F);)
            RUN(15, {
                pg8::Gemm g{(const bf16_t*)(F.ws + WS_ON), (const bf16_t*)(F.ws + WS_POOLW), D, 256};
                pg8::PoolOrder S{F.G, c};
                pg8::EpiPool E{(float*)(F.ws + WS_H), (const float*)(F.ws + WS_MOD) + 5 * 6144 + 2 * D, F.in[I_POOLS]};
                pg8::gemm_phase(F.lds, g, S, E);
            })
        }
        const int p0 = l == 0 ? 8 : 16;
        RUN(p0, {
            phase_moe_pre(F, l);
            if (l == 1) { LAS unsigned char* scr = F.lds + 73728 + F.wave * 8192; const int gw = F.vcu * NWAVE + F.wave, NGW = F.G * NWAVE;
                for (int t = gw; t < TR_MOE; t += NGW) tr_moe_job(F, 1, t, scr); }
        })
        RUN(p0 + 1, phase_topk(F);)
        RUN(p0 + 2, phase_gather(F);)
        RUN(p0 + 3, {
            pg8::Gemm g{(const bf16_t*)(F.ws + WS_XS), (const bf16_t*)(F.ws + WS_WMOE), D, D};
            pg8::MoeUpOrder S{F.G, c};
            pg8::EpiSwiglu E{(bf16_t*)(F.ws + WS_HID)};
            pg8::gemm_phase(F.lds, g, S, E);
        })
        RUN(p0 + 4, {
            pg8::Gemm g{(const bf16_t*)(F.ws + WS_HID), (const bf16_t*)(F.ws + WS_W2T), DF, DF};
            pg8::MoeDownOrder S{F.G, c};
            pg8::EpiDown E{(bf16_t*)(F.ws + WS_YS), (const float*)(F.ws + WS_GATE)};
            pg8::gemm_phase(F.lds, g, S, E);
        })
        RUN(p0 + 5, phase_combine(F, l);)
    }
#undef IN
#undef SEAM
#undef RUN
}

extern "C" void kernel_launch(void* const* d_in, const int* in_sizes, int n_in, void* d_out, int out_size, void* d_ws, size_t ws_size, hipStream_t stream) {
    static int grid = 0;
    if (grid == 0) {
        if (n_in != 21 || ws_size < WS_END) { fprintf(stderr, "kernel_launch: unexpected inputs (n_in %d, ws %zu)\n", n_in, ws_size); grid = -1; return; }
        int dev = 0, cus = 0, per_cu = 0;
        hipGetDevice(&dev);
        hipDeviceGetAttribute(&cus, hipDeviceAttributeMultiprocessorCount, dev);
        hipFuncSetAttribute((const void*)mega_fwd, hipFuncAttributeMaxDynamicSharedMemorySize, LDS_BYTES);
        hipOccupancyMaxActiveBlocksPerMultiprocessor(&per_cu, (const void*)mega_fwd, NTHR, LDS_BYTES);
        if (per_cu < 1) { fprintf(stderr, "kernel_launch: occupancy query says %d blocks per CU\n", per_cu); per_cu = 1; }
        grid = cus;
        (void)hipGetLastError();
    }
    if (grid < 0) return;
    hipMemsetAsync((char*)d_ws + WS_CTL, 0, 1 * MiB, stream);
    Args a{};
    for (int i = 0; i < 21; ++i) a.in[i] = (const float*)d_in[i];
    a.out = (float*)d_out; a.ws = (unsigned char*)d_ws;
#if MK_N_LAUNCHES == 1
    a.ph_lo = 0; a.ph_hi = NPHASE;
    void* params[] = {&a};
    hipError_t e = hipLaunchCooperativeKernel((const void*)mega_fwd, dim3(grid), dim3(NTHR), params, LDS_BYTES, stream);
    if (e != hipSuccess) fprintf(stderr, "cooperative launch failed: %s (grid %d)\n", hipGetErrorString(e), grid);
#else
    for (int p = 0; p < NPHASE; ++p) {
        a.ph_lo = p; a.ph_hi = p + 1;
        void* params[] = {&a};
        hipError_t e = hipLaunchCooperativeKernel((const void*)mega_fwd, dim3(grid), dim3(NTHR), params, LDS_BYTES, stream);
        if (e != hipSuccess) { fprintf(stderr, "launch %d failed: %s (grid %d)\n", p, hipGetErrorString(e), grid); break; }
    }
#endif
}
```

```cpp
#include <hip/hip_runtime.h>
#include <hip/hip_cooperative_groups.h>
#include <cstdio>
namespace cg = cooperative_groups;

#ifndef MK_N_LAUNCHES
#define MK_N_LAUNCHES 1
#endif

#define LAS __attribute__((address_space(3)))
typedef unsigned short bf16_t;
typedef short bf16x8 __attribute__((ext_vector_type(8)));
typedef float f32x4 __attribute__((ext_vector_type(4)));
typedef float f32x2 __attribute__((ext_vector_type(2)));
typedef unsigned u32x4 __attribute__((ext_vector_type(4)));
typedef unsigned u32x2 __attribute__((ext_vector_type(2)));

constexpr int NB = 4, T = 4096, D = 1024, TC = 256, NH = 8, DH = 128, NE = 16, CAP = 512, DF = 2048;
constexpr int ML = NB * T;
constexpr int MC = NB * TC;
constexpr int MA = ML + MC;
constexpr int NPROJ = 4128, NPROJ_PAD = 4352, NQKV = 3072, NP = 4096;
constexpr int NCHUNK = MA / 64;
constexpr int MX = NB * NE * CAP;
constexpr float EPS = 1e-6f;
constexpr int NTHR = 512, NWAVE = 8;

constexpr size_t MiB = 1u << 20;
constexpr size_t WS_CTL = 0;
constexpr size_t WS_MOD = 1 * MiB;
constexpr size_t WS_AB = 2 * MiB;
constexpr size_t WS_GCB = 5 * MiB;
constexpr size_t WS_AFF = 5 * MiB;
constexpr size_t WS_SLOT = 6 * MiB;
constexpr size_t WS_IDX = 7 * MiB;
constexpr size_t WS_GATE = 7 * MiB + 256 * 1024;
constexpr size_t WS_WIN = 8 * MiB;
constexpr size_t WS_WOUT = 17 * MiB;
constexpr size_t WS_POOLW = 19 * MiB;
constexpr size_t WS_WMOE = 20 * MiB;
constexpr size_t WS_W2T = WS_WMOE + 64 * MiB;
constexpr size_t WS_H = 212 * MiB;
constexpr size_t WS_U = 276 * MiB;
constexpr size_t WS_ON = 310 * MiB;
constexpr size_t WS_G = 342 * MiB;
constexpr size_t WS_P = WS_G;
constexpr size_t WS_QKV = WS_G + 136 * MiB;
constexpr size_t WS_KT = WS_G + 238 * MiB;
constexpr size_t WS_VT = WS_G + 272 * MiB;
constexpr size_t WS_W = WS_G + 306 * MiB;
constexpr size_t WS_UT = WS_G + 374 * MiB;
constexpr size_t WS_ATT = WS_G + 442 * MiB;
constexpr size_t WS_O = WS_G + 476 * MiB;
constexpr size_t WS_XS = WS_G;
constexpr size_t WS_HID = WS_G + 64 * MiB;
constexpr size_t WS_YS = WS_G + 192 * MiB;
constexpr size_t WS_END = WS_G + 604 * MiB;

constexpr int LDS_BYTES = 163840;

typedef __bf16 bf16v2 __attribute__((ext_vector_type(2)));
__device__ __forceinline__ unsigned pk2(float lo, float hi) { const f32x2 v = {lo, hi}; return __builtin_bit_cast(unsigned, __builtin_convertvector(v, bf16v2)); }
__device__ __forceinline__ unsigned f2bf(float f) { return pk2(f, 0.f) & 0xffffu; }
__device__ __forceinline__ float bflo(unsigned w) { return __uint_as_float(w << 16); }
__device__ __forceinline__ float bfhi(unsigned w) { return __uint_as_float(w & 0xffff0000u); }
__device__ __forceinline__ float bf1(bf16_t b) { return __uint_as_float(((unsigned)b) << 16); }
#define DPP_ADD(v, ctrl) ((v) + __builtin_bit_cast(float, __builtin_amdgcn_update_dpp(0, __builtin_bit_cast(int, (v)), (ctrl), 0xf, 0xf, true)))
__device__ __forceinline__ float row16_sum(float v) {
    v = DPP_ADD(v, 0xB1); v = DPP_ADD(v, 0x4E); v = DPP_ADD(v, 0x141); v = DPP_ADD(v, 0x140); return v;
}
__device__ __forceinline__ float wave_sum(float v) { v = row16_sum(v); v += __shfl_xor(v, 16); v += __shfl_xor(v, 32); return v; }
__device__ __forceinline__ float siluf(float x) { return x * __builtin_amdgcn_rcpf(1.f + __expf(-x)); }
__device__ __forceinline__ float sigmoidf(float x) { return __builtin_amdgcn_rcpf(1.f + __expf(-x)); }
__device__ __forceinline__ float softplusf(float x) { return fmaxf(x, 0.f) + log1pf(__expf(-fabsf(x))); }
__device__ __forceinline__ float rnd_fp8(float x) { const int p = __builtin_amdgcn_cvt_pk_fp8_f32(x, x, 0, false); return __builtin_amdgcn_cvt_f32_fp8(p, 0); }
__device__ __forceinline__ unsigned pk4_fp8(float a, float b, float c, float d) { int p = __builtin_amdgcn_cvt_pk_fp8_f32(a, b, 0, false); p = __builtin_amdgcn_cvt_pk_fp8_f32(c, d, p, true); return (unsigned)p; }
#define LDS_WAIT() asm volatile("s_waitcnt lgkmcnt(0)" ::: "memory")

namespace pg8 {
constexpr int BM = 256, BK = 64, HALF = 128, HTB = HALF * BK * 2, STAGE_BYTES = 8 * HTB;
__device__ __forceinline__ int lds_byte(int r, int c) { const int st = (r >> 4) * 2 + (c >> 5), rr = r & 15, cc = c & 31, ob = rr * 64 + cc * 2; return st * 1024 + (ob ^ (((ob >> 9) & 1) << 5)); }
__device__ __forceinline__ void stage_rc(int b, int& R, int& C) { const int st = b / 1024, sb = b % 1024, swz = sb ^ (((sb >> 9) & 1) << 5); R = (st >> 1) * 16 + swz / 64; C = (st & 1) * 32 + (swz % 64) / 2; }

struct Unit { int pm, pn, pb, ak; };
struct Gemm { const bf16_t* A; const bf16_t* Bt; int lda, K; };

#ifndef PG8_SP2
#define PG8_SP2 true
#endif
#ifndef PG8_ALIGN
#define PG8_ALIGN true
#endif
typedef int v8i32 __attribute__((ext_vector_type(8)));
__device__ __forceinline__ v8i32 cat8(const bf16x8 lo, const bf16x8 hi) { const u32x4 a = __builtin_bit_cast(u32x4, lo), b = __builtin_bit_cast(u32x4, hi); return (v8i32){(int)a.x, (int)a.y, (int)a.z, (int)a.w, (int)b.x, (int)b.y, (int)b.z, (int)b.w}; }
template <class Epi, class Sched, bool FP8 = false, bool ALIGN_EPI = PG8_ALIGN, bool SP2 = PG8_SP2>
__device__ __forceinline__ void gemm_phase(LAS unsigned char* lds, const Gemm g, const Sched& S, const Epi& E) {
    constexpr int ES = FP8 ? 1 : 2;
    int tid = threadIdx.x; asm volatile("" : "+v"(tid));
    const int wid = __builtin_amdgcn_readfirstlane(tid >> 6), lane = tid & 63, wr = wid >> 2, wc = wid & 3, fr = lane & 15, fq = lane >> 4;
    int K = g.K, lda = g.lda; asm volatile("" : "+s"(K), "+s"(lda));
    const int nt = K * ES / (BK * 2);
    unsigned voffA[2], voffB[2];
#pragma unroll
    for (int i = 0; i < 2; ++i) { int R, C; stage_rc(tid * 16 + i * 8192, R, C); voffA[i] = (unsigned)(R * lda * ES + C * 2); voffB[i] = (unsigned)(R * K * ES + C * 2); }
    const size_t kstep = (size_t)(BK * 2);
    const size_t hsA = (size_t)HALF * lda * ES, hsB = (size_t)HALF * K * ES;
    const unsigned ldsw = (unsigned)wid * 1024u;
    const int aoff0 = FP8 ? lds_byte(wr * 64 + fr, fq * 16) : lds_byte(wr * 64 + fr, fq * 8), aoff1 = FP8 ? aoff0 + 16 : aoff0 + 1024;
    const int boff0 = FP8 ? lds_byte(wc * 32 + fr, fq * 16) : lds_byte(wc * 32 + fr, fq * 8), boff1 = FP8 ? boff0 + 16 : boff0 + 1024;
#define PG8_SA(b, h) (((b) * 2 + (h)) * HTB)
#define PG8_SB(b, h) ((4 + (b) * 2 + (h)) * HTB)
#define PG8_STAGE(bufoff, gbase, voff) do { _Pragma("unroll") for (int _i = 0; _i < 2; ++_i) \
        __builtin_amdgcn_global_load_lds((const unsigned*)((const char*)(gbase) + (voff)[_i]), (LAS unsigned*)(lds + (bufoff) + ldsw + _i * 8192), 16, 0, 0); } while (0)
#define PG8_LD2(dst, off0, off1) do { if constexpr (FP8) { dst.v = *(const LAS v8i32*)(lds + (off0)); } else { const u32x4 _lo = *(const LAS u32x4*)(lds + (off0)), _hi = *(const LAS u32x4*)(lds + (off1)); \
        dst.v = (v8i32){(int)_lo.x, (int)_lo.y, (int)_lo.z, (int)_lo.w, (int)_hi.x, (int)_hi.y, (int)_hi.z, (int)_hi.w}; } } while (0)
#define PG8_LDA(dst, b, h) do { if constexpr (FP8) { _Pragma("unroll") for (int m = 0; m < 4; ++m) PG8_INS8(A32, m, *(const LAS v8i32*)(lds + PG8_SA(b, h) + aoff0 + m * 2048)); } \
        else { _Pragma("unroll") for (int m = 0; m < 4; ++m) PG8_LD2(dst[m], PG8_SA(b, h) + aoff0 + m * 2048, PG8_SA(b, h) + aoff1 + m * 2048); } } while (0)
#define PG8_LDB(dst, b, h) do { if constexpr (FP8) { _Pragma("unroll") for (int n = 0; n < 2; ++n) PG8_INS8(B32, 2 * (h) + n, *(const LAS v8i32*)(lds + PG8_SB(b, h) + boff0 + n * 2048)); } \
        else { _Pragma("unroll") for (int n = 0; n < 2; ++n) PG8_LD2(dst[n], PG8_SB(b, h) + boff0 + n * 2048, PG8_SB(b, h) + boff1 + n * 2048); } } while (0)
#define PG8_MMA(ai, bj, At, Bt) do { __builtin_amdgcn_s_setprio(1); _Pragma("unroll") for (int m = 0; m < 4; ++m) _Pragma("unroll") for (int n = 0; n < 2; ++n) { \
        if constexpr (FP8) { const v8i32 _b = PG8_SUB8(B32, 2 * (bj) + n), _a = PG8_SUB8(A32, m); \
            asm volatile("v_mfma_scale_f32_16x16x128_f8f6f4 %0, %1, %2, %0, %3, %3 op_sel_hi:[0,0,0]" : "+v"(acc[ai][bj][m][n]) : "v"(_b), "v"(_a), "v"(sc1)); } \
        else { acc[ai][bj][m][n] = __builtin_amdgcn_mfma_f32_16x16x32_bf16(Bt[n].lo(), At[m].lo(), acc[ai][bj][m][n], 0, 0, 0); acc[ai][bj][m][n] = __builtin_amdgcn_mfma_f32_16x16x32_bf16(Bt[n].hi(), At[m].hi(), acc[ai][bj][m][n], 0, 0, 0); } } \
        __builtin_amdgcn_s_setprio(0); } while (0)
#define PG8_WAIT_V(n) asm volatile("s_waitcnt vmcnt(" #n ")" ::: "memory")
#define PG8_WAIT_L(n) asm volatile("s_waitcnt lgkmcnt(" #n ")" ::: "memory")
#define PG8_BAR __builtin_amdgcn_s_barrier()
#define PG8_SCHED __builtin_amdgcn_sched_barrier(0)
    Unit cur, nxt; int ui = 0;
    if (!S.next(0, cur)) return;
    f32x4 acc[2][2][4][2];
#pragma unroll
    for (int a = 0; a < 2; ++a)
#pragma unroll
        for (int b = 0; b < 2; ++b)
#pragma unroll
            for (int m = 0; m < 4; ++m)
#pragma unroll
                for (int n = 0; n < 2; ++n) acc[a][b][m][n] = (f32x4){0.f, 0.f, 0.f, 0.f};
    struct Frag2 { v8i32 v;
        __device__ __forceinline__ bf16x8 lo() const { const u32x4 t = {(unsigned)v[0], (unsigned)v[1], (unsigned)v[2], (unsigned)v[3]}; return __builtin_bit_cast(bf16x8, t); }
        __device__ __forceinline__ bf16x8 hi() const { const u32x4 t = {(unsigned)v[4], (unsigned)v[5], (unsigned)v[6], (unsigned)v[7]}; return __builtin_bit_cast(bf16x8, t); } };
    Frag2 At[4], B0[2], B1[2];
    typedef int v32i32 __attribute__((ext_vector_type(32)));
    int sc1 = 0x7f7f7f7f; asm volatile("" : "+v"(sc1));
    v32i32 A32, B32;
#define PG8_SUB8(V, i) ((v8i32){V[8 * (i)], V[8 * (i) + 1], V[8 * (i) + 2], V[8 * (i) + 3], V[8 * (i) + 4], V[8 * (i) + 5], V[8 * (i) + 6], V[8 * (i) + 7]})
#define PG8_INS8(V, i, X) do { const v8i32 _x = (X); _Pragma("unroll") for (int _e = 0; _e < 8; ++_e) V[8 * (i) + _e] = _x[_e]; } while (0)
    const char* cA = (const char*)g.A + ((size_t)cur.pm * BM * lda + cur.ak) * ES; const char* cB = (const char*)g.Bt + (size_t)cur.pb * BM * K * ES;
    if constexpr (SP2) {
        PG8_STAGE(PG8_SB(0, 0), cB, voffB); PG8_STAGE(PG8_SB(0, 1), cB + hsB, voffB); PG8_STAGE(PG8_SA(0, 0), cA, voffA); PG8_STAGE(PG8_SA(0, 1), cA + hsA, voffA);
        if (wr == 1) PG8_BAR;
        PG8_WAIT_V(2); PG8_BAR;
        PG8_STAGE(PG8_SB(1, 0), cB + kstep, voffB); PG8_STAGE(PG8_SA(1, 0), cA + kstep, voffA); PG8_STAGE(PG8_SB(1, 1), cB + hsB + kstep, voffB);
        PG8_WAIT_V(6); PG8_BAR;
    } else {
        PG8_STAGE(PG8_SB(0, 0), cB, voffB); PG8_STAGE(PG8_SA(0, 0), cA, voffA); PG8_STAGE(PG8_SB(0, 1), cB + hsB, voffB); PG8_STAGE(PG8_SA(0, 1), cA + hsA, voffA);
        if (wr == 1) PG8_BAR;
        PG8_WAIT_V(4); PG8_BAR;
        PG8_STAGE(PG8_SB(1, 0), cB + kstep, voffB); PG8_STAGE(PG8_SA(1, 0), cA + kstep, voffA); PG8_STAGE(PG8_SB(1, 1), cB + hsB + kstep, voffB);
        PG8_WAIT_V(6); PG8_BAR;
    }
    for (;;) {
        const bool has_next = S.next(ui + 1, nxt);
        const char* nA = has_next ? (const char*)g.A + ((size_t)nxt.pm * BM * lda + nxt.ak) * ES : cA; const char* nB = has_next ? (const char*)g.Bt + (size_t)nxt.pb * BM * K * ES : cB;
#pragma unroll 1
        for (int t = 0; t < nt; t += 2) {
            const bool last = (t == nt - 2);
            const char* a1 = cA + (size_t)(t + 1) * kstep;
            const char* a2 = last ? nA : cA + (size_t)(t + 2) * kstep; const char* b2 = last ? nB : cB + (size_t)(t + 2) * kstep;
            const char* a3 = a2 + kstep; const char* b3 = b2 + kstep;
            if constexpr (SP2) {
            PG8_LDB(B0, 0, 0); PG8_LDB(B1, 0, 1); PG8_SCHED; PG8_LDA(At, 0, 0); PG8_STAGE(PG8_SA(1, 1), a1 + hsA, voffA);
            PG8_WAIT_V(8); PG8_WAIT_L(0); PG8_BAR; PG8_MMA(0, 0, At, B0); PG8_MMA(0, 1, At, B1); PG8_BAR; PG8_SCHED;
            PG8_LDA(At, 0, 1); PG8_STAGE(PG8_SB(0, 0), b2, voffB); PG8_STAGE(PG8_SB(0, 1), b2 + hsB, voffB); PG8_STAGE(PG8_SA(0, 0), a2, voffA);
            PG8_WAIT_V(8); PG8_WAIT_L(0); PG8_BAR; PG8_MMA(1, 0, At, B0); PG8_MMA(1, 1, At, B1); PG8_BAR; PG8_SCHED;
            PG8_LDB(B0, 1, 0); PG8_LDB(B1, 1, 1); PG8_SCHED; PG8_LDA(At, 1, 0); PG8_STAGE(PG8_SA(0, 1), a2 + hsA, voffA);
            PG8_WAIT_V(8); PG8_WAIT_L(0); PG8_BAR; PG8_MMA(0, 0, At, B0); PG8_MMA(0, 1, At, B1); PG8_BAR; PG8_SCHED;
            PG8_LDA(At, 1, 1); PG8_STAGE(PG8_SB(1, 0), b3, voffB); PG8_STAGE(PG8_SB(1, 1), b3 + hsB, voffB); PG8_STAGE(PG8_SA(1, 0), a3, voffA);
            PG8_WAIT_V(8); PG8_WAIT_L(0); PG8_BAR; PG8_MMA(1, 0, At, B0); PG8_MMA(1, 1, At, B1); PG8_BAR; PG8_SCHED;
            } else {
            PG8_LDB(B0, 0, 0); PG8_SCHED; PG8_LDA(At, 0, 0); PG8_STAGE(PG8_SA(1, 1), a1 + hsA, voffA);
            PG8_WAIT_L(8); PG8_BAR; PG8_WAIT_L(0); PG8_MMA(0, 0, At, B0); PG8_BAR; PG8_SCHED;
            PG8_LDB(B1, 0, 1); PG8_STAGE(PG8_SB(0, 0), b2, voffB);
            PG8_BAR; PG8_WAIT_L(0); PG8_MMA(0, 1, At, B1); PG8_BAR;
            PG8_LDA(At, 0, 1); PG8_STAGE(PG8_SA(0, 0), a2, voffA);
            PG8_BAR; PG8_WAIT_L(0); PG8_MMA(1, 0, At, B0); PG8_BAR; PG8_SCHED;
            PG8_STAGE(PG8_SB(0, 1), b2 + hsB, voffB);
            PG8_WAIT_V(6); PG8_BAR; PG8_MMA(1, 1, At, B1); PG8_BAR;
            PG8_LDB(B0, 1, 0); PG8_SCHED; PG8_LDA(At, 1, 0); PG8_STAGE(PG8_SA(0, 1), a2 + hsA, voffA);
            PG8_WAIT_L(8); PG8_BAR; PG8_WAIT_L(0); PG8_MMA(0, 0, At, B0); PG8_BAR; PG8_SCHED;
            PG8_LDB(B1, 1, 1); PG8_STAGE(PG8_SB(1, 0), b3, voffB);
            PG8_BAR; PG8_WAIT_L(0); PG8_MMA(0, 1, At, B1); PG8_BAR;
            PG8_LDA(At, 1, 1); PG8_STAGE(PG8_SA(1, 0), a3, voffA);
            PG8_BAR; PG8_WAIT_L(0); PG8_MMA(1, 0, At, B0); PG8_BAR; PG8_SCHED;
            PG8_STAGE(PG8_SB(1, 1), b3 + hsB, voffB);
            PG8_WAIT_V(6); PG8_BAR; PG8_MMA(1, 1, At, B1); PG8_BAR;
            }
        }
        if constexpr (ALIGN_EPI) { if (wr == 0) PG8_BAR; }
        if constexpr (FP8) asm volatile("s_nop 15\n\ts_nop 15" ::: "memory");
        E(acc, cur, wr, wc, fr, fq);
        if (!has_next) break;
#pragma unroll
        for (int a = 0; a < 2; ++a)
#pragma unroll
            for (int b = 0; b < 2; ++b)
#pragma unroll
                for (int m = 0; m < 4; ++m)
#pragma unroll
                    for (int n = 0; n < 2; ++n) acc[a][b][m][n] = (f32x4){0.f, 0.f, 0.f, 0.f};
        cur = nxt; cA = nA; cB = nB; ++ui;
        if constexpr (ALIGN_EPI) { if (wr == 1) PG8_BAR; }
    }
    PG8_WAIT_V(0);
    if constexpr (!ALIGN_EPI) { if (wr == 0) PG8_BAR; }
    PG8_BAR;
#undef PG8_SA
#undef PG8_SB
#undef PG8_STAGE
#undef PG8_LDA
#undef PG8_LDB
#undef PG8_MMA
#undef PG8_WAIT_V
#undef PG8_WAIT_L
#undef PG8_BAR
#undef PG8_SCHED
#undef PG8_SUB8
#undef PG8_INS8
}

struct DenseOrder {
    int nM, nN, nwg, G, c;
    __device__ __forceinline__ void init(int nM_, int nN_, int G_, int c_) { nM = nM_; nN = nN_; nwg = nM * nN; G = G_; c = c_; }
    __device__ __forceinline__ bool next(int i, Unit& u) const {
        const long L = (long)i * G + c; if (L >= nwg) return false;
        int wgid = (int)L; { const int q = nwg / 8, r = nwg % 8, xcd = wgid % 8, off = wgid / 8; wgid = (xcd < r ? xcd * (q + 1) : r * (q + 1) + (xcd - r) * q) + off; }
        const int nig = 8 * nN, gid = wgid / nig, fm = gid * 8, gsz = (nM - fm) < 8 ? (nM - fm) : 8;
        u.pm = fm + ((wgid % nig) % gsz); u.pn = (wgid % nig) / gsz; u.pb = u.pn; u.ak = 0; return true;
    }
};
struct MoeUpOrder {
    int G, c;
    __device__ __forceinline__ bool next(int i, Unit& u) const {
        const int L = i * G + c; if (L >= 2048) return false;
        const int r = L / 256, cc = L % 256, x = cc % 8, j = cc / 8;
        const int e = 2 * x + (r >> 2); u.pm = e * 8 + (j & 7); u.pn = 4 * (r & 3) + (j >> 3); u.pb = e * 16 + u.pn; u.ak = 0; return true;
    }
};
struct MoeDownOrder {
    int G, c;
    __device__ __forceinline__ bool next(int i, Unit& u) const {
        const int L = i * G + c; if (L >= 512) return false;
        const int r = L / 256, cc = L % 256, x = cc % 8, j = cc / 8;
        const int e = 8 * r + x; u.pm = e * 8 + (j & 7); u.pn = j >> 3; u.pb = e * 4 + u.pn; u.ak = 0; return true;
    }
};
struct PoolOrder {
    int G, c;
    __device__ __forceinline__ bool next(int i, Unit& u) const {
        const int L = i * G + c; if (L >= 256) return false;
        const int x = L % 8, j = L / 8; u.pm = x * 8 + (j & 7); u.pn = j >> 3; u.pb = u.pn; u.ak = u.pn * 256; return true;
    }
};

struct EpiInProj {
    bf16_t* P; float* AB;
    __device__ __forceinline__ void operator()(const f32x4 (&acc)[2][2][4][2], const Unit& u, int wr, int wc, int fr, int fq) const {
        const int row0 = u.pm * BM + wr * 64 + fr;
        if (u.pn < 16) {
            const int col0 = u.pn * BM + wc * 32 + 4 * fq;
#pragma unroll
            for (int ai = 0; ai < 2; ++ai)
#pragma unroll
                for (int m = 0; m < 4; ++m) { bf16_t* rowp = P + (size_t)(row0 + ai * HALF + m * 16) * NP + col0;
#pragma unroll
                    for (int bj = 0; bj < 2; ++bj)
#pragma unroll
                        for (int n = 0; n < 2; ++n) { const f32x4 v = acc[ai][bj][m][n]; u32x2 w; w.x = pk2(v[0], v[1]); w.y = pk2(v[2], v[3]); *(u32x2*)(rowp + bj * HALF + n * 16) = w; } }
        } else if (wc == 0) {
#pragma unroll
            for (int ai = 0; ai < 2; ++ai)
#pragma unroll
                for (int m = 0; m < 4; ++m) { float* rowp = AB + (size_t)(row0 + ai * HALF + m * 16) * 32 + 4 * fq;
#pragma unroll
                    for (int n = 0; n < 2; ++n) *(f32x4*)(rowp + n * 16) = acc[ai][0][m][n]; }
        }
    }
};
struct EpiOutProj {
    const float* X; float* H; const float* gate;
    __device__ __forceinline__ void operator()(const f32x4 (&acc)[2][2][4][2], const Unit& u, int wr, int wc, int fr, int fq) const {
        const int row0 = u.pm * BM + wr * 64 + fr, col0 = u.pn * BM + wc * 32 + 4 * fq;
        const float* gp = gate + (size_t)(u.pm * BM / T) * 6144 + col0;
        f32x4 gv[2][2];
#pragma unroll
        for (int bj = 0; bj < 2; ++bj)
#pragma unroll
            for (int n = 0; n < 2; ++n) gv[bj][n] = *(const f32x4*)(gp + bj * HALF + n * 16);
#pragma unroll
        for (int ai = 0; ai < 2; ++ai)
#pragma unroll
            for (int m = 0; m < 4; ++m) { const size_t off = (size_t)(row0 + ai * HALF + m * 16) * D + col0;
#pragma unroll
                for (int bj = 0; bj < 2; ++bj)
#pragma unroll
                    for (int n = 0; n < 2; ++n) { const f32x4 xv = *(const f32x4*)(X + off + bj * HALF + n * 16); *(f32x4*)(H + off + bj * HALF + n * 16) = xv + gv[bj][n] * acc[ai][bj][m][n]; }
                asm volatile("" ::: "memory"); }
    }
};
struct EpiSwiglu {
    unsigned char* HID;
    __device__ __forceinline__ void operator()(const f32x4 (&acc)[2][2][4][2], const Unit& u, int wr, int wc, int fr, int fq) const {
        asm volatile("" : "+v"(fr), "+v"(fq));
        const int row0 = u.pm * BM + wr * 64 + fr, col0 = u.pn * HALF + wc * 32 + 4 * fq;
#pragma unroll
        for (int ai = 0; ai < 2; ++ai)
#pragma unroll
            for (int m = 0; m < 4; ++m) { unsigned char* rowp = HID + (size_t)(row0 + ai * HALF + m * 16) * DF + col0;
#pragma unroll
                for (int n = 0; n < 2; ++n) { const f32x4 g = acc[ai][0][m][n], up = acc[ai][1][m][n]; float h[4];
#pragma unroll
                    for (int j = 0; j < 4; ++j) h[j] = siluf(g[j] * 0.03125f) * (up[j] * 0.03125f);
                    *(unsigned*)(rowp + n * 16) = pk4_fp8(h[0], h[1], h[2], h[3]); } }
    }
};
struct EpiDown {
    bf16_t* YS; const float* gates;
    __device__ __forceinline__ void operator()(const f32x4 (&acc)[2][2][4][2], const Unit& u, int wr, int wc, int fr, int fq) const {
        asm volatile("" : "+v"(fr), "+v"(fq));
        const int row0 = u.pm * BM + wr * 64 + fr, col0 = u.pn * BM + wc * 32 + 4 * fq;
#pragma unroll
        for (int ai = 0; ai < 2; ++ai)
#pragma unroll
            for (int m = 0; m < 4; ++m) { const int row = row0 + ai * HALF + m * 16; const float gt = gates[row] * 0.03125f; bf16_t* rowp = YS + (size_t)row * D + col0;
#pragma unroll
                for (int bj = 0; bj < 2; ++bj)
#pragma unroll
                    for (int n = 0; n < 2; ++n) { const f32x4 v = acc[ai][bj][m][n] * gt; u32x2 w; w.x = pk2(v[0], v[1]); w.y = pk2(v[2], v[3]); *(u32x2*)(rowp + bj * HALF + n * 16) = w; } }
    }
};
struct EpiPool {
    float* H; const float* gate; const float* scale;
    __device__ __forceinline__ void operator()(const f32x4 (&acc)[2][2][4][2], const Unit& u, int wr, int wc, int fr, int fq) const {
        const int row0 = u.pm * BM + wr * 64 + fr, col0 = u.pn * BM + wc * 32 + 4 * fq;
        const float* gp = gate + (size_t)(u.pm * BM / T) * 6144 + col0;
        f32x4 gv[2][2];
#pragma unroll
        for (int bj = 0; bj < 2; ++bj)
#pragma unroll
            for (int n = 0; n < 2; ++n) gv[bj][n] = *(const f32x4*)(gp + bj * HALF + n * 16) * *(const f32x4*)(scale + col0 + bj * HALF + n * 16);
#pragma unroll
        for (int ai = 0; ai < 2; ++ai)
#pragma unroll
            for (int m = 0; m < 4; ++m) { const size_t off = (size_t)(row0 + ai * HALF + m * 16) * D + col0;
#pragma unroll
                for (int bj = 0; bj < 2; ++bj)
#pragma unroll
                    for (int n = 0; n < 2; ++n) { float* p = H + off + bj * HALF + n * 16; const f32x4 hv = *(const f32x4*)p; *(f32x4*)p = hv + gv[bj][n] * acc[ai][bj][m][n]; }
                asm volatile("" ::: "memory"); }
    }
};
}


#define XB_TMO      128
#define XB_XCNT(j)  (256  + 64 * (j))
#define XB_XSUB(j)  (1280 + 64 * (j))
#define XB_XGEN(j)  (2304 + 64 * (j))
#define XB_TOP      3328
#define XB_TOPGEN   3392
#define XCD_BAR_WORDS 3456
#define XB_SPIN_CAP (1u << 20)
__device__ __forceinline__ unsigned xb_ld(unsigned* p)              { return __hip_atomic_load(p, __ATOMIC_RELAXED, __HIP_MEMORY_SCOPE_AGENT); }
__device__ __forceinline__ unsigned xb_add(unsigned* p, unsigned v) { return __hip_atomic_fetch_add(p, v, __ATOMIC_RELAXED, __HIP_MEMORY_SCOPE_AGENT); }
__device__ __forceinline__ unsigned xb_xcc_id() { return (unsigned)__builtin_amdgcn_s_getreg((3 << 11) | 20) & 0xFu; }
#define XB_SPIN(cond, bar) do { unsigned _sp = 0; while (cond) { __builtin_amdgcn_s_sleep(1); \
    if ((++_sp & 255u) == 0u) { if (xb_ld(&(bar)[XB_TMO])) break; if (_sp > XB_SPIN_CAP) { atomicAdd(&(bar)[XB_TMO], 1u); break; } } } } while (0)
struct XcdBarrier { unsigned* bar; unsigned x; volatile LAS unsigned* st; };
__device__ __forceinline__ XcdBarrier xcd_barrier_post(unsigned* bar, volatile LAS unsigned* st) {
    XcdBarrier b; b.bar = bar; b.x = xb_xcc_id(); b.st = st;
    if (threadIdx.x == 0) (void)xb_add(&bar[XB_XCNT(b.x)], 1u);
    return b;
}
__device__ __forceinline__ void xcd_barrier_complete(unsigned* bar, unsigned x, unsigned& nloc, unsigned& nx) {
    const unsigned G = gridDim.x * gridDim.y * gridDim.z;
    unsigned sum, cnt, mine, sp = 0u;
    for (;;) {
        sum = 0u; cnt = 0u; mine = 0u;
#pragma unroll
        for (unsigned j = 0; j < 16; ++j) { const unsigned c = xb_ld(&bar[XB_XCNT(j)]); sum += c; cnt += (c > 0u) ? 1u : 0u; mine = (j == x) ? c : mine; }
        if (sum == G) break;
        __builtin_amdgcn_s_sleep(1);
        if ((++sp & 255u) == 0u) { if (xb_ld(&bar[XB_TMO])) break; if (sp > XB_SPIN_CAP) { atomicAdd(&bar[XB_TMO], 1u); break; } }
    }
    nloc = mine > 0u ? mine : 1u; nx = cnt > 0u ? cnt : 1u;
}
__device__ __forceinline__ void xcd_barrier(const XcdBarrier& b) {
    asm volatile("s_waitcnt vmcnt(0)" ::: "memory");
    __syncthreads();
    if (threadIdx.x == 0) {
        unsigned* bar = b.bar;
        __builtin_amdgcn_s_waitcnt(0);
        unsigned nloc = b.st[0], nx = b.st[1];
        if (nloc == 0u) { xcd_barrier_complete(bar, b.x, nloc, nx); b.st[0] = nloc; b.st[1] = nx; }
        const unsigned old = xb_add(&bar[XB_XSUB(b.x)], 1u);
        const unsigned gen = old / nloc;
        if (old + 1u == (gen + 1u) * nloc) {
            __builtin_amdgcn_fence(__ATOMIC_RELEASE, "agent");
            asm volatile("s_waitcnt vmcnt(0)" ::: "memory");
            const unsigned og = xb_add(&bar[XB_TOP], 1u);
            const unsigned tg = og / nx;
            if (og + 1u == (tg + 1u) * nx) xb_add(&bar[XB_TOPGEN], 1u);
            else XB_SPIN(xb_ld(&bar[XB_TOPGEN]) == tg, bar);
            __builtin_amdgcn_fence(__ATOMIC_ACQUIRE, "agent");
            xb_add(&bar[XB_XGEN(b.x)], 1u);
            asm volatile("s_waitcnt vmcnt(0)" ::: "memory");
        } else {
            XB_SPIN(xb_ld(&bar[XB_XGEN(b.x)]) == gen, bar);
            __builtin_amdgcn_fence(__ATOMIC_ACQUIRE, "agent");
            asm volatile("s_waitcnt vmcnt(0)" ::: "memory");
        }
    }
    __syncthreads();
}
constexpr int MISC_OFF = LDS_BYTES - 128;

struct Args { const float* in[21]; float* out; unsigned char* ws; int ph_lo, ph_hi; };
enum { I_X = 0, I_C, I_CTX, I_CCTX, I_WMOD, I_BMOD, I_GMIX, I_GFFN, I_WIN, I_CONVW, I_ALOG, I_DTB, I_OGAIN, I_WOUT, I_POOLW, I_POOLS, I_WR, I_WG, I_WU, I_WD, I_FING };

struct Frame {
    LAS unsigned char* lds;
    int tid, lane, wave, G, vcu;
    const float* in[21]; float* out; unsigned char* ws;
};

__device__ __forceinline__ void tr_tile(const float* __restrict__ src, int ld_src, int n_valid, bf16_t* dst_row0, int ld_dst, int k0, LAS unsigned char* scr, int lane, float q8 = 0.f) {
    const int nq = lane & 15, g = lane >> 4;
    f32x4 v[2][8];
    const bool ok = 4 * nq < n_valid;
#pragma unroll
    for (int i1 = 0; i1 < 2; ++i1)
#pragma unroll
        for (int i2 = 0; i2 < 8; ++i2) { const int k = 32 * i1 + 8 * g + i2;
            v[i1][i2] = ok ? *(const f32x4*)(src + (size_t)(k0 + k) * ld_src + 4 * nq) : (f32x4){0.f, 0.f, 0.f, 0.f}; }
#ifdef EMU_FP8
    if (q8 > 0.f) { const float iq = 1.f / q8;
#pragma unroll
        for (int i1 = 0; i1 < 2; ++i1)
#pragma unroll
            for (int i2 = 0; i2 < 8; ++i2)
#pragma unroll
                for (int j = 0; j < 4; ++j) v[i1][i2][j] = rnd_fp8(v[i1][i2][j] * q8) * iq; }
#endif
#pragma unroll
    for (int j = 0; j < 4; ++j)
#pragma unroll
        for (int i1 = 0; i1 < 2; ++i1) {
            u32x4 w; w.x = pk2(v[i1][0][j], v[i1][1][j]); w.y = pk2(v[i1][2][j], v[i1][3][j]); w.z = pk2(v[i1][4][j], v[i1][5][j]); w.w = pk2(v[i1][6][j], v[i1][7][j]);
            const int n = 4 * nq + j, c = 4 * i1 + g;
            *(LAS u32x4*)(scr + n * 128 + ((c ^ (nq & 7)) * 16)) = w; }
    LDS_WAIT();
#pragma unroll
    for (int it = 0; it < 8; ++it) { const int n = (lane >> 3) + 8 * it, c = lane & 7;
        const u32x4 w = *(const LAS u32x4*)(scr + n * 128 + ((c ^ ((n >> 2) & 7)) * 16));
        *(u32x4*)(dst_row0 + (size_t)n * ld_dst + k0 + 8 * c) = w; }
    LDS_WAIT();
}

__device__ __forceinline__ void tr_tile8(const float* __restrict__ src, int ld_src, unsigned char* dst_row0, int ld_dst, int k0, LAS unsigned char* scr, int lane) {
    const int nq = lane & 15, g = lane >> 4;
    f32x4 v[2][8];
#pragma unroll
    for (int i1 = 0; i1 < 2; ++i1)
#pragma unroll
        for (int i2 = 0; i2 < 8; ++i2) { const int k = 32 * i1 + 8 * g + i2; v[i1][i2] = *(const f32x4*)(src + (size_t)(k0 + k) * ld_src + 4 * nq) * 32.f; }
#pragma unroll
    for (int j = 0; j < 4; ++j)
#pragma unroll
        for (int i1 = 0; i1 < 2; ++i1) {
            u32x2 w; w.x = pk4_fp8(v[i1][0][j], v[i1][1][j], v[i1][2][j], v[i1][3][j]); w.y = pk4_fp8(v[i1][4][j], v[i1][5][j], v[i1][6][j], v[i1][7][j]);
            const int n = 4 * nq + j, c = 4 * i1 + g;
            *(LAS u32x2*)(scr + n * 64 + ((((c >> 1) ^ (nq & 3))) << 4) + (c & 1) * 8) = w; }
    LDS_WAIT();
#pragma unroll
    for (int it = 0; it < 4; ++it) { const int n = (lane >> 2) + 16 * it, p = lane & 3;
        const u32x4 w = *(const LAS u32x4*)(scr + n * 64 + ((p ^ ((n >> 2) & 3)) << 4));
        *(u32x4*)(dst_row0 + (size_t)n * ld_dst + k0 + 16 * p) = w; }
    LDS_WAIT();
}

constexpr int TR_SMALL = 16 * 68 + 256 + 64;
__device__ __forceinline__ void tr_small_job(Frame& F, int t, LAS unsigned char* scr) {
    if (t < 1088) { const int nt = t / 16, kt = t % 16; int nv = NPROJ - 64 * nt; nv = nv < 0 ? 0 : (nv > 64 ? 64 : nv);
        tr_tile(F.in[I_WIN] + 64 * nt, NPROJ, nv, (bf16_t*)(F.ws + WS_WIN) + (size_t)64 * nt * D, D, 64 * kt, scr, F.lane); return; }
    t -= 1088;
    if (t < 256) { const int nt = t / 16, kt = t % 16;
        tr_tile(F.in[I_WOUT] + 64 * nt, D, 64, (bf16_t*)(F.ws + WS_WOUT) + (size_t)64 * nt * D, D, 64 * kt, scr, F.lane); return; }
    t -= 256;
    { const int gi = t / 16, nt = (t % 16) / 4, kt = t % 4;
        tr_tile(F.in[I_POOLW] + (size_t)gi * 65536 + 64 * nt, 256, 64, (bf16_t*)(F.ws + WS_POOLW) + (size_t)gi * 65536 + (size_t)64 * nt * 256, 256, 64 * kt, scr, F.lane); }
}
constexpr int TR_MOE = 24576;
__device__ __forceinline__ void tr_moe_job(Frame& F, int l, int t, LAS unsigned char* scr) {
    if (t < 16384) { const int e = t / 1024, r = t % 1024, which = r / 512, r2 = r % 512, nt = r2 / 16, kt = r2 % 16;
        const float* src = F.in[which ? I_WU : I_WG] + (size_t)(l * NE + e) * D * DF + 64 * nt;
        unsigned char* dst = (unsigned char*)(F.ws + WS_WMOE) + ((size_t)e * 4096 + (nt >> 1) * 256 + which * 128 + (nt & 1) * 64) * D;
        tr_tile8(src, DF, dst, D, 64 * kt, scr, F.lane); return; }
    t -= 16384;
    { const int e = t / 512, r = t % 512, nt = r / 32, kt = r % 32;
        const float* src = F.in[I_WD] + (size_t)(l * NE + e) * DF * D + 64 * nt;
        unsigned char* dst = (unsigned char*)(F.ws + WS_W2T) + ((size_t)e * D + 64 * nt) * DF;
        tr_tile8(src, D, dst, DF, 64 * kt, scr, F.lane); }
}

__device__ __forceinline__ void mod_item(Frame& F, int item) {
    LAS float* act = (LAS float*)(F.lds + 65536);
    LAS float* part = (LAS float*)(F.lds + 65536 + 20480);
    const int l = item / 96, cgp = item % 96;
    for (int i = F.tid; i < 5 * D; i += NTHR) { const int r = i >> 10, k = i & 1023; const float x = r < 4 ? F.in[I_C][r * D + k] : F.in[I_CCTX][k]; act[i] = siluf(x); }
    __syncthreads();
    const int j = cgp * 64 + F.lane;
    const float* w = F.in[I_WMOD] + (size_t)l * D * 6144 + j;
    float a0 = 0.f, a1 = 0.f, a2 = 0.f, a3 = 0.f, a4 = 0.f;
    const int kb = F.wave * 128;
#pragma unroll 8
    for (int k = 0; k < 128; ++k) { const float wv = w[(size_t)(kb + k) * 6144];
        a0 += act[kb + k] * wv; a1 += act[D + kb + k] * wv; a2 += act[2 * D + kb + k] * wv; a3 += act[3 * D + kb + k] * wv; a4 += act[4 * D + kb + k] * wv; }
    LAS float* pp = part + F.wave * 320 + F.lane;
    pp[0] = a0; pp[64] = a1; pp[128] = a2; pp[192] = a3; pp[256] = a4;
    __syncthreads();
    if (F.tid < 320) { const int r = F.tid >> 6, ln = F.tid & 63; float s = 0.f;
#pragma unroll
        for (int w8 = 0; w8 < 8; ++w8) s += part[w8 * 320 + r * 64 + ln];
        const int jj = cgp * 64 + ln;
        ((float*)(F.ws + WS_MOD))[(size_t)(l * 5 + r) * 6144 + jj] = s + F.in[I_BMOD][l * 6144 + jj]; }
    __syncthreads();
}

__device__ __forceinline__ void load_row(const float* p, int lane, f32x4 (&v)[4]) {
#pragma unroll
    for (int j = 0; j < 4; ++j) v[j] = ((const f32x4*)p)[lane + 64 * j];
}
__device__ __forceinline__ float row_rstd(const f32x4 (&v)[4]) {
    float s = 0.f;
#pragma unroll
    for (int j = 0; j < 4; ++j) s += (v[j][0] * v[j][0] + v[j][1] * v[j][1]) + (v[j][2] * v[j][2] + v[j][3] * v[j][3]);
    return rsqrtf(wave_sum(s) * (1.f / D) + EPS);
}
__device__ __forceinline__ void norm_mod(const f32x4 (&v)[4], float rstd, const float* g, const float* sh, const float* sc, int lane, f32x4 (&y)[4]) {
#pragma unroll
    for (int j = 0; j < 4; ++j) { const f32x4 gv = ((const f32x4*)g)[lane + 64 * j], shv = ((const f32x4*)sh)[lane + 64 * j], scv = ((const f32x4*)sc)[lane + 64 * j];
        y[j] = v[j] * rstd * gv * (1.f + scv) + shv; }
}
__device__ __forceinline__ void store_row_bf16(bf16_t* p, int lane, const f32x4 (&y)[4]) {
#pragma unroll
    for (int j = 0; j < 4; ++j) { u32x2 w; w.x = pk2(y[j][0], y[j][1]); w.y = pk2(y[j][2], y[j][3]); ((u32x2*)p)[lane + 64 * j] = w; }
}

__device__ __forceinline__ void phase_norm0(Frame& F) {
    const float* MOD = (const float*)(F.ws + WS_MOD);
    bf16_t* U = (bf16_t*)(F.ws + WS_U);
    for (int row = F.vcu * NWAVE + F.wave; row < MA; row += F.G * NWAVE) {
        const float* src; int mr;
        if (row < ML) { src = F.in[I_X] + (size_t)row * D; mr = row / T; } else { src = F.in[I_CTX] + (size_t)(row - ML) * D; mr = 4; }
        f32x4 v[4], y[4]; load_row(src, F.lane, v);
        const float rstd = row_rstd(v);
        const float* m = MOD + (size_t)mr * 6144;
        norm_mod(v, rstd, F.in[I_GMIX], m, m + D, F.lane, y);
        store_row_bf16(U + (size_t)row * D, F.lane, y);
    }
}

__device__ __forceinline__ void chunk_rows(int ci, int& row0, int& t0, int& slen) {
    if (ci < 256) { row0 = ci * 64; t0 = (ci & 63) * 64; slen = T; } else { const int cc = ci - 256; row0 = ML + cc * 64; t0 = (cc & 3) * 64; slen = TC; }
}
__device__ __forceinline__ void phase_conv(Frame& F) {
    const bf16_t* P = (const bf16_t*)(F.ws + WS_P);
    bf16_t* QKV = (bf16_t*)(F.ws + WS_QKV);
    bf16_t* KT = (bf16_t*)(F.ws + WS_KT);
    bf16_t* VT = (bf16_t*)(F.ws + WS_VT);
    LAS unsigned* kts = (LAS unsigned*)(F.lds + F.wave * 16896);
    LAS bf16_t* kts16 = (LAS bf16_t*)kts;
    const int lane = F.lane;
    for (int item = F.vcu * NWAVE + F.wave; item < NCHUNK * 24; item += F.G * NWAVE) {
        const int ci = item / 24, slab = item % 24;
        int row0, t0, slen; chunk_rows(ci, row0, t0, slen);
        const int col = slab * 128 + 2 * lane;
        float w0[5], w1[5];
#pragma unroll
        for (int j = 0; j < 5; ++j) { const f32x2 wv = *(const f32x2*)(F.in[I_CONVW] + (size_t)j * NQKV + col); w0[j] = wv[0]; w1[j] = wv[1]; }
        const bf16_t* src = P + (size_t)row0 * NP + col;
        unsigned rowsv[68];
#pragma unroll
        for (int j = 0; j < 68; ++j) { const int tt = j - 2; rowsv[j] = (t0 + tt >= 0 && t0 + tt < slen) ? *(const unsigned*)(src + (long)tt * NP) : 0u; }
        const int kind = slab >> 3;
#pragma unroll
        for (int tt = 0; tt < 64; ++tt) {
            float y0 = 0.f, y1 = 0.f;
#pragma unroll
            for (int j = 0; j < 5; ++j) { y0 += w0[j] * bflo(rowsv[tt + j]); y1 += w1[j] * bfhi(rowsv[tt + j]); }
            y0 = siluf(y0); y1 = siluf(y1);
            if (kind < 2) { const float ss = wave_sum(y0 * y0 + y1 * y1); float sc = rsqrtf(ss + EPS); if (kind == 0) sc *= 0.08838834764831845f; y0 *= sc; y1 *= sc; }
            const unsigned pk = pk2(y0, y1);
            *(unsigned*)(QKV + (size_t)(row0 + tt) * NQKV + col) = pk;
            if (kind >= 1) { kts16[(2 * lane) * 66 + tt] = (bf16_t)(pk & 0xffffu); kts16[(2 * lane + 1) * 66 + tt] = (bf16_t)(pk >> 16); }
        }
        if (kind >= 1) {
            LDS_WAIT();
            unsigned* dst = (unsigned*)((kind == 1 ? KT : VT) + ((size_t)ci * NH + (slab & 7)) * 128 * 64);
#pragma unroll 8
            for (int it = 0; it < 64; ++it) { const int dk = 2 * it + (lane >> 5), dw = lane & 31; dst[dk * 32 + dw] = kts[dk * 33 + dw]; }
            LDS_WAIT();
        }
    }
}

__device__ __forceinline__ void chunk_gates(Frame& F, int row0, int h, int dir, int lane, float& gc, float& beta, float& gtot) {
    const float* ab = (const float*)(F.ws + WS_AB) + (size_t)(row0 + lane) * 32 + dir * 16 + h;
    const float a = ab[0], bb = ab[8];
    const float g = -__expf(F.in[I_ALOG][dir * NH + h]) * softplusf(a + F.in[I_DTB][dir * NH + h]);
    beta = sigmoidf(bb);
    float s = g;
#pragma unroll
    for (int o = 1; o < 64; o <<= 1) { const float t = __builtin_bit_cast(float, __builtin_amdgcn_ds_bpermute((lane - o) << 2, __builtin_bit_cast(int, s))); if (lane >= o) s += t; }
    gtot = __builtin_bit_cast(float, __builtin_amdgcn_readlane(__builtin_bit_cast(int, s), 63));
    gc = dir ? (gtot - s + g) : s;
}

template <int V> __device__ __forceinline__ void phase_prep(Frame& F) {
    const bf16_t* QKV = (const bf16_t*)(F.ws + WS_QKV);
    LAS float* As = (LAS float*)(F.lds + F.wave * 17408);
    LAS float* gs = (LAS float*)(F.lds + F.wave * 17408 + 16384);
#pragma unroll 1
    for (int item = F.vcu * NWAVE + F.wave; item < NCHUNK * NH * 2; item += F.G * NWAVE) {
        const int ci = item >> 4, h = (item >> 1) & 7, dir = item & 1;
        int row0, t0, slen; chunk_rows(ci, row0, t0, slen);
        asm volatile("" ::: "memory");
        int lane_v; asm volatile("v_mbcnt_lo_u32_b32 %0, -1, 0\n\tv_mbcnt_hi_u32_b32 %0, -1, %0" : "=v"(lane_v));
        const int lane = lane_v, fr = lane & 15, fq = lane >> 4;
        const int d4 = 4 * (lane_v >> 4) - (lane_v & 15);
        const size_t dt = (size_t)(dir * NCHUNK + ci) * NH + h;
        const bf16_t* KTg = (const bf16_t*)(F.ws + WS_KT) + ((size_t)ci * NH + h) * 8192; const bf16_t* VTg = (const bf16_t*)(F.ws + WS_VT) + ((size_t)ci * NH + h) * 8192;
        {
            bf16x8 kf[4][4], qf[4][4];
#pragma unroll
            for (int mt = 0; mt < 4; ++mt)
#pragma unroll
                for (int ks = 0; ks < 4; ++ks) { const bf16_t* rp = QKV + (size_t)(row0 + 16 * mt + fr) * NQKV + h * 128 + 32 * ks + 8 * fq; kf[mt][ks] = *(const bf16x8*)(rp + 1024); qf[mt][ks] = *(const bf16x8*)rp; }
            float gc, beta, gtot; chunk_gates(F, row0, h, dir, lane, gc, beta, gtot);
            gs[lane] = gc; gs[64 + lane] = beta;
            { float* gcb = (float*)(F.ws + WS_GCB) + dt * 128; gcb[lane] = gc; gcb[64 + lane] = beta; }
            LDS_WAIT();
#pragma unroll
            for (int mi = 0; mi < (V == 3 ? 0 : 4); ++mi)
#pragma unroll
                for (int nj = 0; nj < 4; ++nj) {
                    if (dir == 0 ? (mi < nj) : (mi > nj)) continue;
                    f32x4 acc = {0.f, 0.f, 0.f, 0.f};
#pragma unroll
                    for (int ks = 0; ks < 4; ++ks) acc = __builtin_amdgcn_mfma_f32_16x16x32_bf16(kf[mi][ks], kf[nj][ks], acc, 0, 0, 0);
                    const int j = 16 * nj + fr; const float gj = gs[j];
#pragma unroll
                    for (int r = 0; r < 4; ++r) { const int i = 16 * mi + 4 * fq + r; const float gi = gs[i], bi = gs[64 + i];
                        const bool keep = (mi != nj) || (dir == 0 ? (d4 + r > 0) : (d4 + r < 0));
                        const float val = keep ? bi * acc[r] * __expf(gi - gj) : 0.f;
                        const int il = dir ? 63 - i : i, jl = dir ? 63 - j : j;
                        As[il * 64 + jl] = val; }
                }
            bf16_t* AT = (bf16_t*)(F.ws + WS_ATT) + dt * 4096;
#pragma unroll
            for (int mi = 0; mi < (V == 3 ? 0 : 4); ++mi) {
#pragma unroll
                for (int nj = 0; nj < 4; ++nj) {
                    const bool none = dir == 0 ? (mi < nj) : (mi > nj);
                    f32x4 acc = {0.f, 0.f, 0.f, 0.f};
                    if (!none) {
#pragma unroll
                        for (int ks = 0; ks < 4; ++ks) acc = __builtin_amdgcn_mfma_f32_16x16x32_bf16(kf[nj][ks], qf[mi][ks], acc, 0, 0, 0);
                    }
                    const int i = 16 * mi + fr; const float gi = gs[i];
                    float val[4];
#pragma unroll
                    for (int r = 0; r < 4; ++r) { const int j = 16 * nj + 4 * fq + r; const float gj = gs[j];
                        const bool keep = !none && ((mi != nj) || (dir == 0 ? (d4 + r <= 0) : (d4 + r >= 0)));
                        val[r] = keep ? acc[r] * __expf(gi - gj) : 0.f; }
                    u32x2 w; w.x = pk2(val[0], val[1]); w.y = pk2(val[2], val[3]);
                    *(u32x2*)(AT + i * 64 + 16 * nj + 4 * fq) = w;
                }
            }
        }
        bf16x8 ktf[8][2];
#pragma unroll
        for (int m8 = 0; m8 < 8; ++m8)
#pragma unroll
            for (int ks = 0; ks < 2; ++ks) ktf[m8][ks] = *(const bf16x8*)(KTg + (16 * m8 + fr) * 64 + 32 * ks + 8 * fq);
        LDS_WAIT();
        asm volatile("" ::: "memory");
        float t[64];
        const float lanef = (float)lane_v;
#pragma unroll
        for (int i = 0; i < 64; ++i) { float s0 = fmaxf(0.f, 1.f - fabsf(lanef - (float)i)), s1 = 0.f, s2 = 0.f, s3 = 0.f;
            asm volatile("" ::: "memory");
#pragma unroll
            for (int j = 0; j < (V == 1 ? 0 : i); ++j) { if (j == 32) asm volatile("" ::: "memory"); const float av = As[i * 64 + j];
                if ((j & 3) == 0) s0 -= av * t[j]; else if ((j & 3) == 1) s1 -= av * t[j]; else if ((j & 3) == 2) s2 -= av * t[j]; else s3 -= av * t[j]; }
            t[i] = (s0 + s1) + (s2 + s3); }
        bf16x8 vtf[8][2];
#pragma unroll
        for (int m8 = 0; m8 < 8; ++m8)
#pragma unroll
            for (int ks = 0; ks < 2; ++ks) vtf[m8][ks] = *(const bf16x8*)(VTg + (16 * m8 + fr) * 64 + 32 * ks + 8 * fq);
        {
            const int co = dir ? 63 - lane : lane;
            const float bco = gs[64 + co], sW = bco * __expf(gs[co]);
            LDS_WAIT();
            asm volatile("" ::: "memory");
            LAS unsigned char* Tl = (LAS unsigned char*)As;
#pragma unroll
            for (int i = 0; i < 64; ++i) { const int io = dir ? 63 - i : i;
                const int off = io * 128 + ((((co >> 3) ^ ((io >> 1) & 7))) << 4) + (co & 7) * 2;
                *(LAS bf16_t*)(Tl + off) = (bf16_t)f2bf(t[i] * sW); *(LAS bf16_t*)(Tl + 8192 + off) = (bf16_t)f2bf(t[i] * bco); }
            LDS_WAIT();
            asm volatile("" ::: "memory");
            bf16_t* Wg = (bf16_t*)(F.ws + WS_W) + dt * 8192; bf16_t* UTg = (bf16_t*)(F.ws + WS_UT) + dt * 8192;
            bf16x8 tf[4][2];
#pragma unroll
            for (int nt = 0; nt < 4; ++nt)
#pragma unroll
                for (int ks = 0; ks < 2; ++ks) { const int row = 16 * nt + fr, c = 4 * ks + fq; tf[nt][ks] = *(const LAS bf16x8*)(Tl + row * 128 + ((c ^ ((row >> 1) & 7)) << 4)); }
#pragma unroll
            for (int mtd = 0; mtd < (V == 2 ? 0 : 8); ++mtd) {
                const bf16x8 a0 = ktf[mtd][0], a1 = ktf[mtd][1];
#pragma unroll
                for (int nt = 0; nt < 4; ++nt) { f32x4 acc = {0.f, 0.f, 0.f, 0.f};
                    acc = __builtin_amdgcn_mfma_f32_16x16x32_bf16(a0, tf[nt][0], acc, 0, 0, 0); acc = __builtin_amdgcn_mfma_f32_16x16x32_bf16(a1, tf[nt][1], acc, 0, 0, 0);
                    u32x2 w; w.x = pk2(acc[0], acc[1]); w.y = pk2(acc[2], acc[3]);
                    if (V == 4) asm volatile("" :: "v"(w)); else *(u32x2*)(Wg + (16 * nt + fr) * 128 + 16 * mtd + 4 * fq) = w; }
            }
#pragma unroll
            for (int nt = 0; nt < 4; ++nt)
#pragma unroll
                for (int ks = 0; ks < 2; ++ks) { const int row = 16 * nt + fr, c = 4 * ks + fq; tf[nt][ks] = *(const LAS bf16x8*)(Tl + 8192 + row * 128 + ((c ^ ((row >> 1) & 7)) << 4)); }
#pragma unroll
            for (int ntd = 0; ntd < (V == 2 ? 0 : 8); ++ntd) {
                const bf16x8 b0 = vtf[ntd][0], b1 = vtf[ntd][1];
#pragma unroll
                for (int mt = 0; mt < 4; ++mt) { f32x4 acc = {0.f, 0.f, 0.f, 0.f};
                    acc = __builtin_amdgcn_mfma_f32_16x16x32_bf16(tf[mt][0], b0, acc, 0, 0, 0); acc = __builtin_amdgcn_mfma_f32_16x16x32_bf16(tf[mt][1], b1, acc, 0, 0, 0);
                    u32x2 w; w.x = pk2(acc[0], acc[1]); w.y = pk2(acc[2], acc[3]);
                    if (V == 4) asm volatile("" :: "v"(w)); else *(u32x2*)(UTg + (16 * ntd + fr) * 64 + 16 * mt + 4 * fq) = w; }
            }
        }
        LDS_WAIT();
    }
}

constexpr int SC_W = 0, SC_Q = 16384, SC_KT = 32768, SC_AT = 49152, SC_UT = 57344, SC_GC = 65536, SC_SLOT = 65792;
constexpr int SC_ST = 2 * SC_SLOT, ST_ROW = 272, SC_VN = SC_ST + 64 * ST_ROW, RT_ROW = 144, SC_END = SC_VN + 64 * RT_ROW;
static_assert(SC_END <= LDS_BYTES - 128, "scan LDS map");
#define SC_WAIT_V(n) asm volatile("s_waitcnt vmcnt(" #n ")" ::: "memory")
#define SC_BAR() do { asm volatile("s_waitcnt lgkmcnt(0)" ::: "memory"); __builtin_amdgcn_s_barrier(); asm volatile("" ::: "memory"); } while (0)
struct ScanCtx { int b, h, dir, half, mt, np, fr, fq, w, lane; unsigned offW[2], offQ[2], offK[2], offA; };
__device__ __forceinline__ int sc_chunk(const ScanCtx& c, int n) { return n < 4 ? 256 + c.b * 4 + (c.dir ? 3 - n : n) : c.b * 64 + (c.dir ? 67 - n : n - 4); }
__device__ __forceinline__ void sc_dma(Frame& F, const ScanCtx& c, int n, int slotoff) {
    const int ci = sc_chunk(c, n); int row0, t0, sl; chunk_rows(ci, row0, t0, sl);
    const size_t dt = ((size_t)(c.dir * NCHUNK + ci) * NH + c.h);
    const char* gW = (const char*)(F.ws + WS_W) + dt * 16384; const char* gQ = (const char*)(F.ws + WS_QKV) + ((size_t)row0 * NQKV + c.h * 128) * 2;
    const char* gK = (const char*)(F.ws + WS_KT) + ((size_t)ci * NH + c.h) * 16384; const char* gA = (const char*)(F.ws + WS_ATT) + dt * 8192;
    const char* gU = (const char*)(F.ws + WS_UT) + dt * 16384 + c.half * 8192; const char* gG = (const char*)(F.ws + WS_GCB) + dt * 512;
    LAS unsigned char* lds = F.lds + slotoff;
#pragma unroll
    for (int i = 0; i < 2; ++i) {
        __builtin_amdgcn_global_load_lds((const unsigned*)(gW + c.offW[i]), (LAS unsigned*)(lds + SC_W + (2 * c.w + i) * 1024), 16, 0, 0);
        __builtin_amdgcn_global_load_lds((const unsigned*)(gQ + c.offQ[i]), (LAS unsigned*)(lds + SC_Q + (2 * c.w + i) * 1024), 16, 0, 0);
        __builtin_amdgcn_global_load_lds((const unsigned*)(gK + c.offK[i]), (LAS unsigned*)(lds + SC_KT + (2 * c.w + i) * 1024), 16, 0, 0); }
    __builtin_amdgcn_global_load_lds((const unsigned*)(gA + c.offA), (LAS unsigned*)(lds + SC_AT + c.w * 1024), 16, 0, 0);
    __builtin_amdgcn_global_load_lds((const unsigned*)(gU + c.offA), (LAS unsigned*)(lds + SC_UT + c.w * 1024), 16, 0, 0);
    __builtin_amdgcn_global_load_lds((const unsigned*)(gG + c.lane * 4), (LAS unsigned*)(lds + SC_GC), 4, 0, 0);
}
__device__ __forceinline__ void sc_store_o(Frame& F, const ScanCtx& c, int n, const f32x4 (&o)[2]) {
    const int lc = c.dir ? 67 - n : n - 4;
    float* Obase = (float*)(F.ws + WS_O);
#pragma unroll
    for (int u = 0; u < 2; ++u) { float* op_ = Obase + ((size_t)c.dir * ML + (size_t)c.b * T + lc * 64 + 16 * c.mt + 4 * c.fq) * D + c.h * 128 + c.half * 64 + 16 * (2 * c.np + u) + c.fr;
#pragma unroll
        for (int r = 0; r < 4; ++r) op_[(size_t)r * D] = o[u][r]; }
}
__device__ __forceinline__ void phase_scan(Frame& F) {
    const int xcd = F.vcu >> 5, jcu = F.vcu & 31;
    if (F.G != 256 || jcu >= 16) {
        const int cw = (F.G == 256) ? xcd * 16 + (jcu - 16) : F.vcu, ncw = (F.G == 256) ? 128 : F.G;
        LAS unsigned char* scr = F.lds + F.wave * 8192;
        for (int t = cw * NWAVE + F.wave; t < TR_MOE; t += ncw * NWAVE) tr_moe_job(F, 0, t, scr);
        if (F.G == 256) return;
        __syncthreads();
    }
    ScanCtx c;
    c.lane = F.lane; c.fr = c.lane & 15; c.fq = c.lane >> 4; c.w = F.wave; c.mt = c.w >> 1; c.np = c.w & 1;
#pragma unroll
    for (int i = 0; i < 2; ++i) {
        { const int I = 2 * c.w + i, row = 4 * I + (c.lane >> 4), cc = (c.lane & 15) ^ (row & 15); c.offW[i] = (unsigned)(row * 256 + cc * 16); c.offQ[i] = (unsigned)(row * (NQKV * 2) + cc * 16); }
        { const int I = 2 * c.w + i, row = 8 * I + (c.lane >> 3), cc = (c.lane & 7) ^ ((row >> 1) & 7); c.offK[i] = (unsigned)(row * 128 + cc * 16); }
    }
    { const int row = 8 * c.w + (c.lane >> 3), cc = (c.lane & 7) ^ ((row >> 1) & 7); c.offA = (unsigned)(row * 128 + cc * 16); }
    const int lane = c.lane, fr = c.fr, fq = c.fq, mt = c.mt, np = c.np;
    LAS unsigned char* const lds = F.lds;
    const int item0 = (F.G == 256) ? xcd * 16 + jcu : F.vcu, nitem = (F.G == 256) ? 128 : F.G;
    for (int item = item0; item < 128; item += nitem) {
        c.half = item & 1; c.dir = (item >> 1) & 1; c.h = (item >> 2) & 7; c.b = item >> 5;
        for (int i = F.tid; i < 64 * ST_ROW / 4; i += NTHR) ((LAS unsigned*)(lds + SC_ST))[i] = 0u;
        f32x4 Sacc[2][2];
#pragma unroll
        for (int ud = 0; ud < 2; ++ud)
#pragma unroll
            for (int uv = 0; uv < 2; ++uv) Sacc[ud][uv] = (f32x4){0.f, 0.f, 0.f, 0.f};
        f32x4 Oprev[2] = {{0.f, 0.f, 0.f, 0.f}, {0.f, 0.f, 0.f, 0.f}};
        sc_dma(F, c, 0, 0);
        SC_WAIT_V(0);
        SC_BAR();
        sc_dma(F, c, 1, SC_SLOT);
#pragma unroll 1
        for (int n = 0; n < 68; ++n) {
            const bool latent = n >= 4;
            const int so = (n & 1) * SC_SLOT;
            LAS unsigned char* const slot = lds + so;
            LAS unsigned char* const St = lds + SC_ST;
            f32x4 xacc[2], oacc[2];
#pragma unroll
            for (int u = 0; u < 2; ++u) { xacc[u] = (f32x4){0.f, 0.f, 0.f, 0.f}; oacc[u] = (f32x4){0.f, 0.f, 0.f, 0.f}; }
            const int arow = 16 * mt + fr;
#pragma unroll
            for (int ks = 0; ks < 4; ++ks) {
                const int co = (((4 * ks + fq) ^ fr) << 4);
                const bf16x8 aW = *(const LAS bf16x8*)(slot + SC_W + arow * 256 + co), aQ = *(const LAS bf16x8*)(slot + SC_Q + arow * 256 + co);
#pragma unroll
                for (int u = 0; u < 2; ++u) { const bf16x8 bS = *(const LAS bf16x8*)(St + (16 * (2 * np + u) + fr) * ST_ROW + (32 * ks + 8 * fq) * 2);
                    xacc[u] = __builtin_amdgcn_mfma_f32_16x16x32_bf16(aW, bS, xacc[u], 0, 0, 0);
                    oacc[u] = __builtin_amdgcn_mfma_f32_16x16x32_bf16(aQ, bS, oacc[u], 0, 0, 0); } }
            const f32x4 gc4 = *(const LAS f32x4*)(slot + SC_GC + (16 * mt + 4 * fq) * 4);
            const float gtot = *(const LAS float*)(slot + SC_GC + (c.dir ? 0 : 63) * 4);
#pragma unroll
            for (int u = 0; u < 2; ++u) { const int urow = 16 * (2 * np + u) + fr, uc = 2 * mt + (fq >> 1);
              const u32x2 uw = *(const LAS u32x2*)(slot + SC_UT + urow * 128 + ((uc ^ ((urow >> 1) & 7)) << 4) + 8 * (fq & 1));
              u32x2 pw; pw.x = pk2(bflo(uw.x) - xacc[u][0], bfhi(uw.x) - xacc[u][1]); pw.y = pk2(bflo(uw.y) - xacc[u][2], bfhi(uw.y) - xacc[u][3]);
              *(LAS u32x2*)(lds + SC_VN + urow * RT_ROW + (16 * mt + 4 * fq) * 2) = pw; }
            bf16x8 aK[2][2], aA[2];
#pragma unroll
            for (int ks = 0; ks < 2; ++ks) {
                aA[ks] = *(const LAS bf16x8*)(slot + SC_AT + arow * 128 + ((((4 * ks + fq) ^ ((arow >> 1) & 7))) << 4));
                const f32x4 g0 = *(const LAS f32x4*)(slot + SC_GC + (32 * ks + 8 * fq) * 4), g1 = *(const LAS f32x4*)(slot + SC_GC + (32 * ks + 8 * fq + 4) * 4);
                float e[8];
#pragma unroll
                for (int j = 0; j < 4; ++j) { e[j] = __expf(gtot - g0[j]); e[4 + j] = __expf(gtot - g1[j]); }
#pragma unroll
                for (int ud = 0; ud < 2; ++ud) { const int krow = 16 * (2 * mt + ud) + fr;
                    const u32x4 kw = *(const LAS u32x4*)(slot + SC_KT + krow * 128 + ((((4 * ks + fq) ^ ((krow >> 1) & 7))) << 4));
                    u32x4 o; o.x = pk2(bflo(kw.x) * e[0], bfhi(kw.x) * e[1]); o.y = pk2(bflo(kw.y) * e[2], bfhi(kw.y) * e[3]); o.z = pk2(bflo(kw.z) * e[4], bfhi(kw.z) * e[5]); o.w = pk2(bflo(kw.w) * e[6], bfhi(kw.w) * e[7]);
                    aK[ud][ks] = __builtin_bit_cast(bf16x8, o); } }
            SC_BAR();
            if (n - 1 >= 4) sc_store_o(F, c, n - 1, Oprev);
            if (n + 2 < 68) sc_dma(F, c, n + 2, so);
            bf16x8 bV[2][2];
#pragma unroll
            for (int u = 0; u < 2; ++u)
#pragma unroll
                for (int ks = 0; ks < 2; ++ks) bV[u][ks] = *(const LAS bf16x8*)(lds + SC_VN + (16 * (2 * np + u) + fr) * RT_ROW + (32 * ks + 8 * fq) * 2);
            if (latent) {
#pragma unroll
                for (int u = 0; u < 2; ++u) {
#pragma unroll
                    for (int r = 0; r < 4; ++r) oacc[u][r] *= __expf(gc4[r]);
#pragma unroll
                    for (int ks = 0; ks < 2; ++ks) oacc[u] = __builtin_amdgcn_mfma_f32_16x16x32_bf16(aA[ks], bV[u][ks], oacc[u], 0, 0, 0);
                    Oprev[u] = oacc[u];
                }
            }
            const float egt = __expf(gtot);
#pragma unroll
            for (int ud = 0; ud < 2; ++ud)
#pragma unroll
                for (int uv = 0; uv < 2; ++uv) {
                    Sacc[ud][uv] *= egt;
#pragma unroll
                    for (int ks = 0; ks < 2; ++ks) Sacc[ud][uv] = __builtin_amdgcn_mfma_f32_16x16x32_bf16(aK[ud][ks], bV[uv][ks], Sacc[ud][uv], 0, 0, 0);
                    u32x2 pw; pw.x = pk2(Sacc[ud][uv][0], Sacc[ud][uv][1]); pw.y = pk2(Sacc[ud][uv][2], Sacc[ud][uv][3]);
                    *(LAS u32x2*)(St + (16 * (2 * np + uv) + fr) * ST_ROW + (16 * (2 * mt + ud) + 4 * fq) * 2) = pw;
                }
            if (n + 2 < 68) SC_WAIT_V(9); else SC_WAIT_V(0);
            SC_BAR();
        }
        sc_store_o(F, c, 67, Oprev);
        SC_WAIT_V(0);
        SC_BAR();
    }
}

__device__ __forceinline__ void phase_gdn_out(Frame& F) {
    const float* O0 = (const float*)(F.ws + WS_O); const float* O1 = O0 + (size_t)ML * D;
    const bf16_t* P = (const bf16_t*)(F.ws + WS_P);
    bf16_t* ON = (bf16_t*)(F.ws + WS_ON);
    const int lane = F.lane;
    const f32x4 gain = *(const f32x4*)(F.in[I_OGAIN] + ((4 * lane) & 127));
    for (int row = F.vcu * NWAVE + F.wave; row < ML; row += F.G * NWAVE) {
        f32x4 a[4], b[4]; load_row(O0 + (size_t)row * D, lane, a); load_row(O1 + (size_t)row * D, lane, b);
        f32x4 y[4];
#pragma unroll
        for (int j = 0; j < 4; ++j) { const f32x4 o = a[j] + b[j];
            float ss = (o[0] * o[0] + o[1] * o[1]) + (o[2] * o[2] + o[3] * o[3]);
            ss = row16_sum(ss); ss += __shfl_xor(ss, 16);
            const float rs = rsqrtf(ss * (1.f / DH) + EPS);
            const u32x2 zw = ((const u32x2*)(P + (size_t)row * NP + NQKV))[lane + 64 * j];
            const float z0 = bflo(zw.x), z1 = bfhi(zw.x), z2 = bflo(zw.y), z3 = bfhi(zw.y);
            y[j][0] = o[0] * rs * gain[0] * siluf(z0); y[j][1] = o[1] * rs * gain[1] * siluf(z1); y[j][2] = o[2] * rs * gain[2] * siluf(z2); y[j][3] = o[3] * rs * gain[3] * siluf(z3); }
        store_row_bf16(ON + (size_t)row * D, lane, y);
    }
}

__device__ __forceinline__ void phase_moe_pre(Frame& F, int l) {
    const float* MOD = (const float*)(F.ws + WS_MOD) + (size_t)l * 5 * 6144;
    const float* H = (const float*)(F.ws + WS_H);
    bf16_t* U = (bf16_t*)(F.ws + WS_U);
    float* AFF = (float*)(F.ws + WS_AFF);
    LAS float* wr = (LAS float*)F.lds;
    const float* wsrc = F.in[I_WR] + (size_t)l * D * NE;
    for (int i = F.tid; i < D * NE / 4; i += NTHR) { const int c = i >> 2, q = i & 3; *(LAS f32x4*)(wr + c * 16 + 4 * q + (c >> 2) * 4) = ((const f32x4*)wsrc)[i]; }
    __syncthreads();
    const int lane = F.lane;
    for (int row = F.vcu * NWAVE + F.wave; row < ML; row += F.G * NWAVE) {
        const int b = row / T, t = row % T;
        f32x4 v[4], y[4]; load_row(H + (size_t)row * D, lane, v);
        const float rstd = row_rstd(v);
        const float* m = MOD + (size_t)b * 6144;
        norm_mod(v, rstd, F.in[I_GFFN] + l * D, m + 3 * D, m + 4 * D, lane, y);
#pragma unroll
        for (int j = 0; j < 4; ++j) ((unsigned*)((unsigned char*)U + (size_t)row * D))[lane + 64 * j] = pk4_fp8(y[j][0], y[j][1], y[j][2], y[j][3]);
        float lg[16];
#pragma unroll
        for (int e = 0; e < 16; ++e) lg[e] = 0.f;
#pragma unroll
        for (int j = 0; j < 4; ++j) {
            asm volatile("" ::: "memory");
#pragma unroll
            for (int i = 0; i < 4; ++i) { const int c = 4 * lane + 256 * j + i; const float yv = y[j][i];
#pragma unroll
                for (int q = 0; q < 4; ++q) { const f32x4 wv = *(const LAS f32x4*)(wr + c * 16 + 4 * q + (c >> 2) * 4);
                    lg[4 * q] += yv * wv[0]; lg[4 * q + 1] += yv * wv[1]; lg[4 * q + 2] += yv * wv[2]; lg[4 * q + 3] += yv * wv[3]; } } }
        float mx = -1e30f;
#pragma unroll
        for (int e = 0; e < 16; ++e) { lg[e] = wave_sum(lg[e]); mx = fmaxf(mx, lg[e]); }
        float den = 0.f;
#pragma unroll
        for (int e = 0; e < 16; ++e) { lg[e] = __expf(lg[e] - mx); den += lg[e]; }
        const float inv = 1.f / den;
        float mine = 0.f;
#pragma unroll
        for (int e = 0; e < 16; ++e) mine = (lane == e) ? lg[e] * inv : mine;
        if (lane < 16) AFF[((size_t)b * NE + lane) * T + t] = mine;
    }
    __syncthreads();
}

__device__ __forceinline__ void phase_topk(Frame& F) {
    LAS unsigned* cnt = (LAS unsigned*)F.lds;
    const float* AFF = (const float*)(F.ws + WS_AFF);
    int* SLOT = (int*)(F.ws + WS_SLOT); int* IDX = (int*)(F.ws + WS_IDX); float* GATE = (float*)(F.ws + WS_GATE);
    for (int item = F.vcu; item < NB * NE; item += F.G) {
        const int b = item / NE, e = item % NE;
        unsigned key[8];
        { const u32x4* p = (const u32x4*)(AFF + (size_t)item * T + F.tid * 8); const u32x4 k0 = p[0], k1 = p[1];
          key[0] = k0.x; key[1] = k0.y; key[2] = k0.z; key[3] = k0.w; key[4] = k1.x; key[5] = k1.y; key[6] = k1.z; key[7] = k1.w; }
        unsigned thr = 0u;
        int par = 0;
        for (int bit = 30; bit >= 0; --bit) {
            const unsigned cand = thr | (1u << bit);
            int c = 0;
#pragma unroll
            for (int i = 0; i < 8; ++i) c += (key[i] >= cand) ? 1 : 0;
#pragma unroll
            for (int o = 1; o < 64; o <<= 1) c += __shfl_xor(c, o);
            if (F.lane == 0) cnt[par * 8 + F.wave] = (unsigned)c;
            __syncthreads();
            unsigned tot = 0;
#pragma unroll
            for (int w8 = 0; w8 < 8; ++w8) tot += cnt[par * 8 + w8];
            if (tot >= (unsigned)CAP) thr = cand;
            par ^= 1;
        }
        __syncthreads();
        int cg_ = 0, ce_ = 0;
#pragma unroll
        for (int i = 0; i < 8; ++i) { cg_ += key[i] > thr; ce_ += key[i] == thr; }
        unsigned pk = (unsigned)cg_ | ((unsigned)ce_ << 16), inc = pk;
#pragma unroll
        for (int o = 1; o < 64; o <<= 1) { const unsigned t = __shfl_up(inc, o); if (F.lane >= o) inc += t; }
        LAS unsigned* wtot = cnt + 64;
        if (F.lane == 63) wtot[F.wave] = inc;
        __syncthreads();
        unsigned base = 0, total = 0;
#pragma unroll
        for (int w8 = 0; w8 < 8; ++w8) { const unsigned v = wtot[w8]; if (w8 < F.wave) base += v; total += v; }
        const unsigned excl = base + inc - pk;
        int gt_before = excl & 0xffffu, eq_before = excl >> 16;
        const int need_eq = CAP - (int)(total & 0xffffu);
#pragma unroll
        for (int i = 0; i < 8; ++i) {
            const int t = F.tid * 8 + i;
            const bool isg = key[i] > thr, ise = key[i] == thr;
            const bool sel = isg || (ise && eq_before < need_eq);
            const int slot = gt_before + (eq_before < need_eq ? eq_before : need_eq);
            SLOT[(size_t)item * T + t] = sel ? slot : -1;
            if (sel) { IDX[item * CAP + slot] = t; GATE[(size_t)e * 2048 + b * CAP + slot] = __uint_as_float(key[i]); }
            gt_before += isg; eq_before += ise;
        }
        __syncthreads();
    }
}

__device__ __forceinline__ void phase_gather(Frame& F) {
    const unsigned char* U = (const unsigned char*)(F.ws + WS_U); unsigned char* XS = (unsigned char*)(F.ws + WS_XS); const int* IDX = (const int*)(F.ws + WS_IDX);
    for (int r = F.vcu * NWAVE + F.wave; r < MX; r += F.G * NWAVE) {
        const int e = r / 2048, b = (r % 2048) / CAP, s = r % CAP;
        const int t = IDX[(b * NE + e) * CAP + s];
        ((u32x4*)(XS + (size_t)r * D))[F.lane] = ((const u32x4*)(U + ((size_t)b * T + t) * D))[F.lane];
    }
}

__device__ __forceinline__ void phase_combine(Frame& F, int l) {
    const float* MOD = (const float*)(F.ws + WS_MOD);
    float* H = (float*)(F.ws + WS_H); const bf16_t* YS = (const bf16_t*)(F.ws + WS_YS); const int* SLOT = (const int*)(F.ws + WS_SLOT);
    bf16_t* U = (bf16_t*)(F.ws + WS_U);
    const int lane = F.lane;
    for (int row = F.vcu * NWAVE + F.wave; row < ML; row += F.G * NWAVE) {
        const int b = row / T, t = row % T;
        f32x4 v[4]; load_row(H + (size_t)row * D, lane, v);
        const int myslot = lane < NE ? SLOT[((size_t)b * NE + lane) * T + t] : -1;
        f32x4 acc[4];
#pragma unroll
        for (int j = 0; j < 4; ++j) acc[j] = (f32x4){0.f, 0.f, 0.f, 0.f};
        for (int e = 0; e < NE; ++e) { const int sl = __shfl(myslot, e);
            if (sl >= 0) { const u32x2* yp = (const u32x2*)(YS + ((size_t)e * 2048 + b * CAP + sl) * D);
#pragma unroll
                for (int j = 0; j < 4; ++j) { const u32x2 w = yp[lane + 64 * j]; acc[j][0] += bflo(w.x); acc[j][1] += bfhi(w.x); acc[j][2] += bflo(w.y); acc[j][3] += bfhi(w.y); } } }
        const float* gtf = MOD + ((size_t)l * 5 + b) * 6144 + 5 * D;
#pragma unroll
        for (int j = 0; j < 4; ++j) v[j] += ((const f32x4*)gtf)[lane + 64 * j] * acc[j];
        const float rstd = row_rstd(v);
        if (l == 0) {
#pragma unroll
            for (int j = 0; j < 4; ++j) ((f32x4*)(H + (size_t)row * D))[lane + 64 * j] = v[j];
            const float* m = MOD + ((size_t)5 + b) * 6144; f32x4 y[4];
            norm_mod(v, rstd, F.in[I_GMIX] + D, m, m + D, lane, y);
            store_row_bf16(U + (size_t)row * D, lane, y);
        } else {
#pragma unroll
            for (int j = 0; j < 4; ++j) ((f32x4*)(F.out + (size_t)row * D))[lane + 64 * j] = v[j] * rstd * ((const f32x4*)F.in[I_FING])[lane + 64 * j];
        }
    }
}

__device__ __forceinline__ void phase_pool(Frame& F) {
    const bf16_t* U = (const bf16_t*)(F.ws + WS_U); bf16_t* PD = (bf16_t*)(F.ws + WS_ON);
    LAS float* Vs = (LAS float*)F.lds;
    const int cp = F.tid & 127, cgp = F.tid >> 7;
    for (int item = F.vcu; item < 1024; item += F.G) {
        const int gi = item >> 8, b = (item >> 6) & 3, r = item & 63;
        const int w = 2 << gi, lo = w >> 1, hi = w - lo;
        const int r_lo = r - lo < 0 ? 0 : r - lo, r_hi = r + hi > 64 ? 64 : r + hi;
        float s0[16], s1[16]; unsigned self[16];
#pragma unroll
        for (int i = 0; i < 16; ++i) { s0[i] = 0.f; s1[i] = 0.f; }
        const bf16_t* base = U + ((size_t)b * T + cgp * 16) * D + gi * 256 + 2 * cp;
        for (int rr = r_lo; rr < r_hi; ++rr) {
#pragma unroll
            for (int i = 0; i < 16; ++i) { const unsigned x = *(const unsigned*)(base + ((size_t)rr * 64 + i) * D); s0[i] += bflo(x); s1[i] += bfhi(x); }
        }
#pragma unroll
        for (int i = 0; i < 16; ++i) { self[i] = *(const unsigned*)(base + ((size_t)r * 64 + i) * D); *(LAS f32x2*)(Vs + (cgp * 16 + i) * 256 + 2 * cp) = (f32x2){s0[i], s1[i]}; }
        __syncthreads();
        const float inv_r = 1.f / (float)(r_hi - r_lo);
#pragma unroll
        for (int i = 0; i < 16; ++i) { const int c = cgp * 16 + i;
            const int c_lo = c - lo < 0 ? 0 : c - lo, c_hi = c + hi > 64 ? 64 : c + hi;
            float a0 = 0.f, a1 = 0.f;
            for (int cc = c_lo; cc < c_hi; ++cc) { const f32x2 x = *(const LAS f32x2*)(Vs + cc * 256 + 2 * cp); a0 += x[0]; a1 += x[1]; }
            const float sc = inv_r / (float)(c_hi - c_lo);
            *(unsigned*)(PD + ((size_t)b * T + r * 64 + c) * D + gi * 256 + 2 * cp) = pk2(a0 * sc - bflo(self[i]), a1 * sc - bfhi(self[i])); }
        __syncthreads();
    }
}

constexpr int NPHASE = 22;
__global__ void __launch_bounds__(NTHR, 2) mega_fwd(Args args) {
    extern __shared__ __attribute__((aligned(16))) unsigned char lds_raw[];
    cg::grid_group grid = cg::this_grid();
    Frame F;
    F.lds = (LAS unsigned char*)lds_raw;
    F.tid = threadIdx.x; F.lane = F.tid & 63; F.wave = __builtin_amdgcn_readfirstlane(F.tid >> 6);
    F.G = gridDim.x; { const int bx = blockIdx.x; F.vcu = (F.G % 8 == 0) ? (bx % 8) * (F.G / 8) + bx / 8 : bx; }
#pragma unroll
    for (int i = 0; i < 21; ++i) F.in[i] = args.in[i];
    F.out = args.out; F.ws = args.ws;
    const int lo = args.ph_lo, hi = args.ph_hi;
    if (F.tid < 32) ((LAS unsigned*)(F.lds + MISC_OFF))[F.tid] = 0u;
    __syncthreads();
    XcdBarrier bar = xcd_barrier_post((unsigned*)(F.ws + WS_CTL) + 4096, (volatile LAS unsigned*)(F.lds + MISC_OFF));
#ifndef PHMASK
#define PHMASK 0x3fffff
#endif
#define IN(k) ((((PHMASK) >> (k)) & 1) && lo <= (k) && (k) < hi)
#define SEAM(k) do { if (IN(k) && IN((k) + 1)) { if ((k) == 0) grid.sync(); else xcd_barrier(bar); } F.tid = threadIdx.x; asm volatile("" : "+v"(F.tid)); F.lane = F.tid & 63; F.wave = __builtin_amdgcn_readfirstlane(F.tid >> 6); } while (0)
    const int c = (int)blockIdx.x;

#ifndef REP_PHASE
#define REP_PHASE (-1)
#endif
#ifndef REP_N
#define REP_N 2
#endif
#define RUN(k, ...) for (int _r = 0; _r < ((k) == REP_PHASE ? 1 + REP_N : 1); ++_r) { if (IN(k)) { __VA_ARGS__ } SEAM(k); }
    RUN(0, {
        if (F.vcu < 192) mod_item(F, F.vcu);
        LAS unsigned char* scr = F.lds + F.wave * 8192;
        const int gw = F.vcu * NWAVE + F.wave, NGW = F.G * NWAVE;
        for (int t = gw; t < TR_SMALL; t += NGW) tr_small_job(F, t, scr);
    })
    RUN(1, phase_norm0(F);)
    RUN(2, {
        pg8::Gemm g{(const bf16_t*)(F.ws + WS_U), (const bf16_t*)(F.ws + WS_WIN), D, D};
        pg8::DenseOrder S; S.init(MA / 256, NPROJ_PAD / 256, F.G, c);
        pg8::EpiInProj E{(bf16_t*)(F.ws + WS_P), (float*)(F.ws + WS_AB)};
        pg8::gemm_phase(F.lds, g, S, E);
    })
    RUN(3, phase_conv(F);)
#ifndef PREPV
    RUN(4, phase_prep<0>(F);)
#else
    RUN(4, phase_prep<PREPV>(F); __syncthreads(); phase_prep<PREPV>(F); __syncthreads(); phase_prep<0>(F);)
#endif
    RUN(5, phase_scan(F);)
    RUN(6, phase_gdn_out(F);)
    RUN(7, {
        pg8::Gemm g{(const bf16_t*)(F.ws + WS_ON), (const bf16_t*)(F.ws + WS_WOUT), D, D};
        pg8::DenseOrder S; S.init(ML / 256, D / 256, F.G, c);
        pg8::EpiOutProj E{F.in[I_X], (float*)(F.ws + WS_H), (const float*)(F.ws + WS_MOD) + 2 * D};
        pg8::gemm_phase(F.lds, g, S, E);
    })
#pragma unroll
    for (int l = 0; l < 2; ++l) {
        if (l == 1) {
            RUN(14, phase_pool(F);)
            RUN(15, {
                pg8::Gemm g{(const bf16_t*)(F.ws + WS_ON), (const bf16_t*)(F.ws + WS_POOLW), D, 256};
                pg8::PoolOrder S{F.G, c};
                pg8::EpiPool E{(float*)(F.ws + WS_H), (const float*)(F.ws + WS_MOD) + 5 * 6144 + 2 * D, F.in[I_POOLS]};
                pg8::gemm_phase(F.lds, g, S, E);
            })
        }
        const int p0 = l == 0 ? 8 : 16;
        RUN(p0, {
            phase_moe_pre(F, l);
            if (l == 1) { LAS unsigned char* scr = F.lds + 73728 + F.wave * 8192; const int gw = F.vcu * NWAVE + F.wave, NGW = F.G * NWAVE;
                for (int t = gw; t < TR_MOE; t += NGW) tr_moe_job(F, 1, t, scr); }
        })
        RUN(p0 + 1, phase_topk(F);)
        RUN(p0 + 2, phase_gather(F);)
        RUN(p0 + 3, {
            pg8::Gemm g{(const bf16_t*)(F.ws + WS_XS), (const bf16_t*)(F.ws + WS_WMOE), D, D};
            pg8::MoeUpOrder S{F.G, c};
            pg8::EpiSwiglu E{(unsigned char*)(F.ws + WS_HID)};
            pg8::gemm_phase<pg8::EpiSwiglu, pg8::MoeUpOrder, true>(F.lds, g, S, E);
        })
        RUN(p0 + 4, {
            pg8::Gemm g{(const bf16_t*)(F.ws + WS_HID), (const bf16_t*)(F.ws + WS_W2T), DF, DF};
            pg8::MoeDownOrder S{F.G, c};
            pg8::EpiDown E{(bf16_t*)(F.ws + WS_YS), (const float*)(F.ws + WS_GATE)};
            pg8::gemm_phase<pg8::EpiDown, pg8::MoeDownOrder, true>(F.lds, g, S, E);
        })
        RUN(p0 + 5, phase_combine(F, l);)
    }
#undef IN
#undef SEAM
#undef RUN
}

extern "C" void kernel_launch(void* const* d_in, const int* in_sizes, int n_in, void* d_out, int out_size, void* d_ws, size_t ws_size, hipStream_t stream) {
    static int grid = 0;
    if (grid == 0) {
        if (n_in != 21 || ws_size < WS_END) { fprintf(stderr, "kernel_launch: unexpected inputs (n_in %d, ws %zu)\n", n_in, ws_size); grid = -1; return; }
        int dev = 0, cus = 0, per_cu = 0;
        hipGetDevice(&dev);
        hipDeviceGetAttribute(&cus, hipDeviceAttributeMultiprocessorCount, dev);
        hipFuncSetAttribute((const void*)mega_fwd, hipFuncAttributeMaxDynamicSharedMemorySize, LDS_BYTES);
        hipOccupancyMaxActiveBlocksPerMultiprocessor(&per_cu, (const void*)mega_fwd, NTHR, LDS_BYTES);
        if (per_cu < 1) { fprintf(stderr, "kernel_launch: occupancy query says %d blocks per CU\n", per_cu); per_cu = 1; }
        grid = cus;
        (void)hipGetLastError();
    }
    if (grid < 0) return;
    hipMemsetAsync((char*)d_ws + WS_CTL, 0, 1 * MiB, stream);
    Args a{};
    for (int i = 0; i < 21; ++i) a.in[i] = (const float*)d_in[i];
    a.out = (float*)d_out; a.ws = (unsigned char*)d_ws;
#if MK_N_LAUNCHES == 1
    a.ph_lo = 0; a.ph_hi = NPHASE;
    void* params[] = {&a};
    hipError_t e = hipLaunchCooperativeKernel((const void*)mega_fwd, dim3(grid), dim3(NTHR), params, LDS_BYTES, stream);
    if (e != hipSuccess) fprintf(stderr, "cooperative launch failed: %s (grid %d)\n", hipGetErrorString(e), grid);
#else
    for (int p = 0; p < NPHASE; ++p) {
        a.ph_lo = p; a.ph_hi = p + 1;
        void* params[] = {&a};
        hipError_t e = hipLaunchCooperativeKernel((const void*)mega_fwd, dim3(grid), dim3(NTHR), params, LDS_BYTES, stream);
        if (e != hipSuccess) { fprintf(stderr, "launch %d failed: %s (grid %d)\n", p, hipGetErrorString(e), grid); break; }
    }
#endif
}
```

```cpp
#include <hip/hip_runtime.h>
#include <hip/hip_cooperative_groups.h>
#include <cstdio>
namespace cg = cooperative_groups;

#ifndef MK_N_LAUNCHES
#define MK_N_LAUNCHES 1
#endif

#define LAS __attribute__((address_space(3)))
typedef unsigned short bf16_t;
typedef short bf16x8 __attribute__((ext_vector_type(8)));
typedef float f32x4 __attribute__((ext_vector_type(4)));
typedef float f32x2 __attribute__((ext_vector_type(2)));
typedef unsigned u32x4 __attribute__((ext_vector_type(4)));
typedef unsigned u32x2 __attribute__((ext_vector_type(2)));

constexpr int NB = 4, T = 4096, D = 1024, TC = 256, NH = 8, DH = 128, NE = 16, CAP = 512, DF = 2048;
constexpr int ML = NB * T;
constexpr int MC = NB * TC;
constexpr int MA = ML + MC;
constexpr int NPROJ = 4128, NPROJ_PAD = 4352, NQKV = 3072, NP = 4096;
constexpr int NCHUNK = MA / 64;
constexpr int MX = NB * NE * CAP;
constexpr float EPS = 1e-6f;
constexpr int NTHR = 512, NWAVE = 8;

constexpr size_t MiB = 1u << 20;
constexpr size_t WS_CTL = 0;
constexpr size_t WS_MOD = 1 * MiB;
constexpr size_t WS_AB = 2 * MiB;
constexpr size_t WS_GCB = 5 * MiB;
constexpr size_t WS_AFF = 5 * MiB;
constexpr size_t WS_SLOT = 6 * MiB;
constexpr size_t WS_IDX = 7 * MiB;
constexpr size_t WS_GATE = 7 * MiB + 256 * 1024;
constexpr size_t WS_WIN = 8 * MiB;
constexpr size_t WS_WOUT = 17 * MiB;
constexpr size_t WS_POOLW = 19 * MiB;
constexpr size_t WS_WMOE = 20 * MiB;
constexpr size_t WS_W2T = WS_WMOE + 64 * MiB;
constexpr size_t WMOE_LAYER = 96 * MiB;
constexpr size_t WS_H = 212 * MiB;
constexpr size_t WS_U = 276 * MiB;
constexpr size_t WS_ON = 310 * MiB;
constexpr size_t WS_G = 342 * MiB;
constexpr size_t WS_P = WS_G;
constexpr size_t WS_QKV = WS_G + 136 * MiB;
constexpr size_t WS_KT = WS_G + 238 * MiB;
constexpr size_t WS_VT = WS_G + 272 * MiB;
constexpr size_t WS_W = WS_G + 306 * MiB;
constexpr size_t WS_UT = WS_G + 374 * MiB;
constexpr size_t WS_ATT = WS_G + 442 * MiB;
constexpr size_t WS_O = WS_G + 476 * MiB;
constexpr size_t WS_XS = WS_G;
constexpr size_t WS_HID = WS_G + 64 * MiB;
constexpr size_t WS_YS = WS_G + 192 * MiB;
constexpr size_t WS_END = WS_G + 604 * MiB;

constexpr int LDS_BYTES = 163840;

typedef __bf16 bf16v2 __attribute__((ext_vector_type(2)));
__device__ __forceinline__ unsigned pk2(float lo, float hi) { const f32x2 v = {lo, hi}; return __builtin_bit_cast(unsigned, __builtin_convertvector(v, bf16v2)); }
__device__ __forceinline__ unsigned f2bf(float f) { return pk2(f, 0.f) & 0xffffu; }
__device__ __forceinline__ float bflo(unsigned w) { return __uint_as_float(w << 16); }
__device__ __forceinline__ float bfhi(unsigned w) { return __uint_as_float(w & 0xffff0000u); }
__device__ __forceinline__ float bf1(bf16_t b) { return __uint_as_float(((unsigned)b) << 16); }
#define DPP_ADD(v, ctrl) ((v) + __builtin_bit_cast(float, __builtin_amdgcn_update_dpp(0, __builtin_bit_cast(int, (v)), (ctrl), 0xf, 0xf, true)))
__device__ __forceinline__ float row16_sum(float v) {
    v = DPP_ADD(v, 0xB1); v = DPP_ADD(v, 0x4E); v = DPP_ADD(v, 0x141); v = DPP_ADD(v, 0x140); return v;
}
__device__ __forceinline__ float wave_sum(float v) { v = row16_sum(v); v += __shfl_xor(v, 16); v += __shfl_xor(v, 32); return v; }
__device__ __forceinline__ float siluf(float x) { return x * __builtin_amdgcn_rcpf(1.f + __expf(-x)); }
__device__ __forceinline__ float sigmoidf(float x) { return __builtin_amdgcn_rcpf(1.f + __expf(-x)); }
__device__ __forceinline__ float softplusf(float x) { return fmaxf(x, 0.f) + log1pf(__expf(-fabsf(x))); }
__device__ __forceinline__ float rnd_fp8(float x) { const int p = __builtin_amdgcn_cvt_pk_fp8_f32(x, x, 0, false); return __builtin_amdgcn_cvt_f32_fp8(p, 0); }
__device__ __forceinline__ unsigned pk4_fp8(float a, float b, float c, float d) { int p = __builtin_amdgcn_cvt_pk_fp8_f32(a, b, 0, false); p = __builtin_amdgcn_cvt_pk_fp8_f32(c, d, p, true); return (unsigned)p; }
#define LDS_WAIT() asm volatile("s_waitcnt lgkmcnt(0)" ::: "memory")

namespace pg8 {
constexpr int BM = 256, BK = 64, HALF = 128, HTB = HALF * BK * 2, STAGE_BYTES = 8 * HTB;
__device__ __forceinline__ int lds_byte(int r, int c) { const int st = (r >> 4) * 2 + (c >> 5), rr = r & 15, cc = c & 31, ob = rr * 64 + cc * 2; return st * 1024 + (ob ^ (((ob >> 9) & 1) << 5)); }
__device__ __forceinline__ void stage_rc(int b, int& R, int& C) { const int st = b / 1024, sb = b % 1024, swz = sb ^ (((sb >> 9) & 1) << 5); R = (st >> 1) * 16 + swz / 64; C = (st & 1) * 32 + (swz % 64) / 2; }

struct Unit { int pm, pn, pb, ak; };
struct Gemm { const bf16_t* A; const bf16_t* Bt; int lda, K; };

#ifndef PG8_SP2
#define PG8_SP2 true
#endif
#ifndef PG8_ALIGN
#define PG8_ALIGN true
#endif
typedef int v8i32 __attribute__((ext_vector_type(8)));
__device__ __forceinline__ v8i32 cat8(const bf16x8 lo, const bf16x8 hi) { const u32x4 a = __builtin_bit_cast(u32x4, lo), b = __builtin_bit_cast(u32x4, hi); return (v8i32){(int)a.x, (int)a.y, (int)a.z, (int)a.w, (int)b.x, (int)b.y, (int)b.z, (int)b.w}; }
template <class Epi, class Sched, bool FP8 = false, bool ALIGN_EPI = PG8_ALIGN, bool SP2 = PG8_SP2>
__device__ __forceinline__ void gemm_phase(LAS unsigned char* lds, const Gemm g, const Sched& S, const Epi& E) {
    constexpr int ES = FP8 ? 1 : 2;
    int tid = threadIdx.x; asm volatile("" : "+v"(tid));
    const int wid = __builtin_amdgcn_readfirstlane(tid >> 6), lane = tid & 63, wr = wid >> 2, wc = wid & 3, fr = lane & 15, fq = lane >> 4;
    int K = g.K, lda = g.lda; asm volatile("" : "+s"(K), "+s"(lda));
    const int nt = K * ES / (BK * 2);
    unsigned voffA[2], voffB[2];
#pragma unroll
    for (int i = 0; i < 2; ++i) { int R, C; stage_rc(tid * 16 + i * 8192, R, C); voffA[i] = (unsigned)(R * lda * ES + C * 2); voffB[i] = (unsigned)(R * K * ES + C * 2); }
    const size_t kstep = (size_t)(BK * 2);
    const size_t hsA = (size_t)HALF * lda * ES, hsB = (size_t)HALF * K * ES;
    const unsigned ldsw = (unsigned)wid * 1024u;
    const int aoff0 = FP8 ? lds_byte(wr * 64 + fr, fq * 16) : lds_byte(wr * 64 + fr, fq * 8), aoff1 = FP8 ? aoff0 + 16 : aoff0 + 1024;
    const int boff0 = FP8 ? lds_byte(wc * 32 + fr, fq * 16) : lds_byte(wc * 32 + fr, fq * 8), boff1 = FP8 ? boff0 + 16 : boff0 + 1024;
#define PG8_SA(b, h) (((b) * 2 + (h)) * HTB)
#define PG8_SB(b, h) ((4 + (b) * 2 + (h)) * HTB)
#define PG8_STAGE(bufoff, gbase, voff) do { _Pragma("unroll") for (int _i = 0; _i < 2; ++_i) \
        __builtin_amdgcn_global_load_lds((const unsigned*)((const char*)(gbase) + (voff)[_i]), (LAS unsigned*)(lds + (bufoff) + ldsw + _i * 8192), 16, 0, 0); } while (0)
#define PG8_LD2(dst, off0, off1) do { if constexpr (FP8) { dst.v = *(const LAS v8i32*)(lds + (off0)); } else { const u32x4 _lo = *(const LAS u32x4*)(lds + (off0)), _hi = *(const LAS u32x4*)(lds + (off1)); \
        dst.v = (v8i32){(int)_lo.x, (int)_lo.y, (int)_lo.z, (int)_lo.w, (int)_hi.x, (int)_hi.y, (int)_hi.z, (int)_hi.w}; } } while (0)
#define PG8_LDA(dst, b, h) do { if constexpr (FP8) { _Pragma("unroll") for (int m = 0; m < 4; ++m) PG8_INS8(A32, m, *(const LAS v8i32*)(lds + PG8_SA(b, h) + aoff0 + m * 2048)); } \
        else { _Pragma("unroll") for (int m = 0; m < 4; ++m) PG8_LD2(dst[m], PG8_SA(b, h) + aoff0 + m * 2048, PG8_SA(b, h) + aoff1 + m * 2048); } } while (0)
#define PG8_LDB(dst, b, h) do { if constexpr (FP8) { _Pragma("unroll") for (int n = 0; n < 2; ++n) PG8_INS8(B32, 2 * (h) + n, *(const LAS v8i32*)(lds + PG8_SB(b, h) + boff0 + n * 2048)); } \
        else { _Pragma("unroll") for (int n = 0; n < 2; ++n) PG8_LD2(dst[n], PG8_SB(b, h) + boff0 + n * 2048, PG8_SB(b, h) + boff1 + n * 2048); } } while (0)
#define PG8_MMA(ai, bj, At, Bt) do { __builtin_amdgcn_s_setprio(1); _Pragma("unroll") for (int m = 0; m < 4; ++m) _Pragma("unroll") for (int n = 0; n < 2; ++n) { \
        if constexpr (FP8) { const v8i32 _b = PG8_SUB8(B32, 2 * (bj) + n), _a = PG8_SUB8(A32, m); \
            asm volatile("v_mfma_scale_f32_16x16x128_f8f6f4 %0, %1, %2, %0, %3, %3 op_sel_hi:[0,0,0]" : "+v"(acc[ai][bj][m][n]) : "v"(_b), "v"(_a), "v"(sc1)); } \
        else { acc[ai][bj][m][n] = __builtin_amdgcn_mfma_f32_16x16x32_bf16(Bt[n].lo(), At[m].lo(), acc[ai][bj][m][n], 0, 0, 0); acc[ai][bj][m][n] = __builtin_amdgcn_mfma_f32_16x16x32_bf16(Bt[n].hi(), At[m].hi(), acc[ai][bj][m][n], 0, 0, 0); } } \
        __builtin_amdgcn_s_setprio(0); } while (0)
#define PG8_WAIT_V(n) asm volatile("s_waitcnt vmcnt(" #n ")" ::: "memory")
#define PG8_WAIT_L(n) asm volatile("s_waitcnt lgkmcnt(" #n ")" ::: "memory")
#define PG8_BAR __builtin_amdgcn_s_barrier()
#define PG8_SCHED __builtin_amdgcn_sched_barrier(0)
    Unit cur, nxt; int ui = 0;
    if (!S.next(0, cur)) return;
    f32x4 acc[2][2][4][2];
#pragma unroll
    for (int a = 0; a < 2; ++a)
#pragma unroll
        for (int b = 0; b < 2; ++b)
#pragma unroll
            for (int m = 0; m < 4; ++m)
#pragma unroll
                for (int n = 0; n < 2; ++n) acc[a][b][m][n] = (f32x4){0.f, 0.f, 0.f, 0.f};
    struct Frag2 { v8i32 v;
        __device__ __forceinline__ bf16x8 lo() const { const u32x4 t = {(unsigned)v[0], (unsigned)v[1], (unsigned)v[2], (unsigned)v[3]}; return __builtin_bit_cast(bf16x8, t); }
        __device__ __forceinline__ bf16x8 hi() const { const u32x4 t = {(unsigned)v[4], (unsigned)v[5], (unsigned)v[6], (unsigned)v[7]}; return __builtin_bit_cast(bf16x8, t); } };
    Frag2 At[4], B0[2], B1[2];
    typedef int v32i32 __attribute__((ext_vector_type(32)));
    int sc1 = 0x7f7f7f7f; asm volatile("" : "+v"(sc1));
    v32i32 A32, B32;
#define PG8_SUB8(V, i) ((v8i32){V[8 * (i)], V[8 * (i) + 1], V[8 * (i) + 2], V[8 * (i) + 3], V[8 * (i) + 4], V[8 * (i) + 5], V[8 * (i) + 6], V[8 * (i) + 7]})
#define PG8_INS8(V, i, X) do { const v8i32 _x = (X); _Pragma("unroll") for (int _e = 0; _e < 8; ++_e) V[8 * (i) + _e] = _x[_e]; } while (0)
    const char* cA = (const char*)g.A + ((size_t)cur.pm * BM * lda + cur.ak) * ES; const char* cB = (const char*)g.Bt + (size_t)cur.pb * BM * K * ES;
    if constexpr (SP2) {
        PG8_STAGE(PG8_SB(0, 0), cB, voffB); PG8_STAGE(PG8_SB(0, 1), cB + hsB, voffB); PG8_STAGE(PG8_SA(0, 0), cA, voffA); PG8_STAGE(PG8_SA(0, 1), cA + hsA, voffA);
        if (wr == 1) PG8_BAR;
        PG8_WAIT_V(2); PG8_BAR;
        PG8_STAGE(PG8_SB(1, 0), cB + kstep, voffB); PG8_STAGE(PG8_SA(1, 0), cA + kstep, voffA); PG8_STAGE(PG8_SB(1, 1), cB + hsB + kstep, voffB);
        PG8_WAIT_V(6); PG8_BAR;
    } else {
        PG8_STAGE(PG8_SB(0, 0), cB, voffB); PG8_STAGE(PG8_SA(0, 0), cA, voffA); PG8_STAGE(PG8_SB(0, 1), cB + hsB, voffB); PG8_STAGE(PG8_SA(0, 1), cA + hsA, voffA);
        if (wr == 1) PG8_BAR;
        PG8_WAIT_V(4); PG8_BAR;
        PG8_STAGE(PG8_SB(1, 0), cB + kstep, voffB); PG8_STAGE(PG8_SA(1, 0), cA + kstep, voffA); PG8_STAGE(PG8_SB(1, 1), cB + hsB + kstep, voffB);
        PG8_WAIT_V(6); PG8_BAR;
    }
    for (;;) {
        const bool has_next = S.next(ui + 1, nxt);
        const char* nA = has_next ? (const char*)g.A + ((size_t)nxt.pm * BM * lda + nxt.ak) * ES : cA; const char* nB = has_next ? (const char*)g.Bt + (size_t)nxt.pb * BM * K * ES : cB;
#pragma unroll 1
        for (int t = 0; t < nt; t += 2) {
            const bool last = (t == nt - 2);
            const char* a1 = cA + (size_t)(t + 1) * kstep;
            const char* a2 = last ? nA : cA + (size_t)(t + 2) * kstep; const char* b2 = last ? nB : cB + (size_t)(t + 2) * kstep;
            const char* a3 = a2 + kstep; const char* b3 = b2 + kstep;
            if constexpr (SP2) {
            PG8_LDB(B0, 0, 0); PG8_LDB(B1, 0, 1); PG8_SCHED; PG8_LDA(At, 0, 0); PG8_STAGE(PG8_SA(1, 1), a1 + hsA, voffA);
            PG8_WAIT_V(8); PG8_WAIT_L(0); PG8_BAR; PG8_MMA(0, 0, At, B0); PG8_MMA(0, 1, At, B1); PG8_BAR; PG8_SCHED;
            PG8_LDA(At, 0, 1); PG8_STAGE(PG8_SB(0, 0), b2, voffB); PG8_STAGE(PG8_SB(0, 1), b2 + hsB, voffB); PG8_STAGE(PG8_SA(0, 0), a2, voffA);
            PG8_WAIT_V(8); PG8_WAIT_L(0); PG8_BAR; PG8_MMA(1, 0, At, B0); PG8_MMA(1, 1, At, B1); PG8_BAR; PG8_SCHED;
            PG8_LDB(B0, 1, 0); PG8_LDB(B1, 1, 1); PG8_SCHED; PG8_LDA(At, 1, 0); PG8_STAGE(PG8_SA(0, 1), a2 + hsA, voffA);
            PG8_WAIT_V(8); PG8_WAIT_L(0); PG8_BAR; PG8_MMA(0, 0, At, B0); PG8_MMA(0, 1, At, B1); PG8_BAR; PG8_SCHED;
            PG8_LDA(At, 1, 1); PG8_STAGE(PG8_SB(1, 0), b3, voffB); PG8_STAGE(PG8_SB(1, 1), b3 + hsB, voffB); PG8_STAGE(PG8_SA(1, 0), a3, voffA);
            PG8_WAIT_V(8); PG8_WAIT_L(0); PG8_BAR; PG8_MMA(1, 0, At, B0); PG8_MMA(1, 1, At, B1); PG8_BAR; PG8_SCHED;
            } else {
            PG8_LDB(B0, 0, 0); PG8_SCHED; PG8_LDA(At, 0, 0); PG8_STAGE(PG8_SA(1, 1), a1 + hsA, voffA);
            PG8_WAIT_L(8); PG8_BAR; PG8_WAIT_L(0); PG8_MMA(0, 0, At, B0); PG8_BAR; PG8_SCHED;
            PG8_LDB(B1, 0, 1); PG8_STAGE(PG8_SB(0, 0), b2, voffB);
            PG8_BAR; PG8_WAIT_L(0); PG8_MMA(0, 1, At, B1); PG8_BAR;
            PG8_LDA(At, 0, 1); PG8_STAGE(PG8_SA(0, 0), a2, voffA);
            PG8_BAR; PG8_WAIT_L(0); PG8_MMA(1, 0, At, B0); PG8_BAR; PG8_SCHED;
            PG8_STAGE(PG8_SB(0, 1), b2 + hsB, voffB);
            PG8_WAIT_V(6); PG8_BAR; PG8_MMA(1, 1, At, B1); PG8_BAR;
            PG8_LDB(B0, 1, 0); PG8_SCHED; PG8_LDA(At, 1, 0); PG8_STAGE(PG8_SA(0, 1), a2 + hsA, voffA);
            PG8_WAIT_L(8); PG8_BAR; PG8_WAIT_L(0); PG8_MMA(0, 0, At, B0); PG8_BAR; PG8_SCHED;
            PG8_LDB(B1, 1, 1); PG8_STAGE(PG8_SB(1, 0), b3, voffB);
            PG8_BAR; PG8_WAIT_L(0); PG8_MMA(0, 1, At, B1); PG8_BAR;
            PG8_LDA(At, 1, 1); PG8_STAGE(PG8_SA(1, 0), a3, voffA);
            PG8_BAR; PG8_WAIT_L(0); PG8_MMA(1, 0, At, B0); PG8_BAR; PG8_SCHED;
            PG8_STAGE(PG8_SB(1, 1), b3 + hsB, voffB);
            PG8_WAIT_V(6); PG8_BAR; PG8_MMA(1, 1, At, B1); PG8_BAR;
            }
        }
        if constexpr (ALIGN_EPI) { if (wr == 0) PG8_BAR; }
        if constexpr (FP8) asm volatile("s_nop 15\n\ts_nop 15" ::: "memory");
        E(acc, cur, wr, wc, fr, fq);
        if (!has_next) break;
#pragma unroll
        for (int a = 0; a < 2; ++a)
#pragma unroll
            for (int b = 0; b < 2; ++b)
#pragma unroll
                for (int m = 0; m < 4; ++m)
#pragma unroll
                    for (int n = 0; n < 2; ++n) acc[a][b][m][n] = (f32x4){0.f, 0.f, 0.f, 0.f};
        cur = nxt; cA = nA; cB = nB; ++ui;
        if constexpr (ALIGN_EPI) { if (wr == 1) PG8_BAR; }
    }
    PG8_WAIT_V(0);
    if constexpr (!ALIGN_EPI) { if (wr == 0) PG8_BAR; }
    PG8_BAR;
#undef PG8_SA
#undef PG8_SB
#undef PG8_STAGE
#undef PG8_LDA
#undef PG8_LDB
#undef PG8_MMA
#undef PG8_WAIT_V
#undef PG8_WAIT_L
#undef PG8_BAR
#undef PG8_SCHED
#undef PG8_SUB8
#undef PG8_INS8
}

struct DenseOrder {
    int nM, nN, nwg, G, c;
    __device__ __forceinline__ void init(int nM_, int nN_, int G_, int c_) { nM = nM_; nN = nN_; nwg = nM * nN; G = G_; c = c_; }
    __device__ __forceinline__ bool next(int i, Unit& u) const {
        const long L = (long)i * G + c; if (L >= nwg) return false;
        int wgid = (int)L; { const int q = nwg / 8, r = nwg % 8, xcd = wgid % 8, off = wgid / 8; wgid = (xcd < r ? xcd * (q + 1) : r * (q + 1) + (xcd - r) * q) + off; }
        const int nig = 8 * nN, gid = wgid / nig, fm = gid * 8, gsz = (nM - fm) < 8 ? (nM - fm) : 8;
        u.pm = fm + ((wgid % nig) % gsz); u.pn = (wgid % nig) / gsz; u.pb = u.pn; u.ak = 0; return true;
    }
};
struct MoeUpOrder {
    int G, c;
    __device__ __forceinline__ bool next(int i, Unit& u) const {
        const int L = i * G + c; if (L >= 2048) return false;
        const int r = L / 256, cc = L % 256, x = cc % 8, j = cc / 8;
        const int e = 2 * x + (r >> 2); u.pm = e * 8 + (j & 7); u.pn = 4 * (r & 3) + (j >> 3); u.pb = e * 16 + u.pn; u.ak = 0; return true;
    }
};
struct MoeDownOrder {
    int G, c;
    __device__ __forceinline__ bool next(int i, Unit& u) const {
        const int L = i * G + c; if (L >= 512) return false;
        const int r = L / 256, cc = L % 256, x = cc % 8, j = cc / 8;
        const int e = 8 * r + x; u.pm = e * 8 + (j & 7); u.pn = j >> 3; u.pb = e * 4 + u.pn; u.ak = 0; return true;
    }
};
struct PoolOrder {
    int G, c;
    __device__ __forceinline__ bool next(int i, Unit& u) const {
        const int L = i * G + c; if (L >= 256) return false;
        const int x = L % 8, j = L / 8; u.pm = x * 8 + (j & 7); u.pn = j >> 3; u.pb = u.pn; u.ak = u.pn * 256; return true;
    }
};

struct EpiInProj {
    bf16_t* P; float* AB;
    __device__ __forceinline__ void operator()(const f32x4 (&acc)[2][2][4][2], const Unit& u, int wr, int wc, int fr, int fq) const {
        const int row0 = u.pm * BM + wr * 64 + fr;
        if (u.pn < 16) {
            const int col0 = u.pn * BM + wc * 32 + 4 * fq;
#pragma unroll
            for (int ai = 0; ai < 2; ++ai)
#pragma unroll
                for (int m = 0; m < 4; ++m) { bf16_t* rowp = P + (size_t)(row0 + ai * HALF + m * 16) * NP + col0;
#pragma unroll
                    for (int bj = 0; bj < 2; ++bj)
#pragma unroll
                        for (int n = 0; n < 2; ++n) { const f32x4 v = acc[ai][bj][m][n]; u32x2 w; w.x = pk2(v[0], v[1]); w.y = pk2(v[2], v[3]); *(u32x2*)(rowp + bj * HALF + n * 16) = w; } }
        } else if (wc == 0) {
#pragma unroll
            for (int ai = 0; ai < 2; ++ai)
#pragma unroll
                for (int m = 0; m < 4; ++m) { float* rowp = AB + (size_t)(row0 + ai * HALF + m * 16) * 32 + 4 * fq;
#pragma unroll
                    for (int n = 0; n < 2; ++n) *(f32x4*)(rowp + n * 16) = acc[ai][0][m][n]; }
        }
    }
};
struct EpiOutProj {
    const float* X; float* H; const float* gate;
    __device__ __forceinline__ void operator()(const f32x4 (&acc)[2][2][4][2], const Unit& u, int wr, int wc, int fr, int fq) const {
        const int row0 = u.pm * BM + wr * 64 + fr, col0 = u.pn * BM + wc * 32 + 4 * fq;
        const float* gp = gate + (size_t)(u.pm * BM / T) * 6144 + col0;
        f32x4 gv[2][2];
#pragma unroll
        for (int bj = 0; bj < 2; ++bj)
#pragma unroll
            for (int n = 0; n < 2; ++n) gv[bj][n] = *(const f32x4*)(gp + bj * HALF + n * 16);
#pragma unroll
        for (int ai = 0; ai < 2; ++ai)
#pragma unroll
            for (int m = 0; m < 4; ++m) { const size_t off = (size_t)(row0 + ai * HALF + m * 16) * D + col0;
#pragma unroll
                for (int bj = 0; bj < 2; ++bj)
#pragma unroll
                    for (int n = 0; n < 2; ++n) { const f32x4 xv = *(const f32x4*)(X + off + bj * HALF + n * 16); *(f32x4*)(H + off + bj * HALF + n * 16) = xv + gv[bj][n] * acc[ai][bj][m][n]; }
                asm volatile("" ::: "memory"); }
    }
};
struct EpiSwiglu {
    unsigned char* HID;
    __device__ __forceinline__ void operator()(const f32x4 (&acc)[2][2][4][2], const Unit& u, int wr, int wc, int fr, int fq) const {
        asm volatile("" : "+v"(fr), "+v"(fq));
        const int row0 = u.pm * BM + wr * 64 + fr, col0 = u.pn * HALF + wc * 32 + 4 * fq;
#pragma unroll
        for (int ai = 0; ai < 2; ++ai)
#pragma unroll
            for (int m = 0; m < 4; ++m) { unsigned char* rowp = HID + (size_t)(row0 + ai * HALF + m * 16) * DF + col0;
#pragma unroll
                for (int n = 0; n < 2; ++n) { const f32x4 g = acc[ai][0][m][n], up = acc[ai][1][m][n]; float h[4];
#pragma unroll
                    for (int j = 0; j < 4; ++j) h[j] = siluf(g[j] * 0.03125f) * (up[j] * 0.03125f);
                    *(unsigned*)(rowp + n * 16) = pk4_fp8(h[0], h[1], h[2], h[3]); } }
    }
};
struct EpiDown {
    bf16_t* YS; const float* gates;
    __device__ __forceinline__ void operator()(const f32x4 (&acc)[2][2][4][2], const Unit& u, int wr, int wc, int fr, int fq) const {
        asm volatile("" : "+v"(fr), "+v"(fq));
        const int row0 = u.pm * BM + wr * 64 + fr, col0 = u.pn * BM + wc * 32 + 4 * fq;
#pragma unroll
        for (int ai = 0; ai < 2; ++ai)
#pragma unroll
            for (int m = 0; m < 4; ++m) { const int row = row0 + ai * HALF + m * 16; const float gt = gates[row] * 0.03125f; bf16_t* rowp = YS + (size_t)row * D + col0;
#pragma unroll
                for (int bj = 0; bj < 2; ++bj)
#pragma unroll
                    for (int n = 0; n < 2; ++n) { const f32x4 v = acc[ai][bj][m][n] * gt; u32x2 w; w.x = pk2(v[0], v[1]); w.y = pk2(v[2], v[3]); *(u32x2*)(rowp + bj * HALF + n * 16) = w; } }
    }
};
struct EpiPool {
    float* H; const float* gate; const float* scale;
    __device__ __forceinline__ void operator()(const f32x4 (&acc)[2][2][4][2], const Unit& u, int wr, int wc, int fr, int fq) const {
        const int row0 = u.pm * BM + wr * 64 + fr, col0 = u.pn * BM + wc * 32 + 4 * fq;
        const float* gp = gate + (size_t)(u.pm * BM / T) * 6144 + col0;
        f32x4 gv[2][2];
#pragma unroll
        for (int bj = 0; bj < 2; ++bj)
#pragma unroll
            for (int n = 0; n < 2; ++n) gv[bj][n] = *(const f32x4*)(gp + bj * HALF + n * 16) * *(const f32x4*)(scale + col0 + bj * HALF + n * 16);
#pragma unroll
        for (int ai = 0; ai < 2; ++ai)
#pragma unroll
            for (int m = 0; m < 4; ++m) { const size_t off = (size_t)(row0 + ai * HALF + m * 16) * D + col0;
#pragma unroll
                for (int bj = 0; bj < 2; ++bj)
#pragma unroll
                    for (int n = 0; n < 2; ++n) { float* p = H + off + bj * HALF + n * 16; const f32x4 hv = *(const f32x4*)p; *(f32x4*)p = hv + gv[bj][n] * acc[ai][bj][m][n]; }
                asm volatile("" ::: "memory"); }
    }
};
}


#define XB_TMO      128
#define XB_XCNT(j)  (256  + 64 * (j))
#define XB_XSUB(j)  (1280 + 64 * (j))
#define XB_XGEN(j)  (2304 + 64 * (j))
#define XB_TOP      3328
#define XB_TOPGEN   3392
#define XCD_BAR_WORDS 3456
#define XB_SPIN_CAP (1u << 20)
__device__ __forceinline__ unsigned xb_ld(unsigned* p)              { return __hip_atomic_load(p, __ATOMIC_RELAXED, __HIP_MEMORY_SCOPE_AGENT); }
__device__ __forceinline__ unsigned xb_add(unsigned* p, unsigned v) { return __hip_atomic_fetch_add(p, v, __ATOMIC_RELAXED, __HIP_MEMORY_SCOPE_AGENT); }
__device__ __forceinline__ unsigned xb_xcc_id() { return (unsigned)__builtin_amdgcn_s_getreg((3 << 11) | 20) & 0xFu; }
#define XB_SPIN(cond, bar) do { unsigned _sp = 0; while (cond) { __builtin_amdgcn_s_sleep(1); \
    if ((++_sp & 255u) == 0u) { if (xb_ld(&(bar)[XB_TMO])) break; if (_sp > XB_SPIN_CAP) { atomicAdd(&(bar)[XB_TMO], 1u); break; } } } } while (0)
struct XcdBarrier { unsigned* bar; unsigned x; volatile LAS unsigned* st; };
__device__ __forceinline__ XcdBarrier xcd_barrier_post(unsigned* bar, volatile LAS unsigned* st) {
    XcdBarrier b; b.bar = bar; b.x = xb_xcc_id(); b.st = st;
    if (threadIdx.x == 0) (void)xb_add(&bar[XB_XCNT(b.x)], 1u);
    return b;
}
__device__ __forceinline__ void xcd_barrier_complete(unsigned* bar, unsigned x, unsigned& nloc, unsigned& nx) {
    const unsigned G = gridDim.x * gridDim.y * gridDim.z;
    unsigned sum, cnt, mine, sp = 0u;
    for (;;) {
        sum = 0u; cnt = 0u; mine = 0u;
#pragma unroll
        for (unsigned j = 0; j < 16; ++j) { const unsigned c = xb_ld(&bar[XB_XCNT(j)]); sum += c; cnt += (c > 0u) ? 1u : 0u; mine = (j == x) ? c : mine; }
        if (sum == G) break;
        __builtin_amdgcn_s_sleep(1);
        if ((++sp & 255u) == 0u) { if (xb_ld(&bar[XB_TMO])) break; if (sp > XB_SPIN_CAP) { atomicAdd(&bar[XB_TMO], 1u); break; } }
    }
    nloc = mine > 0u ? mine : 1u; nx = cnt > 0u ? cnt : 1u;
}
__device__ __forceinline__ void xcd_barrier(const XcdBarrier& b) {
    asm volatile("s_waitcnt vmcnt(0)" ::: "memory");
    __syncthreads();
    if (threadIdx.x == 0) {
        unsigned* bar = b.bar;
        __builtin_amdgcn_s_waitcnt(0);
        unsigned nloc = b.st[0], nx = b.st[1];
        if (nloc == 0u) { xcd_barrier_complete(bar, b.x, nloc, nx); b.st[0] = nloc; b.st[1] = nx; }
        const unsigned old = xb_add(&bar[XB_XSUB(b.x)], 1u);
        const unsigned gen = old / nloc;
        if (old + 1u == (gen + 1u) * nloc) {
            __builtin_amdgcn_fence(__ATOMIC_RELEASE, "agent");
            asm volatile("s_waitcnt vmcnt(0)" ::: "memory");
            const unsigned og = xb_add(&bar[XB_TOP], 1u);
            const unsigned tg = og / nx;
            if (og + 1u == (tg + 1u) * nx) xb_add(&bar[XB_TOPGEN], 1u);
            else XB_SPIN(xb_ld(&bar[XB_TOPGEN]) == tg, bar);
            __builtin_amdgcn_fence(__ATOMIC_ACQUIRE, "agent");
            xb_add(&bar[XB_XGEN(b.x)], 1u);
            asm volatile("s_waitcnt vmcnt(0)" ::: "memory");
        } else {
            XB_SPIN(xb_ld(&bar[XB_XGEN(b.x)]) == gen, bar);
            __builtin_amdgcn_fence(__ATOMIC_ACQUIRE, "agent");
            asm volatile("s_waitcnt vmcnt(0)" ::: "memory");
        }
    }
    __syncthreads();
}
constexpr int MISC_OFF = LDS_BYTES - 128;

struct Args { const float* in[21]; float* out; unsigned char* ws; int ph_lo, ph_hi; };
enum { I_X = 0, I_C, I_CTX, I_CCTX, I_WMOD, I_BMOD, I_GMIX, I_GFFN, I_WIN, I_CONVW, I_ALOG, I_DTB, I_OGAIN, I_WOUT, I_POOLW, I_POOLS, I_WR, I_WG, I_WU, I_WD, I_FING };

struct Frame {
    LAS unsigned char* lds;
    int tid, lane, wave, G, vcu;
    const float* in[21]; float* out; unsigned char* ws;
};

__device__ __forceinline__ void tr_tile(const float* __restrict__ src, int ld_src, int n_valid, bf16_t* dst_row0, int ld_dst, int k0, LAS unsigned char* scr, int lane, float q8 = 0.f) {
    const int nq = lane & 15, g = lane >> 4;
    f32x4 v[2][8];
    const bool ok = 4 * nq < n_valid;
#pragma unroll
    for (int i1 = 0; i1 < 2; ++i1)
#pragma unroll
        for (int i2 = 0; i2 < 8; ++i2) { const int k = 32 * i1 + 8 * g + i2;
            v[i1][i2] = ok ? *(const f32x4*)(src + (size_t)(k0 + k) * ld_src + 4 * nq) : (f32x4){0.f, 0.f, 0.f, 0.f}; }
#ifdef EMU_FP8
    if (q8 > 0.f) { const float iq = 1.f / q8;
#pragma unroll
        for (int i1 = 0; i1 < 2; ++i1)
#pragma unroll
            for (int i2 = 0; i2 < 8; ++i2)
#pragma unroll
                for (int j = 0; j < 4; ++j) v[i1][i2][j] = rnd_fp8(v[i1][i2][j] * q8) * iq; }
#endif
#pragma unroll
    for (int j = 0; j < 4; ++j)
#pragma unroll
        for (int i1 = 0; i1 < 2; ++i1) {
            u32x4 w; w.x = pk2(v[i1][0][j], v[i1][1][j]); w.y = pk2(v[i1][2][j], v[i1][3][j]); w.z = pk2(v[i1][4][j], v[i1][5][j]); w.w = pk2(v[i1][6][j], v[i1][7][j]);
            const int n = 4 * nq + j, c = 4 * i1 + g;
            *(LAS u32x4*)(scr + n * 128 + ((c ^ (nq & 7)) * 16)) = w; }
    LDS_WAIT();
#pragma unroll
    for (int it = 0; it < 8; ++it) { const int n = (lane >> 3) + 8 * it, c = lane & 7;
        const u32x4 w = *(const LAS u32x4*)(scr + n * 128 + ((c ^ ((n >> 2) & 7)) * 16));
        *(u32x4*)(dst_row0 + (size_t)n * ld_dst + k0 + 8 * c) = w; }
    LDS_WAIT();
}

__device__ __forceinline__ void tr_tile8(const float* __restrict__ src, int ld_src, unsigned char* dst_row0, int ld_dst, int k0, LAS unsigned char* scr, int lane) {
    const int nq = lane & 15, g = lane >> 4;
    f32x4 v[2][8];
#pragma unroll
    for (int i1 = 0; i1 < 2; ++i1)
#pragma unroll
        for (int i2 = 0; i2 < 8; ++i2) { const int k = 32 * i1 + 8 * g + i2; v[i1][i2] = *(const f32x4*)(src + (size_t)(k0 + k) * ld_src + 4 * nq) * 32.f; }
#pragma unroll
    for (int j = 0; j < 4; ++j)
#pragma unroll
        for (int i1 = 0; i1 < 2; ++i1) {
            u32x2 w; w.x = pk4_fp8(v[i1][0][j], v[i1][1][j], v[i1][2][j], v[i1][3][j]); w.y = pk4_fp8(v[i1][4][j], v[i1][5][j], v[i1][6][j], v[i1][7][j]);
            const int n = 4 * nq + j, c = 4 * i1 + g;
            *(LAS u32x2*)(scr + n * 64 + ((((c >> 1) ^ (nq & 3))) << 4) + (c & 1) * 8) = w; }
    LDS_WAIT();
#pragma unroll
    for (int it = 0; it < 4; ++it) { const int n = (lane >> 2) + 16 * it, p = lane & 3;
        const u32x4 w = *(const LAS u32x4*)(scr + n * 64 + ((p ^ ((n >> 2) & 3)) << 4));
        *(u32x4*)(dst_row0 + (size_t)n * ld_dst + k0 + 16 * p) = w; }
    LDS_WAIT();
}

constexpr int TR_SMALL = 16 * 68 + 256 + 64;
__device__ __forceinline__ void tr_small_job(Frame& F, int t, LAS unsigned char* scr) {
    if (t < 1088) { const int nt = t / 16, kt = t % 16; int nv = NPROJ - 64 * nt; nv = nv < 0 ? 0 : (nv > 64 ? 64 : nv);
        tr_tile(F.in[I_WIN] + 64 * nt, NPROJ, nv, (bf16_t*)(F.ws + WS_WIN) + (size_t)64 * nt * D, D, 64 * kt, scr, F.lane); return; }
    t -= 1088;
    if (t < 256) { const int nt = t / 16, kt = t % 16;
        tr_tile(F.in[I_WOUT] + 64 * nt, D, 64, (bf16_t*)(F.ws + WS_WOUT) + (size_t)64 * nt * D, D, 64 * kt, scr, F.lane); return; }
    t -= 256;
    { const int gi = t / 16, nt = (t % 16) / 4, kt = t % 4;
        tr_tile(F.in[I_POOLW] + (size_t)gi * 65536 + 64 * nt, 256, 64, (bf16_t*)(F.ws + WS_POOLW) + (size_t)gi * 65536 + (size_t)64 * nt * 256, 256, 64 * kt, scr, F.lane); }
}
constexpr int TR_MOE = 24576;
__device__ __forceinline__ void tr_moe_job(Frame& F, int l, int t, LAS unsigned char* scr) {
    if (t < 16384) { const int e = t / 1024, r = t % 1024, which = r / 512, r2 = r % 512, nt = r2 / 16, kt = r2 % 16;
        const float* src = F.in[which ? I_WU : I_WG] + (size_t)(l * NE + e) * D * DF + 64 * nt;
        unsigned char* dst = (unsigned char*)(F.ws + WS_WMOE) + (size_t)l * WMOE_LAYER + ((size_t)e * 4096 + (nt >> 1) * 256 + which * 128 + (nt & 1) * 64) * D;
        tr_tile8(src, DF, dst, D, 64 * kt, scr, F.lane); return; }
    t -= 16384;
    { const int e = t / 512, r = t % 512, nt = r / 32, kt = r % 32;
        const float* src = F.in[I_WD] + (size_t)(l * NE + e) * DF * D + 64 * nt;
        unsigned char* dst = (unsigned char*)(F.ws + WS_W2T) + (size_t)l * WMOE_LAYER + ((size_t)e * D + 64 * nt) * DF;
        tr_tile8(src, D, dst, DF, 64 * kt, scr, F.lane); }
}

__device__ __forceinline__ void mod_item(Frame& F, int item) {
    LAS float* act = (LAS float*)(F.lds + 65536);
    LAS float* part = (LAS float*)(F.lds + 65536 + 20480);
    const int l = item / 96, cgp = item % 96;
    for (int i = F.tid; i < 5 * D; i += NTHR) { const int r = i >> 10, k = i & 1023; const float x = r < 4 ? F.in[I_C][r * D + k] : F.in[I_CCTX][k]; act[i] = siluf(x); }
    __syncthreads();
    const int j = cgp * 64 + F.lane;
    const float* w = F.in[I_WMOD] + (size_t)l * D * 6144 + j;
    float a0 = 0.f, a1 = 0.f, a2 = 0.f, a3 = 0.f, a4 = 0.f;
    const int kb = F.wave * 128;
#pragma unroll 8
    for (int k = 0; k < 128; ++k) { const float wv = w[(size_t)(kb + k) * 6144];
        a0 += act[kb + k] * wv; a1 += act[D + kb + k] * wv; a2 += act[2 * D + kb + k] * wv; a3 += act[3 * D + kb + k] * wv; a4 += act[4 * D + kb + k] * wv; }
    LAS float* pp = part + F.wave * 320 + F.lane;
    pp[0] = a0; pp[64] = a1; pp[128] = a2; pp[192] = a3; pp[256] = a4;
    __syncthreads();
    if (F.tid < 320) { const int r = F.tid >> 6, ln = F.tid & 63; float s = 0.f;
#pragma unroll
        for (int w8 = 0; w8 < 8; ++w8) s += part[w8 * 320 + r * 64 + ln];
        const int jj = cgp * 64 + ln;
        ((float*)(F.ws + WS_MOD))[(size_t)(l * 5 + r) * 6144 + jj] = s + F.in[I_BMOD][l * 6144 + jj]; }
    __syncthreads();
}

__device__ __forceinline__ void load_row(const float* p, int lane, f32x4 (&v)[4]) {
#pragma unroll
    for (int j = 0; j < 4; ++j) v[j] = ((const f32x4*)p)[lane + 64 * j];
}
__device__ __forceinline__ float row_rstd(const f32x4 (&v)[4]) {
    float s = 0.f;
#pragma unroll
    for (int j = 0; j < 4; ++j) s += (v[j][0] * v[j][0] + v[j][1] * v[j][1]) + (v[j][2] * v[j][2] + v[j][3] * v[j][3]);
    return rsqrtf(wave_sum(s) * (1.f / D) + EPS);
}
__device__ __forceinline__ void norm_mod(const f32x4 (&v)[4], float rstd, const float* g, const float* sh, const float* sc, int lane, f32x4 (&y)[4]) {
#pragma unroll
    for (int j = 0; j < 4; ++j) { const f32x4 gv = ((const f32x4*)g)[lane + 64 * j], shv = ((const f32x4*)sh)[lane + 64 * j], scv = ((const f32x4*)sc)[lane + 64 * j];
        y[j] = v[j] * rstd * gv * (1.f + scv) + shv; }
}
__device__ __forceinline__ void store_row_bf16(bf16_t* p, int lane, const f32x4 (&y)[4]) {
#pragma unroll
    for (int j = 0; j < 4; ++j) { u32x2 w; w.x = pk2(y[j][0], y[j][1]); w.y = pk2(y[j][2], y[j][3]); ((u32x2*)p)[lane + 64 * j] = w; }
}

__device__ __forceinline__ void phase_norm0(Frame& F) {
    const float* MOD = (const float*)(F.ws + WS_MOD);
    bf16_t* U = (bf16_t*)(F.ws + WS_U);
    for (int row = F.vcu * NWAVE + F.wave; row < MA; row += F.G * NWAVE) {
        const float* src; int mr;
        if (row < ML) { src = F.in[I_X] + (size_t)row * D; mr = row / T; } else { src = F.in[I_CTX] + (size_t)(row - ML) * D; mr = 4; }
        f32x4 v[4], y[4]; load_row(src, F.lane, v);
        const float rstd = row_rstd(v);
        const float* m = MOD + (size_t)mr * 6144;
        norm_mod(v, rstd, F.in[I_GMIX], m, m + D, F.lane, y);
        store_row_bf16(U + (size_t)row * D, F.lane, y);
    }
}

__device__ __forceinline__ void chunk_rows(int ci, int& row0, int& t0, int& slen) {
    if (ci < 256) { row0 = ci * 64; t0 = (ci & 63) * 64; slen = T; } else { const int cc = ci - 256; row0 = ML + cc * 64; t0 = (cc & 3) * 64; slen = TC; }
}
__device__ __forceinline__ void phase_conv(Frame& F) {
    const bf16_t* P = (const bf16_t*)(F.ws + WS_P);
    bf16_t* QKV = (bf16_t*)(F.ws + WS_QKV);
    bf16_t* KT = (bf16_t*)(F.ws + WS_KT);
    bf16_t* VT = (bf16_t*)(F.ws + WS_VT);
    LAS unsigned* kts = (LAS unsigned*)(F.lds + F.wave * 16896);
    LAS bf16_t* kts16 = (LAS bf16_t*)kts;
    const int lane = F.lane;
    for (int item = F.vcu * NWAVE + F.wave; item < NCHUNK * 24; item += F.G * NWAVE) {
        const int ci = item / 24, slab = item % 24;
        int row0, t0, slen; chunk_rows(ci, row0, t0, slen);
        const int col = slab * 128 + 2 * lane;
        float w0[5], w1[5];
#pragma unroll
        for (int j = 0; j < 5; ++j) { const f32x2 wv = *(const f32x2*)(F.in[I_CONVW] + (size_t)j * NQKV + col); w0[j] = wv[0]; w1[j] = wv[1]; }
        const bf16_t* src = P + (size_t)row0 * NP + col;
        unsigned rowsv[68];
#pragma unroll
        for (int j = 0; j < 68; ++j) { const int tt = j - 2; rowsv[j] = (t0 + tt >= 0 && t0 + tt < slen) ? *(const unsigned*)(src + (long)tt * NP) : 0u; }
        const int kind = slab >> 3;
#pragma unroll 1
        for (int t8 = 0; t8 < 64; t8 += 8) {
#pragma unroll
            for (int q = 0; q < 8; ++q) {
                const int tt = t8 + q;
                float y0 = 0.f, y1 = 0.f;
#pragma unroll
                for (int j = 0; j < 5; ++j) { y0 += w0[j] * bflo(rowsv[q + j]); y1 += w1[j] * bfhi(rowsv[q + j]); }
                y0 = siluf(y0); y1 = siluf(y1);
                if (kind < 2) { const float ss = wave_sum(y0 * y0 + y1 * y1); float sc = rsqrtf(ss + EPS); if (kind == 0) sc *= 0.08838834764831845f; y0 *= sc; y1 *= sc; }
                const unsigned pk = pk2(y0, y1);
                *(unsigned*)(QKV + (size_t)(row0 + tt) * NQKV + col) = pk;
                if (kind >= 1) { kts16[(2 * lane) * 66 + tt] = (bf16_t)(pk & 0xffffu); kts16[(2 * lane + 1) * 66 + tt] = (bf16_t)(pk >> 16); }
            }
#pragma unroll
            for (int j = 0; j < 60; ++j) rowsv[j] = rowsv[j + 8];
        }
        if (kind >= 1) {
            LDS_WAIT();
            unsigned* dst = (unsigned*)((kind == 1 ? KT : VT) + ((size_t)ci * NH + (slab & 7)) * 128 * 64);
#pragma unroll 8
            for (int it = 0; it < 64; ++it) { const int dk = 2 * it + (lane >> 5), dw = lane & 31; dst[dk * 32 + dw] = kts[dk * 33 + dw]; }
            LDS_WAIT();
        }
    }
}

__device__ __forceinline__ void chunk_gates(Frame& F, int row0, int h, int dir, int lane, float& gc, float& beta, float& gtot) {
    const float* ab = (const float*)(F.ws + WS_AB) + (size_t)(row0 + lane) * 32 + dir * 16 + h;
    const float a = ab[0], bb = ab[8];
    const float g = -__expf(F.in[I_ALOG][dir * NH + h]) * softplusf(a + F.in[I_DTB][dir * NH + h]);
    beta = sigmoidf(bb);
    float s = g;
#pragma unroll
    for (int o = 1; o < 64; o <<= 1) { const float t = __builtin_bit_cast(float, __builtin_amdgcn_ds_bpermute((lane - o) << 2, __builtin_bit_cast(int, s))); if (lane >= o) s += t; }
    gtot = __builtin_bit_cast(float, __builtin_amdgcn_readlane(__builtin_bit_cast(int, s), 63));
    gc = dir ? (gtot - s + g) : s;
}

template <int V> __device__ __forceinline__ void phase_prep(Frame& F) {
    const bf16_t* QKV = (const bf16_t*)(F.ws + WS_QKV);
    LAS float* As = (LAS float*)(F.lds + F.wave * 17408);
    LAS float* gs = (LAS float*)(F.lds + F.wave * 17408 + 16384);
#pragma unroll 1
    for (int item = F.vcu * NWAVE + F.wave; item < NCHUNK * NH * 2; item += F.G * NWAVE) {
        const int ci = item >> 4, h = (item >> 1) & 7, dir = item & 1;
        int row0, t0, slen; chunk_rows(ci, row0, t0, slen);
        asm volatile("" ::: "memory");
        int lane_v; asm volatile("v_mbcnt_lo_u32_b32 %0, -1, 0\n\tv_mbcnt_hi_u32_b32 %0, -1, %0" : "=v"(lane_v));
        const int lane = lane_v, fr = lane & 15, fq = lane >> 4;
        const int d4 = 4 * (lane_v >> 4) - (lane_v & 15);
        const size_t dt = (size_t)(dir * NCHUNK + ci) * NH + h;
        const bf16_t* KTg = (const bf16_t*)(F.ws + WS_KT) + ((size_t)ci * NH + h) * 8192; const bf16_t* VTg = (const bf16_t*)(F.ws + WS_VT) + ((size_t)ci * NH + h) * 8192;
        {
            bf16x8 kf[4][4], qf[4][4];
#pragma unroll
            for (int mt = 0; mt < 4; ++mt)
#pragma unroll
                for (int ks = 0; ks < 4; ++ks) { const bf16_t* rp = QKV + (size_t)(row0 + 16 * mt + fr) * NQKV + h * 128 + 32 * ks + 8 * fq; kf[mt][ks] = *(const bf16x8*)(rp + 1024); qf[mt][ks] = *(const bf16x8*)rp; }
            float gc, beta, gtot; chunk_gates(F, row0, h, dir, lane, gc, beta, gtot);
            gs[lane] = gc; gs[64 + lane] = beta;
            { float* gcb = (float*)(F.ws + WS_GCB) + dt * 128; gcb[lane] = gc; gcb[64 + lane] = beta; }
            LDS_WAIT();
#pragma unroll
            for (int mi = 0; mi < (V == 3 ? 0 : 4); ++mi)
#pragma unroll
                for (int nj = 0; nj < 4; ++nj) {
                    if (dir == 0 ? (mi < nj) : (mi > nj)) continue;
                    f32x4 acc = {0.f, 0.f, 0.f, 0.f};
#pragma unroll
                    for (int ks = 0; ks < 4; ++ks) acc = __builtin_amdgcn_mfma_f32_16x16x32_bf16(kf[mi][ks], kf[nj][ks], acc, 0, 0, 0);
                    const int j = 16 * nj + fr; const float gj = gs[j];
#pragma unroll
                    for (int r = 0; r < 4; ++r) { const int i = 16 * mi + 4 * fq + r; const float gi = gs[i], bi = gs[64 + i];
                        const bool keep = (mi != nj) || (dir == 0 ? (d4 + r > 0) : (d4 + r < 0));
                        const float val = keep ? bi * acc[r] * __expf(gi - gj) : 0.f;
                        const int il = dir ? 63 - i : i, jl = dir ? 63 - j : j;
                        As[il * 64 + jl] = val; }
                }
            bf16_t* AT = (bf16_t*)(F.ws + WS_ATT) + dt * 4096;
#pragma unroll
            for (int mi = 0; mi < (V == 3 ? 0 : 4); ++mi) {
#pragma unroll
                for (int nj = 0; nj < 4; ++nj) {
                    const bool none = dir == 0 ? (mi < nj) : (mi > nj);
                    f32x4 acc = {0.f, 0.f, 0.f, 0.f};
                    if (!none) {
#pragma unroll
                        for (int ks = 0; ks < 4; ++ks) acc = __builtin_amdgcn_mfma_f32_16x16x32_bf16(kf[nj][ks], qf[mi][ks], acc, 0, 0, 0);
                    }
                    const int i = 16 * mi + fr; const float gi = gs[i];
                    float val[4];
#pragma unroll
                    for (int r = 0; r < 4; ++r) { const int j = 16 * nj + 4 * fq + r; const float gj = gs[j];
                        const bool keep = !none && ((mi != nj) || (dir == 0 ? (d4 + r <= 0) : (d4 + r >= 0)));
                        val[r] = keep ? acc[r] * __expf(gi - gj) : 0.f; }
                    u32x2 w; w.x = pk2(val[0], val[1]); w.y = pk2(val[2], val[3]);
                    *(u32x2*)(AT + i * 64 + 16 * nj + 4 * fq) = w;
                }
            }
        }
        bf16x8 ktf[8][2];
#pragma unroll
        for (int m8 = 0; m8 < 8; ++m8)
#pragma unroll
            for (int ks = 0; ks < 2; ++ks) ktf[m8][ks] = *(const bf16x8*)(KTg + (16 * m8 + fr) * 64 + 32 * ks + 8 * fq);
        LDS_WAIT();
        asm volatile("" ::: "memory");
        float t[64];
        const float lanef = (float)lane_v;
#pragma unroll
        for (int i = 0; i < 64; ++i) { float s0 = fmaxf(0.f, 1.f - fabsf(lanef - (float)i)), s1 = 0.f, s2 = 0.f, s3 = 0.f;
            asm volatile("" ::: "memory");
#pragma unroll
            for (int j = 0; j < (V == 1 ? 0 : i); ++j) { if (j == 32) asm volatile("" ::: "memory"); const float av = As[i * 64 + j];
                if ((j & 3) == 0) s0 -= av * t[j]; else if ((j & 3) == 1) s1 -= av * t[j]; else if ((j & 3) == 2) s2 -= av * t[j]; else s3 -= av * t[j]; }
            t[i] = (s0 + s1) + (s2 + s3); }
        bf16x8 vtf[8][2];
#pragma unroll
        for (int m8 = 0; m8 < 8; ++m8)
#pragma unroll
            for (int ks = 0; ks < 2; ++ks) vtf[m8][ks] = *(const bf16x8*)(VTg + (16 * m8 + fr) * 64 + 32 * ks + 8 * fq);
        {
            const int co = dir ? 63 - lane : lane;
            const float bco = gs[64 + co], sW = bco * __expf(gs[co]);
            LDS_WAIT();
            asm volatile("" ::: "memory");
            LAS unsigned char* Tl = (LAS unsigned char*)As;
#pragma unroll
            for (int i = 0; i < 64; ++i) { const int io = dir ? 63 - i : i;
                const int off = io * 128 + ((((co >> 3) ^ ((io >> 1) & 7))) << 4) + (co & 7) * 2;
                *(LAS bf16_t*)(Tl + off) = (bf16_t)f2bf(t[i] * sW); *(LAS bf16_t*)(Tl + 8192 + off) = (bf16_t)f2bf(t[i] * bco); }
            LDS_WAIT();
            asm volatile("" ::: "memory");
            bf16_t* Wg = (bf16_t*)(F.ws + WS_W) + dt * 8192; bf16_t* UTg = (bf16_t*)(F.ws + WS_UT) + dt * 8192;
            bf16x8 tf[4][2];
#pragma unroll
            for (int nt = 0; nt < 4; ++nt)
#pragma unroll
                for (int ks = 0; ks < 2; ++ks) { const int row = 16 * nt + fr, c = 4 * ks + fq; tf[nt][ks] = *(const LAS bf16x8*)(Tl + row * 128 + ((c ^ ((row >> 1) & 7)) << 4)); }
#pragma unroll
            for (int mtd = 0; mtd < (V == 2 ? 0 : 8); ++mtd) {
                const bf16x8 a0 = ktf[mtd][0], a1 = ktf[mtd][1];
#pragma unroll
                for (int nt = 0; nt < 4; ++nt) { f32x4 acc = {0.f, 0.f, 0.f, 0.f};
                    acc = __builtin_amdgcn_mfma_f32_16x16x32_bf16(a0, tf[nt][0], acc, 0, 0, 0); acc = __builtin_amdgcn_mfma_f32_16x16x32_bf16(a1, tf[nt][1], acc, 0, 0, 0);
                    u32x2 w; w.x = pk2(acc[0], acc[1]); w.y = pk2(acc[2], acc[3]);
                    if (V == 4) asm volatile("" :: "v"(w)); else *(u32x2*)(Wg + (16 * nt + fr) * 128 + 16 * mtd + 4 * fq) = w; }
            }
#pragma unroll
            for (int nt = 0; nt < 4; ++nt)
#pragma unroll
                for (int ks = 0; ks < 2; ++ks) { const int row = 16 * nt + fr, c = 4 * ks + fq; tf[nt][ks] = *(const LAS bf16x8*)(Tl + 8192 + row * 128 + ((c ^ ((row >> 1) & 7)) << 4)); }
#pragma unroll
            for (int ntd = 0; ntd < (V == 2 ? 0 : 8); ++ntd) {
                const bf16x8 b0 = vtf[ntd][0], b1 = vtf[ntd][1];
#pragma unroll
                for (int mt = 0; mt < 4; ++mt) { f32x4 acc = {0.f, 0.f, 0.f, 0.f};
                    acc = __builtin_amdgcn_mfma_f32_16x16x32_bf16(tf[mt][0], b0, acc, 0, 0, 0); acc = __builtin_amdgcn_mfma_f32_16x16x32_bf16(tf[mt][1], b1, acc, 0, 0, 0);
                    u32x2 w; w.x = pk2(acc[0], acc[1]); w.y = pk2(acc[2], acc[3]);
                    if (V == 4) asm volatile("" :: "v"(w)); else *(u32x2*)(UTg + (16 * ntd + fr) * 64 + 16 * mt + 4 * fq) = w; }
            }
        }
        LDS_WAIT();
    }
}

constexpr int SC_W = 0, SC_Q = 16384, SC_KT = 32768, SC_AT = 49152, SC_UT = 57344, SC_GC = 65536, SC_SLOT = 65792;
constexpr int SC_ST = 2 * SC_SLOT, ST_ROW = 272, SC_VN = SC_ST + 64 * ST_ROW, RT_ROW = 144, SC_END = SC_VN + 64 * RT_ROW;
static_assert(SC_END <= LDS_BYTES - 128, "scan LDS map");
#define SC_WAIT_V(n) asm volatile("s_waitcnt vmcnt(" #n ")" ::: "memory")
#define SC_BAR() do { asm volatile("s_waitcnt lgkmcnt(0)" ::: "memory"); __builtin_amdgcn_s_barrier(); asm volatile("" ::: "memory"); } while (0)
struct ScanCtx { int b, h, dir, half, mt, np, fr, fq, w, lane; unsigned offW[2], offQ[2], offK[2], offA; };
__device__ __forceinline__ int sc_chunk(const ScanCtx& c, int n) { return n < 4 ? 256 + c.b * 4 + (c.dir ? 3 - n : n) : c.b * 64 + (c.dir ? 67 - n : n - 4); }
__device__ __forceinline__ void sc_dma(Frame& F, const ScanCtx& c, int n, int slotoff) {
    const int ci = sc_chunk(c, n); int row0, t0, sl; chunk_rows(ci, row0, t0, sl);
    const size_t dt = ((size_t)(c.dir * NCHUNK + ci) * NH + c.h);
    const char* gW = (const char*)(F.ws + WS_W) + dt * 16384; const char* gQ = (const char*)(F.ws + WS_QKV) + ((size_t)row0 * NQKV + c.h * 128) * 2;
    const char* gK = (const char*)(F.ws + WS_KT) + ((size_t)ci * NH + c.h) * 16384; const char* gA = (const char*)(F.ws + WS_ATT) + dt * 8192;
    const char* gU = (const char*)(F.ws + WS_UT) + dt * 16384 + c.half * 8192; const char* gG = (const char*)(F.ws + WS_GCB) + dt * 512;
    LAS unsigned char* lds = F.lds + slotoff;
#pragma unroll
    for (int i = 0; i < 2; ++i) {
        __builtin_amdgcn_global_load_lds((const unsigned*)(gW + c.offW[i]), (LAS unsigned*)(lds + SC_W + (2 * c.w + i) * 1024), 16, 0, 0);
        __builtin_amdgcn_global_load_lds((const unsigned*)(gQ + c.offQ[i]), (LAS unsigned*)(lds + SC_Q + (2 * c.w + i) * 1024), 16, 0, 0);
        __builtin_amdgcn_global_load_lds((const unsigned*)(gK + c.offK[i]), (LAS unsigned*)(lds + SC_KT + (2 * c.w + i) * 1024), 16, 0, 0); }
    __builtin_amdgcn_global_load_lds((const unsigned*)(gA + c.offA), (LAS unsigned*)(lds + SC_AT + c.w * 1024), 16, 0, 0);
    __builtin_amdgcn_global_load_lds((const unsigned*)(gU + c.offA), (LAS unsigned*)(lds + SC_UT + c.w * 1024), 16, 0, 0);
    __builtin_amdgcn_global_load_lds((const unsigned*)(gG + c.lane * 4), (LAS unsigned*)(lds + SC_GC), 4, 0, 0);
}
__device__ __forceinline__ void sc_store_o(Frame& F, const ScanCtx& c, int n, const f32x4 (&o)[2]) {
    const int lc = c.dir ? 67 - n : n - 4;
    float* Obase = (float*)(F.ws + WS_O);
#pragma unroll
    for (int u = 0; u < 2; ++u) { float* op_ = Obase + ((size_t)c.dir * ML + (size_t)c.b * T + lc * 64 + 16 * c.mt + 4 * c.fq) * D + c.h * 128 + c.half * 64 + 16 * (2 * c.np + u) + c.fr;
#pragma unroll
        for (int r = 0; r < 4; ++r) op_[(size_t)r * D] = o[u][r]; }
}
__device__ __forceinline__ void moe_convert_queue(Frame& F) {
    unsigned* ctr = (unsigned*)(F.ws + WS_CTL) + 16384;
    LAS unsigned* slot = (LAS unsigned*)(F.lds + 65536);
    LAS unsigned char* scr = F.lds + F.wave * 8192;
    for (;;) {
        __syncthreads();
        if (F.tid == 0) slot[0] = __hip_atomic_fetch_add(ctr, 8u, __ATOMIC_RELAXED, __HIP_MEMORY_SCOPE_AGENT);
        __syncthreads();
        const unsigned t = slot[0] + (unsigned)F.wave;
        if (slot[0] >= 2u * TR_MOE) break;
        if (t < 2u * TR_MOE) tr_moe_job(F, t >= (unsigned)TR_MOE, (int)(t >= (unsigned)TR_MOE ? t - TR_MOE : t), scr);
    }
    __syncthreads();
}
__device__ __forceinline__ void phase_scan(Frame& F) {
    const int xcd = F.vcu >> 5, jcu = F.vcu & 31;
    if (F.G != 256 || jcu >= 16) {
        moe_convert_queue(F);
        if (F.G == 256) return;
    }
    ScanCtx c;
    c.lane = F.lane; c.fr = c.lane & 15; c.fq = c.lane >> 4; c.w = F.wave; c.mt = c.w >> 1; c.np = c.w & 1;
#pragma unroll
    for (int i = 0; i < 2; ++i) {
        { const int I = 2 * c.w + i, row = 4 * I + (c.lane >> 4), cc = (c.lane & 15) ^ (row & 15); c.offW[i] = (unsigned)(row * 256 + cc * 16); c.offQ[i] = (unsigned)(row * (NQKV * 2) + cc * 16); }
        { const int I = 2 * c.w + i, row = 8 * I + (c.lane >> 3), cc = (c.lane & 7) ^ ((row >> 1) & 7); c.offK[i] = (unsigned)(row * 128 + cc * 16); }
    }
    { const int row = 8 * c.w + (c.lane >> 3), cc = (c.lane & 7) ^ ((row >> 1) & 7); c.offA = (unsigned)(row * 128 + cc * 16); }
    const int lane = c.lane, fr = c.fr, fq = c.fq, mt = c.mt, np = c.np;
    LAS unsigned char* const lds = F.lds;
    const int item0 = (F.G == 256) ? xcd * 16 + jcu : F.vcu, nitem = (F.G == 256) ? 128 : F.G;
    for (int item = item0; item < 128; item += nitem) {
        c.half = item & 1; c.dir = (item >> 1) & 1; c.h = (item >> 2) & 7; c.b = item >> 5;
        for (int i = F.tid; i < 64 * ST_ROW / 4; i += NTHR) ((LAS unsigned*)(lds + SC_ST))[i] = 0u;
        f32x4 Sacc[2][2];
#pragma unroll
        for (int ud = 0; ud < 2; ++ud)
#pragma unroll
            for (int uv = 0; uv < 2; ++uv) Sacc[ud][uv] = (f32x4){0.f, 0.f, 0.f, 0.f};
        f32x4 Oprev[2] = {{0.f, 0.f, 0.f, 0.f}, {0.f, 0.f, 0.f, 0.f}};
        sc_dma(F, c, 0, 0);
        SC_WAIT_V(0);
        SC_BAR();
        sc_dma(F, c, 1, SC_SLOT);
#pragma unroll 1
        for (int n = 0; n < 68; ++n) {
            const bool latent = n >= 4;
            const int so = (n & 1) * SC_SLOT;
            LAS unsigned char* const slot = lds + so;
            LAS unsigned char* const St = lds + SC_ST;
            f32x4 xacc[2], oacc[2];
#pragma unroll
            for (int u = 0; u < 2; ++u) { xacc[u] = (f32x4){0.f, 0.f, 0.f, 0.f}; oacc[u] = (f32x4){0.f, 0.f, 0.f, 0.f}; }
            const int arow = 16 * mt + fr;
#pragma unroll
            for (int ks = 0; ks < 4; ++ks) {
                const int co = (((4 * ks + fq) ^ fr) << 4);
                const bf16x8 aW = *(const LAS bf16x8*)(slot + SC_W + arow * 256 + co), aQ = *(const LAS bf16x8*)(slot + SC_Q + arow * 256 + co);
#pragma unroll
                for (int u = 0; u < 2; ++u) { const bf16x8 bS = *(const LAS bf16x8*)(St + (16 * (2 * np + u) + fr) * ST_ROW + (32 * ks + 8 * fq) * 2);
                    xacc[u] = __builtin_amdgcn_mfma_f32_16x16x32_bf16(aW, bS, xacc[u], 0, 0, 0);
                    oacc[u] = __builtin_amdgcn_mfma_f32_16x16x32_bf16(aQ, bS, oacc[u], 0, 0, 0); } }
            const f32x4 gc4 = *(const LAS f32x4*)(slot + SC_GC + (16 * mt + 4 * fq) * 4);
            const float gtot = *(const LAS float*)(slot + SC_GC + (c.dir ? 0 : 63) * 4);
#pragma unroll
            for (int u = 0; u < 2; ++u) { const int urow = 16 * (2 * np + u) + fr, uc = 2 * mt + (fq >> 1);
              const u32x2 uw = *(const LAS u32x2*)(slot + SC_UT + urow * 128 + ((uc ^ ((urow >> 1) & 7)) << 4) + 8 * (fq & 1));
              u32x2 pw; pw.x = pk2(bflo(uw.x) - xacc[u][0], bfhi(uw.x) - xacc[u][1]); pw.y = pk2(bflo(uw.y) - xacc[u][2], bfhi(uw.y) - xacc[u][3]);
              *(LAS u32x2*)(lds + SC_VN + urow * RT_ROW + (16 * mt + 4 * fq) * 2) = pw; }
            bf16x8 aK[2][2], aA[2];
#pragma unroll
            for (int ks = 0; ks < 2; ++ks) {
                aA[ks] = *(const LAS bf16x8*)(slot + SC_AT + arow * 128 + ((((4 * ks + fq) ^ ((arow >> 1) & 7))) << 4));
                const f32x4 g0 = *(const LAS f32x4*)(slot + SC_GC + (32 * ks + 8 * fq) * 4), g1 = *(const LAS f32x4*)(slot + SC_GC + (32 * ks + 8 * fq + 4) * 4);
                float e[8];
#pragma unroll
                for (int j = 0; j < 4; ++j) { e[j] = __expf(gtot - g0[j]); e[4 + j] = __expf(gtot - g1[j]); }
#pragma unroll
                for (int ud = 0; ud < 2; ++ud) { const int krow = 16 * (2 * mt + ud) + fr;
                    const u32x4 kw = *(const LAS u32x4*)(slot + SC_KT + krow * 128 + ((((4 * ks + fq) ^ ((krow >> 1) & 7))) << 4));
                    u32x4 o; o.x = pk2(bflo(kw.x) * e[0], bfhi(kw.x) * e[1]); o.y = pk2(bflo(kw.y) * e[2], bfhi(kw.y) * e[3]); o.z = pk2(bflo(kw.z) * e[4], bfhi(kw.z) * e[5]); o.w = pk2(bflo(kw.w) * e[6], bfhi(kw.w) * e[7]);
                    aK[ud][ks] = __builtin_bit_cast(bf16x8, o); } }
            SC_BAR();
            if (n - 1 >= 4) sc_store_o(F, c, n - 1, Oprev);
            if (n + 2 < 68) sc_dma(F, c, n + 2, so);
            bf16x8 bV[2][2];
#pragma unroll
            for (int u = 0; u < 2; ++u)
#pragma unroll
                for (int ks = 0; ks < 2; ++ks) bV[u][ks] = *(const LAS bf16x8*)(lds + SC_VN + (16 * (2 * np + u) + fr) * RT_ROW + (32 * ks + 8 * fq) * 2);
            if (latent) {
#pragma unroll
                for (int u = 0; u < 2; ++u) {
#pragma unroll
                    for (int r = 0; r < 4; ++r) oacc[u][r] *= __expf(gc4[r]);
#pragma unroll
                    for (int ks = 0; ks < 2; ++ks) oacc[u] = __builtin_amdgcn_mfma_f32_16x16x32_bf16(aA[ks], bV[u][ks], oacc[u], 0, 0, 0);
                    Oprev[u] = oacc[u];
                }
            }
            const float egt = __expf(gtot);
#pragma unroll
            for (int ud = 0; ud < 2; ++ud)
#pragma unroll
                for (int uv = 0; uv < 2; ++uv) {
                    Sacc[ud][uv] *= egt;
#pragma unroll
                    for (int ks = 0; ks < 2; ++ks) Sacc[ud][uv] = __builtin_amdgcn_mfma_f32_16x16x32_bf16(aK[ud][ks], bV[uv][ks], Sacc[ud][uv], 0, 0, 0);
                    u32x2 pw; pw.x = pk2(Sacc[ud][uv][0], Sacc[ud][uv][1]); pw.y = pk2(Sacc[ud][uv][2], Sacc[ud][uv][3]);
                    *(LAS u32x2*)(St + (16 * (2 * np + uv) + fr) * ST_ROW + (16 * (2 * mt + ud) + 4 * fq) * 2) = pw;
                }
            if (n + 2 < 68) SC_WAIT_V(9); else SC_WAIT_V(0);
            SC_BAR();
        }
        sc_store_o(F, c, 67, Oprev);
        SC_WAIT_V(0);
        SC_BAR();
    }
    if (F.G == 256) moe_convert_queue(F);
}

__device__ __forceinline__ void phase_gdn_out(Frame& F) {
    const float* O0 = (const float*)(F.ws + WS_O); const float* O1 = O0 + (size_t)ML * D;
    const bf16_t* P = (const bf16_t*)(F.ws + WS_P);
    bf16_t* ON = (bf16_t*)(F.ws + WS_ON);
    const int lane = F.lane;
    const f32x4 gain = *(const f32x4*)(F.in[I_OGAIN] + ((4 * lane) & 127));
    for (int row = F.vcu * NWAVE + F.wave; row < ML; row += F.G * NWAVE) {
        f32x4 a[4], b[4]; load_row(O0 + (size_t)row * D, lane, a); load_row(O1 + (size_t)row * D, lane, b);
        f32x4 y[4];
#pragma unroll
        for (int j = 0; j < 4; ++j) { const f32x4 o = a[j] + b[j];
            float ss = (o[0] * o[0] + o[1] * o[1]) + (o[2] * o[2] + o[3] * o[3]);
            ss = row16_sum(ss); ss += __shfl_xor(ss, 16);
            const float rs = rsqrtf(ss * (1.f / DH) + EPS);
            const u32x2 zw = ((const u32x2*)(P + (size_t)row * NP + NQKV))[lane + 64 * j];
            const float z0 = bflo(zw.x), z1 = bfhi(zw.x), z2 = bflo(zw.y), z3 = bfhi(zw.y);
            y[j][0] = o[0] * rs * gain[0] * siluf(z0); y[j][1] = o[1] * rs * gain[1] * siluf(z1); y[j][2] = o[2] * rs * gain[2] * siluf(z2); y[j][3] = o[3] * rs * gain[3] * siluf(z3); }
        store_row_bf16(ON + (size_t)row * D, lane, y);
    }
}

__device__ __forceinline__ void phase_moe_pre(Frame& F, int l) {
    const float* MOD = (const float*)(F.ws + WS_MOD) + (size_t)l * 5 * 6144;
    const float* H = (const float*)(F.ws + WS_H);
    bf16_t* U = (bf16_t*)(F.ws + WS_U);
    float* AFF = (float*)(F.ws + WS_AFF);
    LAS float* wr = (LAS float*)F.lds;
    const float* wsrc = F.in[I_WR] + (size_t)l * D * NE;
    for (int i = F.tid; i < D * NE / 4; i += NTHR) { const int c = i >> 2, q = i & 3; *(LAS f32x4*)(wr + c * 16 + 4 * q + (c >> 2) * 4) = ((const f32x4*)wsrc)[i]; }
    __syncthreads();
    const int lane = F.lane;
    for (int row = F.vcu * NWAVE + F.wave; row < ML; row += F.G * NWAVE) {
        const int b = row / T, t = row % T;
        f32x4 v[4], y[4]; load_row(H + (size_t)row * D, lane, v);
        const float rstd = row_rstd(v);
        const float* m = MOD + (size_t)b * 6144;
        norm_mod(v, rstd, F.in[I_GFFN] + l * D, m + 3 * D, m + 4 * D, lane, y);
#pragma unroll
        for (int j = 0; j < 4; ++j) ((unsigned*)((unsigned char*)U + (size_t)row * D))[lane + 64 * j] = pk4_fp8(y[j][0], y[j][1], y[j][2], y[j][3]);
        float lg[16];
#pragma unroll
        for (int e = 0; e < 16; ++e) lg[e] = 0.f;
#pragma unroll
        for (int j = 0; j < 4; ++j) {
            asm volatile("" ::: "memory");
#pragma unroll
            for (int i = 0; i < 4; ++i) { const int c = 4 * lane + 256 * j + i; const float yv = y[j][i];
#pragma unroll
                for (int q = 0; q < 4; ++q) { const f32x4 wv = *(const LAS f32x4*)(wr + c * 16 + 4 * q + (c >> 2) * 4);
                    lg[4 * q] += yv * wv[0]; lg[4 * q + 1] += yv * wv[1]; lg[4 * q + 2] += yv * wv[2]; lg[4 * q + 3] += yv * wv[3]; } } }
        float mx = -1e30f;
#pragma unroll
        for (int e = 0; e < 16; ++e) { lg[e] = wave_sum(lg[e]); mx = fmaxf(mx, lg[e]); }
        float den = 0.f;
#pragma unroll
        for (int e = 0; e < 16; ++e) { lg[e] = __expf(lg[e] - mx); den += lg[e]; }
        const float inv = 1.f / den;
        float mine = 0.f;
#pragma unroll
        for (int e = 0; e < 16; ++e) mine = (lane == e) ? lg[e] * inv : mine;
        if (lane < 16) AFF[((size_t)b * NE + lane) * T + t] = mine;
    }
    __syncthreads();
}

__device__ __forceinline__ void phase_topk(Frame& F) {
    LAS unsigned* cnt = (LAS unsigned*)F.lds;
    const float* AFF = (const float*)(F.ws + WS_AFF);
    int* SLOT = (int*)(F.ws + WS_SLOT); int* IDX = (int*)(F.ws + WS_IDX); float* GATE = (float*)(F.ws + WS_GATE);
    for (int item = F.vcu; item < NB * NE; item += F.G) {
        const int b = item / NE, e = item % NE;
        unsigned key[8];
        { const u32x4* p = (const u32x4*)(AFF + (size_t)item * T + F.tid * 8); const u32x4 k0 = p[0], k1 = p[1];
          key[0] = k0.x; key[1] = k0.y; key[2] = k0.z; key[3] = k0.w; key[4] = k1.x; key[5] = k1.y; key[6] = k1.z; key[7] = k1.w; }
        unsigned thr = 0u;
        int par = 0;
        for (int bit = 30; bit >= 0; --bit) {
            const unsigned cand = thr | (1u << bit);
            int c = 0;
#pragma unroll
            for (int i = 0; i < 8; ++i) c += (key[i] >= cand) ? 1 : 0;
#pragma unroll
            for (int o = 1; o < 64; o <<= 1) c += __shfl_xor(c, o);
            if (F.lane == 0) cnt[par * 8 + F.wave] = (unsigned)c;
            __syncthreads();
            unsigned tot = 0;
#pragma unroll
            for (int w8 = 0; w8 < 8; ++w8) tot += cnt[par * 8 + w8];
            if (tot >= (unsigned)CAP) thr = cand;
            par ^= 1;
        }
        __syncthreads();
        int cg_ = 0, ce_ = 0;
#pragma unroll
        for (int i = 0; i < 8; ++i) { cg_ += key[i] > thr; ce_ += key[i] == thr; }
        unsigned pk = (unsigned)cg_ | ((unsigned)ce_ << 16), inc = pk;
#pragma unroll
        for (int o = 1; o < 64; o <<= 1) { const unsigned t = __shfl_up(inc, o); if (F.lane >= o) inc += t; }
        LAS unsigned* wtot = cnt + 64;
        if (F.lane == 63) wtot[F.wave] = inc;
        __syncthreads();
        unsigned base = 0, total = 0;
#pragma unroll
        for (int w8 = 0; w8 < 8; ++w8) { const unsigned v = wtot[w8]; if (w8 < F.wave) base += v; total += v; }
        const unsigned excl = base + inc - pk;
        int gt_before = excl & 0xffffu, eq_before = excl >> 16;
        const int need_eq = CAP - (int)(total & 0xffffu);
#pragma unroll
        for (int i = 0; i < 8; ++i) {
            const int t = F.tid * 8 + i;
            const bool isg = key[i] > thr, ise = key[i] == thr;
            const bool sel = isg || (ise && eq_before < need_eq);
            const int slot = gt_before + (eq_before < need_eq ? eq_before : need_eq);
            SLOT[(size_t)item * T + t] = sel ? slot : -1;
            if (sel) { IDX[item * CAP + slot] = t; GATE[(size_t)e * 2048 + b * CAP + slot] = __uint_as_float(key[i]); }
            gt_before += isg; eq_before += ise;
        }
        __syncthreads();
    }
}

__device__ __forceinline__ void phase_gather(Frame& F) {
    const unsigned char* U = (const unsigned char*)(F.ws + WS_U); unsigned char* XS = (unsigned char*)(F.ws + WS_XS); const int* IDX = (const int*)(F.ws + WS_IDX);
    for (int r = F.vcu * NWAVE + F.wave; r < MX; r += F.G * NWAVE) {
        const int e = r / 2048, b = (r % 2048) / CAP, s = r % CAP;
        const int t = IDX[(b * NE + e) * CAP + s];
        ((u32x4*)(XS + (size_t)r * D))[F.lane] = ((const u32x4*)(U + ((size_t)b * T + t) * D))[F.lane];
    }
}

__device__ __forceinline__ void phase_combine(Frame& F, int l) {
    const float* MOD = (const float*)(F.ws + WS_MOD);
    float* H = (float*)(F.ws + WS_H); const bf16_t* YS = (const bf16_t*)(F.ws + WS_YS); const int* SLOT = (const int*)(F.ws + WS_SLOT);
    bf16_t* U = (bf16_t*)(F.ws + WS_U);
    const int lane = F.lane;
    for (int row = F.vcu * NWAVE + F.wave; row < ML; row += F.G * NWAVE) {
        const int b = row / T, t = row % T;
        f32x4 v[4]; load_row(H + (size_t)row * D, lane, v);
        const int myslot = lane < NE ? SLOT[((size_t)b * NE + lane) * T + t] : -1;
        f32x4 acc[4];
#pragma unroll
        for (int j = 0; j < 4; ++j) acc[j] = (f32x4){0.f, 0.f, 0.f, 0.f};
        for (int e = 0; e < NE; ++e) { const int sl = __shfl(myslot, e);
            if (sl >= 0) { const u32x2* yp = (const u32x2*)(YS + ((size_t)e * 2048 + b * CAP + sl) * D);
#pragma unroll
                for (int j = 0; j < 4; ++j) { const u32x2 w = yp[lane + 64 * j]; acc[j][0] += bflo(w.x); acc[j][1] += bfhi(w.x); acc[j][2] += bflo(w.y); acc[j][3] += bfhi(w.y); } } }
        const float* gtf = MOD + ((size_t)l * 5 + b) * 6144 + 5 * D;
#pragma unroll
        for (int j = 0; j < 4; ++j) v[j] += ((const f32x4*)gtf)[lane + 64 * j] * acc[j];
        const float rstd = row_rstd(v);
        if (l == 0) {
#pragma unroll
            for (int j = 0; j < 4; ++j) ((f32x4*)(H + (size_t)row * D))[lane + 64 * j] = v[j];
            const float* m = MOD + ((size_t)5 + b) * 6144; f32x4 y[4];
            norm_mod(v, rstd, F.in[I_GMIX] + D, m, m + D, lane, y);
            store_row_bf16(U + (size_t)row * D, lane, y);
        } else {
#pragma unroll
            for (int j = 0; j < 4; ++j) ((f32x4*)(F.out + (size_t)row * D))[lane + 64 * j] = v[j] * rstd * ((const f32x4*)F.in[I_FING])[lane + 64 * j];
        }
    }
}

__device__ __forceinline__ void phase_pool(Frame& F) {
    const bf16_t* U = (const bf16_t*)(F.ws + WS_U); bf16_t* PD = (bf16_t*)(F.ws + WS_ON);
    LAS float* Vs = (LAS float*)F.lds;
    const int cp = F.tid & 127, cgp = F.tid >> 7;
    for (int item = F.vcu; item < 1024; item += F.G) {
        const int gi = item >> 8, b = (item >> 6) & 3, r = item & 63;
        const int w = 2 << gi, lo = w >> 1, hi = w - lo;
        const int r_lo = r - lo < 0 ? 0 : r - lo, r_hi = r + hi > 64 ? 64 : r + hi;
        float s0[16], s1[16]; unsigned self[16];
#pragma unroll
        for (int i = 0; i < 16; ++i) { s0[i] = 0.f; s1[i] = 0.f; }
        const bf16_t* base = U + ((size_t)b * T + cgp * 16) * D + gi * 256 + 2 * cp;
        for (int rr = r_lo; rr < r_hi; ++rr) {
#pragma unroll
            for (int i = 0; i < 16; ++i) { const unsigned x = *(const unsigned*)(base + ((size_t)rr * 64 + i) * D); s0[i] += bflo(x); s1[i] += bfhi(x); }
        }
#pragma unroll
        for (int i = 0; i < 16; ++i) { self[i] = *(const unsigned*)(base + ((size_t)r * 64 + i) * D); *(LAS f32x2*)(Vs + (cgp * 16 + i) * 256 + 2 * cp) = (f32x2){s0[i], s1[i]}; }
        __syncthreads();
        const float inv_r = 1.f / (float)(r_hi - r_lo);
#pragma unroll
        for (int i = 0; i < 16; ++i) { const int c = cgp * 16 + i;
            const int c_lo = c - lo < 0 ? 0 : c - lo, c_hi = c + hi > 64 ? 64 : c + hi;
            float a0 = 0.f, a1 = 0.f;
            for (int cc = c_lo; cc < c_hi; ++cc) { const f32x2 x = *(const LAS f32x2*)(Vs + cc * 256 + 2 * cp); a0 += x[0]; a1 += x[1]; }
            const float sc = inv_r / (float)(c_hi - c_lo);
            *(unsigned*)(PD + ((size_t)b * T + r * 64 + c) * D + gi * 256 + 2 * cp) = pk2(a0 * sc - bflo(self[i]), a1 * sc - bfhi(self[i])); }
        __syncthreads();
    }
}

constexpr int NPHASE = 22;
__global__ void __launch_bounds__(NTHR, 2) mega_fwd(Args args) {
    extern __shared__ __attribute__((aligned(16))) unsigned char lds_raw[];
    cg::grid_group grid = cg::this_grid();
    Frame F;
    F.lds = (LAS unsigned char*)lds_raw;
    F.tid = threadIdx.x; F.lane = F.tid & 63; F.wave = __builtin_amdgcn_readfirstlane(F.tid >> 6);
    F.G = gridDim.x; { const int bx = blockIdx.x; F.vcu = (F.G % 8 == 0) ? (bx % 8) * (F.G / 8) + bx / 8 : bx; }
#pragma unroll
    for (int i = 0; i < 21; ++i) F.in[i] = args.in[i];
    F.out = args.out; F.ws = args.ws;
    const int lo = args.ph_lo, hi = args.ph_hi;
    if (F.tid < 32) ((LAS unsigned*)(F.lds + MISC_OFF))[F.tid] = 0u;
    __syncthreads();
    XcdBarrier bar = xcd_barrier_post((unsigned*)(F.ws + WS_CTL) + 4096, (volatile LAS unsigned*)(F.lds + MISC_OFF));
#ifndef PHMASK
#define PHMASK 0x3fffff
#endif
#define IN(k) ((((PHMASK) >> (k)) & 1) && lo <= (k) && (k) < hi)
#define SEAM(k) do { if (IN(k) && IN((k) + 1)) { if ((k) == 0) grid.sync(); else xcd_barrier(bar); } F.tid = threadIdx.x; asm volatile("" : "+v"(F.tid)); F.lane = F.tid & 63; F.wave = __builtin_amdgcn_readfirstlane(F.tid >> 6); } while (0)
    const int c = (int)blockIdx.x;

#ifndef REP_PHASE
#define REP_PHASE (-1)
#endif
#ifndef REP_N
#define REP_N 2
#endif
#define RUN(k, ...) for (int _r = 0; _r < ((k) == REP_PHASE ? 1 + REP_N : 1); ++_r) { if (IN(k)) { __VA_ARGS__ } SEAM(k); }
    RUN(0, {
        if (F.vcu < 192) mod_item(F, F.vcu);
        LAS unsigned char* scr = F.lds + F.wave * 8192;
        const int gw = F.vcu * NWAVE + F.wave, NGW = F.G * NWAVE;
        for (int t = gw; t < TR_SMALL; t += NGW) tr_small_job(F, t, scr);
    })
    RUN(1, phase_norm0(F);)
    RUN(2, {
        pg8::Gemm g{(const bf16_t*)(F.ws + WS_U), (const bf16_t*)(F.ws + WS_WIN), D, D};
        pg8::DenseOrder S; S.init(MA / 256, NPROJ_PAD / 256, F.G, c);
        pg8::EpiInProj E{(bf16_t*)(F.ws + WS_P), (float*)(F.ws + WS_AB)};
        pg8::gemm_phase(F.lds, g, S, E);
    })
    RUN(3, phase_conv(F);)
#ifndef PREPV
    RUN(4, phase_prep<0>(F);)
#else
    RUN(4, phase_prep<PREPV>(F); __syncthreads(); phase_prep<PREPV>(F); __syncthreads(); phase_prep<0>(F);)
#endif
    RUN(5, phase_scan(F);)
    RUN(6, phase_gdn_out(F);)
    RUN(7, {
        pg8::Gemm g{(const bf16_t*)(F.ws + WS_ON), (const bf16_t*)(F.ws + WS_WOUT), D, D};
        pg8::DenseOrder S; S.init(ML / 256, D / 256, F.G, c);
        pg8::EpiOutProj E{F.in[I_X], (float*)(F.ws + WS_H), (const float*)(F.ws + WS_MOD) + 2 * D};
        pg8::gemm_phase(F.lds, g, S, E);
    })
#pragma unroll
    for (int l = 0; l < 2; ++l) {
        if (l == 1) {
            RUN(14, phase_pool(F);)
            RUN(15, {
                pg8::Gemm g{(const bf16_t*)(F.ws + WS_ON), (const bf16_t*)(F.ws + WS_POOLW), D, 256};
                pg8::PoolOrder S{F.G, c};
                pg8::EpiPool E{(float*)(F.ws + WS_H), (const float*)(F.ws + WS_MOD) + 5 * 6144 + 2 * D, F.in[I_POOLS]};
                pg8::gemm_phase(F.lds, g, S, E);
            })
        }
        const int p0 = l == 0 ? 8 : 16;
        RUN(p0, {
            phase_moe_pre(F, l);

        })
        RUN(p0 + 1, phase_topk(F);)
        RUN(p0 + 2, phase_gather(F);)
        RUN(p0 + 3, {
            pg8::Gemm g{(const bf16_t*)(F.ws + WS_XS), (const bf16_t*)(F.ws + WS_WMOE + (size_t)l * WMOE_LAYER), D, D};
            pg8::MoeUpOrder S{F.G, c};
            pg8::EpiSwiglu E{(unsigned char*)(F.ws + WS_HID)};
            pg8::gemm_phase<pg8::EpiSwiglu, pg8::MoeUpOrder, true>(F.lds, g, S, E);
        })
        RUN(p0 + 4, {
            pg8::Gemm g{(const bf16_t*)(F.ws + WS_HID), (const bf16_t*)(F.ws + WS_W2T + (size_t)l * WMOE_LAYER), DF, DF};
            pg8::MoeDownOrder S{F.G, c};
            pg8::EpiDown E{(bf16_t*)(F.ws + WS_YS), (const float*)(F.ws + WS_GATE)};
            pg8::gemm_phase<pg8::EpiDown, pg8::MoeDownOrder, true>(F.lds, g, S, E);
        })
        RUN(p0 + 5, phase_combine(F, l);)
    }
#undef IN
#undef SEAM
#undef RUN
}

extern "C" void kernel_launch(void* const* d_in, const int* in_sizes, int n_in, void* d_out, int out_size, void* d_ws, size_t ws_size, hipStream_t stream) {
    static int grid = 0;
    if (grid == 0) {
        if (n_in != 21 || ws_size < WS_END) { fprintf(stderr, "kernel_launch: unexpected inputs (n_in %d, ws %zu)\n", n_in, ws_size); grid = -1; return; }
        int dev = 0, cus = 0, per_cu = 0;
        hipGetDevice(&dev);
        hipDeviceGetAttribute(&cus, hipDeviceAttributeMultiprocessorCount, dev);
        hipFuncSetAttribute((const void*)mega_fwd, hipFuncAttributeMaxDynamicSharedMemorySize, LDS_BYTES);
        hipOccupancyMaxActiveBlocksPerMultiprocessor(&per_cu, (const void*)mega_fwd, NTHR, LDS_BYTES);
        if (per_cu < 1) { fprintf(stderr, "kernel_launch: occupancy query says %d blocks per CU\n", per_cu); per_cu = 1; }
        grid = cus;
        (void)hipGetLastError();
    }
    if (grid < 0) return;
    hipMemsetAsync((char*)d_ws + WS_CTL, 0, 1 * MiB, stream);
    Args a{};
    for (int i = 0; i < 21; ++i) a.in[i] = (const float*)d_in[i];
    a.out = (float*)d_out; a.ws = (unsigned char*)d_ws;
#if MK_N_LAUNCHES == 1
    a.ph_lo = 0; a.ph_hi = NPHASE;
    void* params[] = {&a};
    hipError_t e = hipLaunchCooperativeKernel((const void*)mega_fwd, dim3(grid), dim3(NTHR), params, LDS_BYTES, stream);
    if (e != hipSuccess) fprintf(stderr, "cooperative launch failed: %s (grid %d)\n", hipGetErrorString(e), grid);
#else
    for (int p = 0; p < NPHASE; ++p) {
        a.ph_lo = p; a.ph_hi = p + 1;
        void* params[] = {&a};
        hipError_t e = hipLaunchCooperativeKernel((const void*)mega_fwd, dim3(grid), dim3(NTHR), params, LDS_BYTES, stream);
        if (e != hipSuccess) { fprintf(stderr, "launch %d failed: %s (grid %d)\n", p, hipGetErrorString(e), grid); break; }
    }
#endif
}
```

```cpp
#include <hip/hip_runtime.h>
#include <hip/hip_cooperative_groups.h>
#include <cstdio>
namespace cg = cooperative_groups;

#ifndef MK_N_LAUNCHES
#define MK_N_LAUNCHES 1
#endif

#define LAS __attribute__((address_space(3)))
typedef unsigned short bf16_t;
typedef short bf16x8 __attribute__((ext_vector_type(8)));
typedef float f32x4 __attribute__((ext_vector_type(4)));
typedef float f32x2 __attribute__((ext_vector_type(2)));
typedef unsigned u32x4 __attribute__((ext_vector_type(4)));
typedef unsigned u32x2 __attribute__((ext_vector_type(2)));

constexpr int NB = 4, T = 4096, D = 1024, TC = 256, NH = 8, DH = 128, NE = 16, CAP = 512, DF = 2048;
constexpr int ML = NB * T;
constexpr int MC = NB * TC;
constexpr int MA = ML + MC;
constexpr int NPROJ = 4128, NPROJ_PAD = 4352, NQKV = 3072, NP = 4096;
constexpr int NCHUNK = MA / 64;
constexpr int MX = NB * NE * CAP;
constexpr float EPS = 1e-6f;
constexpr int NTHR = 512, NWAVE = 8;

constexpr size_t MiB = 1u << 20;
constexpr size_t WS_CTL = 0;
constexpr size_t WS_MOD = 1 * MiB;
constexpr size_t WS_AB = 2 * MiB;
constexpr size_t WS_GCB = 5 * MiB;
constexpr size_t WS_AFF = 5 * MiB;
constexpr size_t WS_SLOT = 6 * MiB;
constexpr size_t WS_IDX = 7 * MiB;
constexpr size_t WS_GATE = 7 * MiB + 256 * 1024;
constexpr size_t WS_WIN = 8 * MiB;
constexpr size_t WS_WOUT = 17 * MiB;
constexpr size_t WS_POOLW = 19 * MiB;
constexpr size_t WS_WMOE = 20 * MiB;
constexpr size_t WS_W2T = WS_WMOE + 64 * MiB;
constexpr size_t WMOE_LAYER = 96 * MiB;
constexpr size_t WS_H = 212 * MiB;
constexpr size_t WS_U = 276 * MiB;
constexpr size_t WS_ON = 310 * MiB;
constexpr size_t WS_G = 342 * MiB;
constexpr size_t WS_P = WS_G;
constexpr size_t WS_QKV = WS_G + 136 * MiB;
constexpr size_t WS_KT = WS_G + 238 * MiB;
constexpr size_t WS_VT = WS_G + 272 * MiB;
constexpr size_t WS_W = WS_G + 306 * MiB;
constexpr size_t WS_UT = WS_G + 374 * MiB;
constexpr size_t WS_ATT = WS_G + 442 * MiB;
constexpr size_t WS_O = WS_G + 476 * MiB;
constexpr size_t WS_XS = WS_G;
constexpr size_t WS_HID = WS_G + 64 * MiB;
constexpr size_t WS_YS = WS_G + 192 * MiB;
constexpr size_t WS_END = WS_G + 604 * MiB;

constexpr int LDS_BYTES = 163840;

typedef __bf16 bf16v2 __attribute__((ext_vector_type(2)));
__device__ __forceinline__ unsigned pk2(float lo, float hi) { const f32x2 v = {lo, hi}; return __builtin_bit_cast(unsigned, __builtin_convertvector(v, bf16v2)); }
__device__ __forceinline__ unsigned f2bf(float f) { return pk2(f, 0.f) & 0xffffu; }
__device__ __forceinline__ float bflo(unsigned w) { return __uint_as_float(w << 16); }
__device__ __forceinline__ float bfhi(unsigned w) { return __uint_as_float(w & 0xffff0000u); }
__device__ __forceinline__ float bf1(bf16_t b) { return __uint_as_float(((unsigned)b) << 16); }
#define DPP_ADD(v, ctrl) ((v) + __builtin_bit_cast(float, __builtin_amdgcn_update_dpp(0, __builtin_bit_cast(int, (v)), (ctrl), 0xf, 0xf, true)))
__device__ __forceinline__ float row16_sum(float v) {
    v = DPP_ADD(v, 0xB1); v = DPP_ADD(v, 0x4E); v = DPP_ADD(v, 0x141); v = DPP_ADD(v, 0x140); return v;
}
__device__ __forceinline__ float wave_sum(float v) { v = row16_sum(v); v += __shfl_xor(v, 16); v += __shfl_xor(v, 32); return v; }
__device__ __forceinline__ float siluf(float x) { return x * __builtin_amdgcn_rcpf(1.f + __expf(-x)); }
__device__ __forceinline__ float sigmoidf(float x) { return __builtin_amdgcn_rcpf(1.f + __expf(-x)); }
__device__ __forceinline__ float softplusf(float x) { return fmaxf(x, 0.f) + log1pf(__expf(-fabsf(x))); }
__device__ __forceinline__ float rnd_fp8(float x) { const int p = __builtin_amdgcn_cvt_pk_fp8_f32(x, x, 0, false); return __builtin_amdgcn_cvt_f32_fp8(p, 0); }
__device__ __forceinline__ unsigned pk4_fp8(float a, float b, float c, float d) { int p = __builtin_amdgcn_cvt_pk_fp8_f32(a, b, 0, false); p = __builtin_amdgcn_cvt_pk_fp8_f32(c, d, p, true); return (unsigned)p; }
#define LDS_WAIT() asm volatile("s_waitcnt lgkmcnt(0)" ::: "memory")

namespace pg8 {
constexpr int BM = 256, BK = 64, HALF = 128, HTB = HALF * BK * 2, STAGE_BYTES = 8 * HTB;
__device__ __forceinline__ int lds_byte(int r, int c) { const int st = (r >> 4) * 2 + (c >> 5), rr = r & 15, cc = c & 31, ob = rr * 64 + cc * 2; return st * 1024 + (ob ^ (((ob >> 9) & 1) << 5)); }
__device__ __forceinline__ void stage_rc(int b, int& R, int& C) { const int st = b / 1024, sb = b % 1024, swz = sb ^ (((sb >> 9) & 1) << 5); R = (st >> 1) * 16 + swz / 64; C = (st & 1) * 32 + (swz % 64) / 2; }

struct Unit { int pm, pn, pb, ak; };
struct Gemm { const bf16_t* A; const bf16_t* Bt; int lda, K; };

#ifndef PG8_SP2
#define PG8_SP2 true
#endif
#ifndef PG8_ALIGN
#define PG8_ALIGN true
#endif
typedef int v8i32 __attribute__((ext_vector_type(8)));
__device__ __forceinline__ v8i32 cat8(const bf16x8 lo, const bf16x8 hi) { const u32x4 a = __builtin_bit_cast(u32x4, lo), b = __builtin_bit_cast(u32x4, hi); return (v8i32){(int)a.x, (int)a.y, (int)a.z, (int)a.w, (int)b.x, (int)b.y, (int)b.z, (int)b.w}; }
template <class Epi, class Sched, bool FP8 = false, bool ALIGN_EPI = PG8_ALIGN, bool SP2 = PG8_SP2>
__device__ __forceinline__ void gemm_phase(LAS unsigned char* lds, const Gemm g, const Sched& S, const Epi& E) {
    constexpr int ES = FP8 ? 1 : 2;
    int tid = threadIdx.x; asm volatile("" : "+v"(tid));
    const int wid = __builtin_amdgcn_readfirstlane(tid >> 6), lane = tid & 63, wr = wid >> 2, wc = wid & 3, fr = lane & 15, fq = lane >> 4;
    int K = g.K, lda = g.lda; asm volatile("" : "+s"(K), "+s"(lda));
    const int nt = K * ES / (BK * 2);
    unsigned voffA[2], voffB[2];
#pragma unroll
    for (int i = 0; i < 2; ++i) { int R, C; stage_rc(tid * 16 + i * 8192, R, C); voffA[i] = (unsigned)(R * lda * ES + C * 2); voffB[i] = (unsigned)(R * K * ES + C * 2); }
    const size_t kstep = (size_t)(BK * 2);
    const size_t hsA = (size_t)HALF * lda * ES, hsB = (size_t)HALF * K * ES;
    const unsigned ldsw = (unsigned)wid * 1024u;
    const int aoff0 = FP8 ? lds_byte(wr * 64 + fr, fq * 16) : lds_byte(wr * 64 + fr, fq * 8), aoff1 = FP8 ? aoff0 + 16 : aoff0 + 1024;
    const int boff0 = FP8 ? lds_byte(wc * 32 + fr, fq * 16) : lds_byte(wc * 32 + fr, fq * 8), boff1 = FP8 ? boff0 + 16 : boff0 + 1024;
#define PG8_SA(b, h) (((b) * 2 + (h)) * HTB)
#define PG8_SB(b, h) ((4 + (b) * 2 + (h)) * HTB)
#define PG8_STAGE(bufoff, gbase, voff) do { _Pragma("unroll") for (int _i = 0; _i < 2; ++_i) \
        __builtin_amdgcn_global_load_lds((const unsigned*)((const char*)(gbase) + (voff)[_i]), (LAS unsigned*)(lds + (bufoff) + ldsw + _i * 8192), 16, 0, 0); } while (0)
#define PG8_LD2(dst, off0, off1) do { if constexpr (FP8) { dst.v = *(const LAS v8i32*)(lds + (off0)); } else { const u32x4 _lo = *(const LAS u32x4*)(lds + (off0)), _hi = *(const LAS u32x4*)(lds + (off1)); \
        dst.v = (v8i32){(int)_lo.x, (int)_lo.y, (int)_lo.z, (int)_lo.w, (int)_hi.x, (int)_hi.y, (int)_hi.z, (int)_hi.w}; } } while (0)
#define PG8_LDA(dst, b, h) do { if constexpr (FP8) { _Pragma("unroll") for (int m = 0; m < 4; ++m) PG8_INS8(A32, m, *(const LAS v8i32*)(lds + PG8_SA(b, h) + aoff0 + m * 2048)); } \
        else { _Pragma("unroll") for (int m = 0; m < 4; ++m) PG8_LD2(dst[m], PG8_SA(b, h) + aoff0 + m * 2048, PG8_SA(b, h) + aoff1 + m * 2048); } } while (0)
#define PG8_LDB(dst, b, h) do { if constexpr (FP8) { _Pragma("unroll") for (int n = 0; n < 2; ++n) PG8_INS8(B32, 2 * (h) + n, *(const LAS v8i32*)(lds + PG8_SB(b, h) + boff0 + n * 2048)); } \
        else { _Pragma("unroll") for (int n = 0; n < 2; ++n) PG8_LD2(dst[n], PG8_SB(b, h) + boff0 + n * 2048, PG8_SB(b, h) + boff1 + n * 2048); } } while (0)
#define PG8_MMA(ai, bj, At, Bt) do { __builtin_amdgcn_s_setprio(1); _Pragma("unroll") for (int m = 0; m < 4; ++m) _Pragma("unroll") for (int n = 0; n < 2; ++n) { \
        if constexpr (FP8) { const v8i32 _b = PG8_SUB8(B32, 2 * (bj) + n), _a = PG8_SUB8(A32, m); \
            asm volatile("v_mfma_scale_f32_16x16x128_f8f6f4 %0, %1, %2, %0, %3, %3 op_sel_hi:[0,0,0]" : "+v"(acc[ai][bj][m][n]) : "v"(_b), "v"(_a), "v"(sc1)); } \
        else { acc[ai][bj][m][n] = __builtin_amdgcn_mfma_f32_16x16x32_bf16(Bt[n].lo(), At[m].lo(), acc[ai][bj][m][n], 0, 0, 0); acc[ai][bj][m][n] = __builtin_amdgcn_mfma_f32_16x16x32_bf16(Bt[n].hi(), At[m].hi(), acc[ai][bj][m][n], 0, 0, 0); } } \
        __builtin_amdgcn_s_setprio(0); } while (0)
#define PG8_WAIT_V(n) asm volatile("s_waitcnt vmcnt(" #n ")" ::: "memory")
#define PG8_WAIT_L(n) asm volatile("s_waitcnt lgkmcnt(" #n ")" ::: "memory")
#define PG8_BAR __builtin_amdgcn_s_barrier()
#define PG8_SCHED __builtin_amdgcn_sched_barrier(0)
    Unit cur, nxt; int ui = 0;
    if (!S.next(0, cur)) return;
    f32x4 acc[2][2][4][2];
#pragma unroll
    for (int a = 0; a < 2; ++a)
#pragma unroll
        for (int b = 0; b < 2; ++b)
#pragma unroll
            for (int m = 0; m < 4; ++m)
#pragma unroll
                for (int n = 0; n < 2; ++n) acc[a][b][m][n] = (f32x4){0.f, 0.f, 0.f, 0.f};
    struct Frag2 { v8i32 v;
        __device__ __forceinline__ bf16x8 lo() const { const u32x4 t = {(unsigned)v[0], (unsigned)v[1], (unsigned)v[2], (unsigned)v[3]}; return __builtin_bit_cast(bf16x8, t); }
        __device__ __forceinline__ bf16x8 hi() const { const u32x4 t = {(unsigned)v[4], (unsigned)v[5], (unsigned)v[6], (unsigned)v[7]}; return __builtin_bit_cast(bf16x8, t); } };
    Frag2 At[4], B0[2], B1[2];
    typedef int v32i32 __attribute__((ext_vector_type(32)));
    int sc1 = 0x7f7f7f7f; asm volatile("" : "+v"(sc1));
    v32i32 A32, B32;
#define PG8_SUB8(V, i) ((v8i32){V[8 * (i)], V[8 * (i) + 1], V[8 * (i) + 2], V[8 * (i) + 3], V[8 * (i) + 4], V[8 * (i) + 5], V[8 * (i) + 6], V[8 * (i) + 7]})
#define PG8_INS8(V, i, X) do { const v8i32 _x = (X); _Pragma("unroll") for (int _e = 0; _e < 8; ++_e) V[8 * (i) + _e] = _x[_e]; } while (0)
    const char* cA = (const char*)g.A + ((size_t)cur.pm * BM * lda + cur.ak) * ES; const char* cB = (const char*)g.Bt + (size_t)cur.pb * BM * K * ES;
    if constexpr (SP2) {
        PG8_STAGE(PG8_SB(0, 0), cB, voffB); PG8_STAGE(PG8_SB(0, 1), cB + hsB, voffB); PG8_STAGE(PG8_SA(0, 0), cA, voffA); PG8_STAGE(PG8_SA(0, 1), cA + hsA, voffA);
        if (wr == 1) PG8_BAR;
        PG8_WAIT_V(2); PG8_BAR;
        PG8_STAGE(PG8_SB(1, 0), cB + kstep, voffB); PG8_STAGE(PG8_SA(1, 0), cA + kstep, voffA); PG8_STAGE(PG8_SB(1, 1), cB + hsB + kstep, voffB);
        PG8_WAIT_V(6); PG8_BAR;
    } else {
        PG8_STAGE(PG8_SB(0, 0), cB, voffB); PG8_STAGE(PG8_SA(0, 0), cA, voffA); PG8_STAGE(PG8_SB(0, 1), cB + hsB, voffB); PG8_STAGE(PG8_SA(0, 1), cA + hsA, voffA);
        if (wr == 1) PG8_BAR;
        PG8_WAIT_V(4); PG8_BAR;
        PG8_STAGE(PG8_SB(1, 0), cB + kstep, voffB); PG8_STAGE(PG8_SA(1, 0), cA + kstep, voffA); PG8_STAGE(PG8_SB(1, 1), cB + hsB + kstep, voffB);
        PG8_WAIT_V(6); PG8_BAR;
    }
    for (;;) {
        const bool has_next = S.next(ui + 1, nxt);
        const char* nA = has_next ? (const char*)g.A + ((size_t)nxt.pm * BM * lda + nxt.ak) * ES : cA; const char* nB = has_next ? (const char*)g.Bt + (size_t)nxt.pb * BM * K * ES : cB;
#pragma unroll 1
        for (int t = 0; t < nt; t += 2) {
            const bool last = (t == nt - 2);
            const char* a1 = cA + (size_t)(t + 1) * kstep;
            const char* a2 = last ? nA : cA + (size_t)(t + 2) * kstep; const char* b2 = last ? nB : cB + (size_t)(t + 2) * kstep;
            const char* a3 = a2 + kstep; const char* b3 = b2 + kstep;
            if constexpr (SP2) {
            PG8_LDB(B0, 0, 0); PG8_LDB(B1, 0, 1); PG8_SCHED; PG8_LDA(At, 0, 0); PG8_STAGE(PG8_SA(1, 1), a1 + hsA, voffA);
            PG8_WAIT_V(8); PG8_WAIT_L(0); PG8_BAR; PG8_MMA(0, 0, At, B0); PG8_MMA(0, 1, At, B1); PG8_BAR; PG8_SCHED;
            PG8_LDA(At, 0, 1); PG8_STAGE(PG8_SB(0, 0), b2, voffB); PG8_STAGE(PG8_SB(0, 1), b2 + hsB, voffB); PG8_STAGE(PG8_SA(0, 0), a2, voffA);
            PG8_WAIT_V(8); PG8_WAIT_L(0); PG8_BAR; PG8_MMA(1, 0, At, B0); PG8_MMA(1, 1, At, B1); PG8_BAR; PG8_SCHED;
            PG8_LDB(B0, 1, 0); PG8_LDB(B1, 1, 1); PG8_SCHED; PG8_LDA(At, 1, 0); PG8_STAGE(PG8_SA(0, 1), a2 + hsA, voffA);
            PG8_WAIT_V(8); PG8_WAIT_L(0); PG8_BAR; PG8_MMA(0, 0, At, B0); PG8_MMA(0, 1, At, B1); PG8_BAR; PG8_SCHED;
            PG8_LDA(At, 1, 1); PG8_STAGE(PG8_SB(1, 0), b3, voffB); PG8_STAGE(PG8_SB(1, 1), b3 + hsB, voffB); PG8_STAGE(PG8_SA(1, 0), a3, voffA);
            PG8_WAIT_V(8); PG8_WAIT_L(0); PG8_BAR; PG8_MMA(1, 0, At, B0); PG8_MMA(1, 1, At, B1); PG8_BAR; PG8_SCHED;
            } else {
            PG8_LDB(B0, 0, 0); PG8_SCHED; PG8_LDA(At, 0, 0); PG8_STAGE(PG8_SA(1, 1), a1 + hsA, voffA);
            PG8_WAIT_L(8); PG8_BAR; PG8_WAIT_L(0); PG8_MMA(0, 0, At, B0); PG8_BAR; PG8_SCHED;
            PG8_LDB(B1, 0, 1); PG8_STAGE(PG8_SB(0, 0), b2, voffB);
            PG8_BAR; PG8_WAIT_L(0); PG8_MMA(0, 1, At, B1); PG8_BAR;
            PG8_LDA(At, 0, 1); PG8_STAGE(PG8_SA(0, 0), a2, voffA);
            PG8_BAR; PG8_WAIT_L(0); PG8_MMA(1, 0, At, B0); PG8_BAR; PG8_SCHED;
            PG8_STAGE(PG8_SB(0, 1), b2 + hsB, voffB);
            PG8_WAIT_V(6); PG8_BAR; PG8_MMA(1, 1, At, B1); PG8_BAR;
            PG8_LDB(B0, 1, 0); PG8_SCHED; PG8_LDA(At, 1, 0); PG8_STAGE(PG8_SA(0, 1), a2 + hsA, voffA);
            PG8_WAIT_L(8); PG8_BAR; PG8_WAIT_L(0); PG8_MMA(0, 0, At, B0); PG8_BAR; PG8_SCHED;
            PG8_LDB(B1, 1, 1); PG8_STAGE(PG8_SB(1, 0), b3, voffB);
            PG8_BAR; PG8_WAIT_L(0); PG8_MMA(0, 1, At, B1); PG8_BAR;
            PG8_LDA(At, 1, 1); PG8_STAGE(PG8_SA(1, 0), a3, voffA);
            PG8_BAR; PG8_WAIT_L(0); PG8_MMA(1, 0, At, B0); PG8_BAR; PG8_SCHED;
            PG8_STAGE(PG8_SB(1, 1), b3 + hsB, voffB);
            PG8_WAIT_V(6); PG8_BAR; PG8_MMA(1, 1, At, B1); PG8_BAR;
            }
        }
        if constexpr (ALIGN_EPI) { if (wr == 0) PG8_BAR; }
        if constexpr (FP8) asm volatile("s_nop 15\n\ts_nop 15" ::: "memory");
        E(acc, cur, wr, wc, fr, fq);
        if (!has_next) break;
#pragma unroll
        for (int a = 0; a < 2; ++a)
#pragma unroll
            for (int b = 0; b < 2; ++b)
#pragma unroll
                for (int m = 0; m < 4; ++m)
#pragma unroll
                    for (int n = 0; n < 2; ++n) acc[a][b][m][n] = (f32x4){0.f, 0.f, 0.f, 0.f};
        cur = nxt; cA = nA; cB = nB; ++ui;
        if constexpr (ALIGN_EPI) { if (wr == 1) PG8_BAR; }
    }
    PG8_WAIT_V(0);
    if constexpr (!ALIGN_EPI) { if (wr == 0) PG8_BAR; }
    PG8_BAR;
#undef PG8_SA
#undef PG8_SB
#undef PG8_STAGE
#undef PG8_LDA
#undef PG8_LDB
#undef PG8_MMA
#undef PG8_WAIT_V
#undef PG8_WAIT_L
#undef PG8_BAR
#undef PG8_SCHED
#undef PG8_SUB8
#undef PG8_INS8
}

struct DenseOrder {
    int nM, nN, nwg, G, c;
    __device__ __forceinline__ void init(int nM_, int nN_, int G_, int c_) { nM = nM_; nN = nN_; nwg = nM * nN; G = G_; c = c_; }
    __device__ __forceinline__ bool next(int i, Unit& u) const {
        const long L = (long)i * G + c; if (L >= nwg) return false;
        int wgid = (int)L; { const int q = nwg / 8, r = nwg % 8, xcd = wgid % 8, off = wgid / 8; wgid = (xcd < r ? xcd * (q + 1) : r * (q + 1) + (xcd - r) * q) + off; }
        const int nig = 8 * nN, gid = wgid / nig, fm = gid * 8, gsz = (nM - fm) < 8 ? (nM - fm) : 8;
        u.pm = fm + ((wgid % nig) % gsz); u.pn = (wgid % nig) / gsz; u.pb = u.pn; u.ak = 0; return true;
    }
};
struct MoeUpOrder {
    int G, c;
    __device__ __forceinline__ bool next(int i, Unit& u) const {
        const int L = i * G + c; if (L >= 2048) return false;
        const int r = L / 256, cc = L % 256, x = cc % 8, j = cc / 8;
        const int e = 2 * x + (r >> 2); u.pm = e * 8 + (j & 7); u.pn = 4 * (r & 3) + (j >> 3); u.pb = e * 16 + u.pn; u.ak = 0; return true;
    }
};
struct MoeDownOrder {
    int G, c;
    __device__ __forceinline__ bool next(int i, Unit& u) const {
        const int L = i * G + c; if (L >= 512) return false;
        const int r = L / 256, cc = L % 256, x = cc % 8, j = cc / 8;
        const int e = 8 * r + x; u.pm = e * 8 + (j & 7); u.pn = j >> 3; u.pb = e * 4 + u.pn; u.ak = 0; return true;
    }
};
struct PoolOrder {
    int G, c;
    __device__ __forceinline__ bool next(int i, Unit& u) const {
        const int L = i * G + c; if (L >= 256) return false;
        const int x = L % 8, j = L / 8; u.pm = x * 8 + (j & 7); u.pn = j >> 3; u.pb = u.pn; u.ak = u.pn * 256; return true;
    }
};

struct EpiInProj {
    bf16_t* P; float* AB;
    __device__ __forceinline__ void operator()(const f32x4 (&acc)[2][2][4][2], const Unit& u, int wr, int wc, int fr, int fq) const {
        const int row0 = u.pm * BM + wr * 64 + fr;
        if (u.pn < 16) {
            const int col0 = u.pn * BM + wc * 32 + 4 * fq;
#pragma unroll
            for (int ai = 0; ai < 2; ++ai)
#pragma unroll
                for (int m = 0; m < 4; ++m) { bf16_t* rowp = P + (size_t)(row0 + ai * HALF + m * 16) * NP + col0;
#pragma unroll
                    for (int bj = 0; bj < 2; ++bj)
#pragma unroll
                        for (int n = 0; n < 2; ++n) { const f32x4 v = acc[ai][bj][m][n]; u32x2 w; w.x = pk2(v[0], v[1]); w.y = pk2(v[2], v[3]); *(u32x2*)(rowp + bj * HALF + n * 16) = w; } }
        } else if (wc == 0) {
#pragma unroll
            for (int ai = 0; ai < 2; ++ai)
#pragma unroll
                for (int m = 0; m < 4; ++m) { float* rowp = AB + (size_t)(row0 + ai * HALF + m * 16) * 32 + 4 * fq;
#pragma unroll
                    for (int n = 0; n < 2; ++n) *(f32x4*)(rowp + n * 16) = acc[ai][0][m][n]; }
        }
    }
};
struct EpiOutProj {
    const float* X; float* H; const float* gate;
    __device__ __forceinline__ void operator()(const f32x4 (&acc)[2][2][4][2], const Unit& u, int wr, int wc, int fr, int fq) const {
        const int row0 = u.pm * BM + wr * 64 + fr, col0 = u.pn * BM + wc * 32 + 4 * fq;
        const float* gp = gate + (size_t)(u.pm * BM / T) * 6144 + col0;
        f32x4 gv[2][2];
#pragma unroll
        for (int bj = 0; bj < 2; ++bj)
#pragma unroll
            for (int n = 0; n < 2; ++n) gv[bj][n] = *(const f32x4*)(gp + bj * HALF + n * 16);
#pragma unroll
        for (int ai = 0; ai < 2; ++ai)
#pragma unroll
            for (int m = 0; m < 4; ++m) { const size_t off = (size_t)(row0 + ai * HALF + m * 16) * D + col0;
#pragma unroll
                for (int bj = 0; bj < 2; ++bj)
#pragma unroll
                    for (int n = 0; n < 2; ++n) { const f32x4 xv = *(const f32x4*)(X + off + bj * HALF + n * 16); *(f32x4*)(H + off + bj * HALF + n * 16) = xv + gv[bj][n] * acc[ai][bj][m][n]; }
                asm volatile("" ::: "memory"); }
    }
};
struct EpiSwiglu {
    unsigned char* HID;
    __device__ __forceinline__ void operator()(const f32x4 (&acc)[2][2][4][2], const Unit& u, int wr, int wc, int fr, int fq) const {
        asm volatile("" : "+v"(fr), "+v"(fq));
        const int row0 = u.pm * BM + wr * 64 + fr, col0 = u.pn * HALF + wc * 32 + 4 * fq;
#pragma unroll
        for (int ai = 0; ai < 2; ++ai)
#pragma unroll
            for (int m = 0; m < 4; ++m) { unsigned char* rowp = HID + (size_t)(row0 + ai * HALF + m * 16) * DF + col0;
#pragma unroll
                for (int n = 0; n < 2; ++n) { const f32x4 g = acc[ai][0][m][n], up = acc[ai][1][m][n]; float h[4];
#pragma unroll
                    for (int j = 0; j < 4; ++j) h[j] = siluf(g[j] * 0.03125f) * (up[j] * 0.03125f);
                    *(unsigned*)(rowp + n * 16) = pk4_fp8(h[0], h[1], h[2], h[3]); } }
    }
};
struct EpiDown {
    bf16_t* YS; const float* gates;
    __device__ __forceinline__ void operator()(const f32x4 (&acc)[2][2][4][2], const Unit& u, int wr, int wc, int fr, int fq) const {
        asm volatile("" : "+v"(fr), "+v"(fq));
        const int row0 = u.pm * BM + wr * 64 + fr, col0 = u.pn * BM + wc * 32 + 4 * fq;
#pragma unroll
        for (int ai = 0; ai < 2; ++ai)
#pragma unroll
            for (int m = 0; m < 4; ++m) { const int row = row0 + ai * HALF + m * 16; const float gt = gates[row] * 0.03125f; bf16_t* rowp = YS + (size_t)row * D + col0;
#pragma unroll
                for (int bj = 0; bj < 2; ++bj)
#pragma unroll
                    for (int n = 0; n < 2; ++n) { const f32x4 v = acc[ai][bj][m][n] * gt; u32x2 w; w.x = pk2(v[0], v[1]); w.y = pk2(v[2], v[3]); *(u32x2*)(rowp + bj * HALF + n * 16) = w; } }
    }
};
struct EpiPool {
    float* H; const float* gate; const float* scale;
    __device__ __forceinline__ void operator()(const f32x4 (&acc)[2][2][4][2], const Unit& u, int wr, int wc, int fr, int fq) const {
        const int row0 = u.pm * BM + wr * 64 + fr, col0 = u.pn * BM + wc * 32 + 4 * fq;
        const float* gp = gate + (size_t)(u.pm * BM / T) * 6144 + col0;
        f32x4 gv[2][2];
#pragma unroll
        for (int bj = 0; bj < 2; ++bj)
#pragma unroll
            for (int n = 0; n < 2; ++n) gv[bj][n] = *(const f32x4*)(gp + bj * HALF + n * 16) * *(const f32x4*)(scale + col0 + bj * HALF + n * 16);
#pragma unroll
        for (int ai = 0; ai < 2; ++ai)
#pragma unroll
            for (int m = 0; m < 4; ++m) { const size_t off = (size_t)(row0 + ai * HALF + m * 16) * D + col0;
#pragma unroll
                for (int bj = 0; bj < 2; ++bj)
#pragma unroll
                    for (int n = 0; n < 2; ++n) { float* p = H + off + bj * HALF + n * 16; const f32x4 hv = *(const f32x4*)p; *(f32x4*)p = hv + gv[bj][n] * acc[ai][bj][m][n]; }
                asm volatile("" ::: "memory"); }
    }
};
}


#define XB_TMO      128
#define XB_XCNT(j)  (256  + 64 * (j))
#define XB_XSUB(j)  (1280 + 64 * (j))
#define XB_XGEN(j)  (2304 + 64 * (j))
#define XB_TOP      3328
#define XB_TOPGEN   3392
#define XCD_BAR_WORDS 3456
#define XB_SPIN_CAP (1u << 20)
__device__ __forceinline__ unsigned xb_ld(unsigned* p)              { return __hip_atomic_load(p, __ATOMIC_RELAXED, __HIP_MEMORY_SCOPE_AGENT); }
__device__ __forceinline__ unsigned xb_add(unsigned* p, unsigned v) { return __hip_atomic_fetch_add(p, v, __ATOMIC_RELAXED, __HIP_MEMORY_SCOPE_AGENT); }
__device__ __forceinline__ unsigned xb_xcc_id() { return (unsigned)__builtin_amdgcn_s_getreg((3 << 11) | 20) & 0xFu; }
#define XB_SPIN(cond, bar) do { unsigned _sp = 0; while (cond) { __builtin_amdgcn_s_sleep(1); \
    if ((++_sp & 255u) == 0u) { if (xb_ld(&(bar)[XB_TMO])) break; if (_sp > XB_SPIN_CAP) { atomicAdd(&(bar)[XB_TMO], 1u); break; } } } } while (0)
struct XcdBarrier { unsigned* bar; unsigned x; volatile LAS unsigned* st; };
__device__ __forceinline__ XcdBarrier xcd_barrier_post(unsigned* bar, volatile LAS unsigned* st) {
    XcdBarrier b; b.bar = bar; b.x = xb_xcc_id(); b.st = st;
    if (threadIdx.x == 0) (void)xb_add(&bar[XB_XCNT(b.x)], 1u);
    return b;
}
__device__ __forceinline__ void xcd_barrier_complete(unsigned* bar, unsigned x, unsigned& nloc, unsigned& nx) {
    const unsigned G = gridDim.x * gridDim.y * gridDim.z;
    unsigned sum, cnt, mine, sp = 0u;
    for (;;) {
        sum = 0u; cnt = 0u; mine = 0u;
#pragma unroll
        for (unsigned j = 0; j < 16; ++j) { const unsigned c = xb_ld(&bar[XB_XCNT(j)]); sum += c; cnt += (c > 0u) ? 1u : 0u; mine = (j == x) ? c : mine; }
        if (sum == G) break;
        __builtin_amdgcn_s_sleep(1);
        if ((++sp & 255u) == 0u) { if (xb_ld(&bar[XB_TMO])) break; if (sp > XB_SPIN_CAP) { atomicAdd(&bar[XB_TMO], 1u); break; } }
    }
    nloc = mine > 0u ? mine : 1u; nx = cnt > 0u ? cnt : 1u;
}
__device__ __forceinline__ void xcd_barrier(const XcdBarrier& b) {
    asm volatile("s_waitcnt vmcnt(0)" ::: "memory");
    __syncthreads();
    if (threadIdx.x == 0) {
        unsigned* bar = b.bar;
        __builtin_amdgcn_s_waitcnt(0);
        unsigned nloc = b.st[0], nx = b.st[1];
        if (nloc == 0u) { xcd_barrier_complete(bar, b.x, nloc, nx); b.st[0] = nloc; b.st[1] = nx; }
        const unsigned old = xb_add(&bar[XB_XSUB(b.x)], 1u);
        const unsigned gen = old / nloc;
        if (old + 1u == (gen + 1u) * nloc) {
            __builtin_amdgcn_fence(__ATOMIC_RELEASE, "agent");
            asm volatile("s_waitcnt vmcnt(0)" ::: "memory");
            const unsigned og = xb_add(&bar[XB_TOP], 1u);
            const unsigned tg = og / nx;
            if (og + 1u == (tg + 1u) * nx) xb_add(&bar[XB_TOPGEN], 1u);
            else XB_SPIN(xb_ld(&bar[XB_TOPGEN]) == tg, bar);
            __builtin_amdgcn_fence(__ATOMIC_ACQUIRE, "agent");
            xb_add(&bar[XB_XGEN(b.x)], 1u);
            asm volatile("s_waitcnt vmcnt(0)" ::: "memory");
        } else {
            XB_SPIN(xb_ld(&bar[XB_XGEN(b.x)]) == gen, bar);
            __builtin_amdgcn_fence(__ATOMIC_ACQUIRE, "agent");
            asm volatile("s_waitcnt vmcnt(0)" ::: "memory");
        }
    }
    __syncthreads();
}
constexpr int MISC_OFF = LDS_BYTES - 128;

struct Args { const float* in[21]; float* out; unsigned char* ws; int ph_lo, ph_hi; };
enum { I_X = 0, I_C, I_CTX, I_CCTX, I_WMOD, I_BMOD, I_GMIX, I_GFFN, I_WIN, I_CONVW, I_ALOG, I_DTB, I_OGAIN, I_WOUT, I_POOLW, I_POOLS, I_WR, I_WG, I_WU, I_WD, I_FING };

struct Frame {
    LAS unsigned char* lds;
    int tid, lane, wave, G, vcu;
    const float* in[21]; float* out; unsigned char* ws;
};

__device__ __forceinline__ void tr_tile(const float* __restrict__ src, int ld_src, int n_valid, bf16_t* dst_row0, int ld_dst, int k0, LAS unsigned char* scr, int lane, float q8 = 0.f) {
    const int nq = lane & 15, g = lane >> 4;
    f32x4 v[2][8];
    const bool ok = 4 * nq < n_valid;
#pragma unroll
    for (int i1 = 0; i1 < 2; ++i1)
#pragma unroll
        for (int i2 = 0; i2 < 8; ++i2) { const int k = 32 * i1 + 8 * g + i2;
            v[i1][i2] = ok ? *(const f32x4*)(src + (size_t)(k0 + k) * ld_src + 4 * nq) : (f32x4){0.f, 0.f, 0.f, 0.f}; }
#ifdef EMU_FP8
    if (q8 > 0.f) { const float iq = 1.f / q8;
#pragma unroll
        for (int i1 = 0; i1 < 2; ++i1)
#pragma unroll
            for (int i2 = 0; i2 < 8; ++i2)
#pragma unroll
                for (int j = 0; j < 4; ++j) v[i1][i2][j] = rnd_fp8(v[i1][i2][j] * q8) * iq; }
#endif
#pragma unroll
    for (int j = 0; j < 4; ++j)
#pragma unroll
        for (int i1 = 0; i1 < 2; ++i1) {
            u32x4 w; w.x = pk2(v[i1][0][j], v[i1][1][j]); w.y = pk2(v[i1][2][j], v[i1][3][j]); w.z = pk2(v[i1][4][j], v[i1][5][j]); w.w = pk2(v[i1][6][j], v[i1][7][j]);
            const int n = 4 * nq + j, c = 4 * i1 + g;
            *(LAS u32x4*)(scr + n * 128 + ((c ^ (nq & 7)) * 16)) = w; }
    LDS_WAIT();
#pragma unroll
    for (int it = 0; it < 8; ++it) { const int n = (lane >> 3) + 8 * it, c = lane & 7;
        const u32x4 w = *(const LAS u32x4*)(scr + n * 128 + ((c ^ ((n >> 2) & 7)) * 16));
        *(u32x4*)(dst_row0 + (size_t)n * ld_dst + k0 + 8 * c) = w; }
    LDS_WAIT();
}

__device__ __forceinline__ void tr_tile8(const float* __restrict__ src, int ld_src, unsigned char* dst_row0, int ld_dst, int k0, LAS unsigned char* scr, int lane) {
    const int nq = lane & 15, g = lane >> 4;
    f32x4 v[2][8];
#pragma unroll
    for (int i1 = 0; i1 < 2; ++i1)
#pragma unroll
        for (int i2 = 0; i2 < 8; ++i2) { const int k = 32 * i1 + 8 * g + i2; v[i1][i2] = *(const f32x4*)(src + (size_t)(k0 + k) * ld_src + 4 * nq) * 32.f; }
#pragma unroll
    for (int j = 0; j < 4; ++j)
#pragma unroll
        for (int i1 = 0; i1 < 2; ++i1) {
            u32x2 w; w.x = pk4_fp8(v[i1][0][j], v[i1][1][j], v[i1][2][j], v[i1][3][j]); w.y = pk4_fp8(v[i1][4][j], v[i1][5][j], v[i1][6][j], v[i1][7][j]);
            const int n = 4 * nq + j, c = 4 * i1 + g;
            *(LAS u32x2*)(scr + n * 64 + ((((c >> 1) ^ (nq & 3))) << 4) + (c & 1) * 8) = w; }
    LDS_WAIT();
#pragma unroll
    for (int it = 0; it < 4; ++it) { const int n = (lane >> 2) + 16 * it, p = lane & 3;
        const u32x4 w = *(const LAS u32x4*)(scr + n * 64 + ((p ^ ((n >> 2) & 3)) << 4));
        *(u32x4*)(dst_row0 + (size_t)n * ld_dst + k0 + 16 * p) = w; }
    LDS_WAIT();
}

constexpr int TR_SMALL = 16 * 68 + 256 + 64;
__device__ __forceinline__ void tr_small_job(Frame& F, int t, LAS unsigned char* scr) {
    if (t < 1088) { const int nt = t / 16, kt = t % 16; int nv = NPROJ - 64 * nt; nv = nv < 0 ? 0 : (nv > 64 ? 64 : nv);
        tr_tile(F.in[I_WIN] + 64 * nt, NPROJ, nv, (bf16_t*)(F.ws + WS_WIN) + (size_t)64 * nt * D, D, 64 * kt, scr, F.lane); return; }
    t -= 1088;
    if (t < 256) { const int nt = t / 16, kt = t % 16;
        tr_tile(F.in[I_WOUT] + 64 * nt, D, 64, (bf16_t*)(F.ws + WS_WOUT) + (size_t)64 * nt * D, D, 64 * kt, scr, F.lane); return; }
    t -= 256;
    { const int gi = t / 16, nt = (t % 16) / 4, kt = t % 4;
        tr_tile(F.in[I_POOLW] + (size_t)gi * 65536 + 64 * nt, 256, 64, (bf16_t*)(F.ws + WS_POOLW) + (size_t)gi * 65536 + (size_t)64 * nt * 256, 256, 64 * kt, scr, F.lane); }
}
constexpr int TR_MOE = 24576;
__device__ __forceinline__ void tr_moe_job(Frame& F, int l, int t, LAS unsigned char* scr) {
    if (t < 16384) { const int e = t / 1024, r = t % 1024, which = r / 512, r2 = r % 512, nt = r2 / 16, kt = r2 % 16;
        const float* src = F.in[which ? I_WU : I_WG] + (size_t)(l * NE + e) * D * DF + 64 * nt;
        unsigned char* dst = (unsigned char*)(F.ws + WS_WMOE) + (size_t)l * WMOE_LAYER + ((size_t)e * 4096 + (nt >> 1) * 256 + which * 128 + (nt & 1) * 64) * D;
        tr_tile8(src, DF, dst, D, 64 * kt, scr, F.lane); return; }
    t -= 16384;
    { const int e = t / 512, r = t % 512, nt = r / 32, kt = r % 32;
        const float* src = F.in[I_WD] + (size_t)(l * NE + e) * DF * D + 64 * nt;
        unsigned char* dst = (unsigned char*)(F.ws + WS_W2T) + (size_t)l * WMOE_LAYER + ((size_t)e * D + 64 * nt) * DF;
        tr_tile8(src, D, dst, DF, 64 * kt, scr, F.lane); }
}

__device__ __forceinline__ void mod_item(Frame& F, int item) {
    LAS float* act = (LAS float*)(F.lds + 65536);
    LAS float* part = (LAS float*)(F.lds + 65536 + 20480);
    const int l = item / 96, cgp = item % 96;
    for (int i = F.tid; i < 5 * D; i += NTHR) { const int r = i >> 10, k = i & 1023; const float x = r < 4 ? F.in[I_C][r * D + k] : F.in[I_CCTX][k]; act[i] = siluf(x); }
    __syncthreads();
    const int j = cgp * 64 + F.lane;
    const float* w = F.in[I_WMOD] + (size_t)l * D * 6144 + j;
    float a0 = 0.f, a1 = 0.f, a2 = 0.f, a3 = 0.f, a4 = 0.f;
    const int kb = F.wave * 128;
#pragma unroll 8
    for (int k = 0; k < 128; ++k) { const float wv = w[(size_t)(kb + k) * 6144];
        a0 += act[kb + k] * wv; a1 += act[D + kb + k] * wv; a2 += act[2 * D + kb + k] * wv; a3 += act[3 * D + kb + k] * wv; a4 += act[4 * D + kb + k] * wv; }
    LAS float* pp = part + F.wave * 320 + F.lane;
    pp[0] = a0; pp[64] = a1; pp[128] = a2; pp[192] = a3; pp[256] = a4;
    __syncthreads();
    if (F.tid < 320) { const int r = F.tid >> 6, ln = F.tid & 63; float s = 0.f;
#pragma unroll
        for (int w8 = 0; w8 < 8; ++w8) s += part[w8 * 320 + r * 64 + ln];
        const int jj = cgp * 64 + ln;
        ((float*)(F.ws + WS_MOD))[(size_t)(l * 5 + r) * 6144 + jj] = s + F.in[I_BMOD][l * 6144 + jj]; }
    __syncthreads();
}

__device__ __forceinline__ void load_row(const float* p, int lane, f32x4 (&v)[4]) {
#pragma unroll
    for (int j = 0; j < 4; ++j) v[j] = ((const f32x4*)p)[lane + 64 * j];
}
__device__ __forceinline__ float row_rstd(const f32x4 (&v)[4]) {
    float s = 0.f;
#pragma unroll
    for (int j = 0; j < 4; ++j) s += (v[j][0] * v[j][0] + v[j][1] * v[j][1]) + (v[j][2] * v[j][2] + v[j][3] * v[j][3]);
    return rsqrtf(wave_sum(s) * (1.f / D) + EPS);
}
__device__ __forceinline__ void norm_mod(const f32x4 (&v)[4], float rstd, const float* g, const float* sh, const float* sc, int lane, f32x4 (&y)[4]) {
#pragma unroll
    for (int j = 0; j < 4; ++j) { const f32x4 gv = ((const f32x4*)g)[lane + 64 * j], shv = ((const f32x4*)sh)[lane + 64 * j], scv = ((const f32x4*)sc)[lane + 64 * j];
        y[j] = v[j] * rstd * gv * (1.f + scv) + shv; }
}
__device__ __forceinline__ void store_row_bf16(bf16_t* p, int lane, const f32x4 (&y)[4]) {
#pragma unroll
    for (int j = 0; j < 4; ++j) { u32x2 w; w.x = pk2(y[j][0], y[j][1]); w.y = pk2(y[j][2], y[j][3]); ((u32x2*)p)[lane + 64 * j] = w; }
}

__device__ __forceinline__ void phase_norm0(Frame& F) {
    const float* MOD = (const float*)(F.ws + WS_MOD);
    bf16_t* U = (bf16_t*)(F.ws + WS_U);
    for (int row = F.vcu * NWAVE + F.wave; row < MA; row += F.G * NWAVE) {
        const float* src; int mr;
        if (row < ML) { src = F.in[I_X] + (size_t)row * D; mr = row / T; } else { src = F.in[I_CTX] + (size_t)(row - ML) * D; mr = 4; }
        f32x4 v[4], y[4]; load_row(src, F.lane, v);
        const float rstd = row_rstd(v);
        const float* m = MOD + (size_t)mr * 6144;
        norm_mod(v, rstd, F.in[I_GMIX], m, m + D, F.lane, y);
        store_row_bf16(U + (size_t)row * D, F.lane, y);
    }
}

__device__ __forceinline__ void chunk_rows(int ci, int& row0, int& t0, int& slen) {
    if (ci < 256) { row0 = ci * 64; t0 = (ci & 63) * 64; slen = T; } else { const int cc = ci - 256; row0 = ML + cc * 64; t0 = (cc & 3) * 64; slen = TC; }
}
__device__ __forceinline__ void phase_conv(Frame& F) {
    const bf16_t* P = (const bf16_t*)(F.ws + WS_P);
    bf16_t* QKV = (bf16_t*)(F.ws + WS_QKV);
    bf16_t* KT = (bf16_t*)(F.ws + WS_KT);
    bf16_t* VT = (bf16_t*)(F.ws + WS_VT);
    LAS unsigned* kts = (LAS unsigned*)(F.lds + F.wave * 16896);
    LAS bf16_t* kts16 = (LAS bf16_t*)kts;
    const int lane = F.lane;
    for (int item = F.vcu * NWAVE + F.wave; item < NCHUNK * 24; item += F.G * NWAVE) {
        const int ci = item / 24, slab = item % 24;
        int row0, t0, slen; chunk_rows(ci, row0, t0, slen);
        const int col = slab * 128 + 2 * lane;
        float w0[5], w1[5];
#pragma unroll
        for (int j = 0; j < 5; ++j) { const f32x2 wv = *(const f32x2*)(F.in[I_CONVW] + (size_t)j * NQKV + col); w0[j] = wv[0]; w1[j] = wv[1]; }
        const bf16_t* src = P + (size_t)row0 * NP + col;
        unsigned rowsv[68];
#pragma unroll
        for (int j = 0; j < 68; ++j) { const int tt = j - 2; rowsv[j] = (t0 + tt >= 0 && t0 + tt < slen) ? *(const unsigned*)(src + (long)tt * NP) : 0u; }
        const int kind = slab >> 3;
#pragma unroll 1
        for (int t8 = 0; t8 < 64; t8 += 8) {
#pragma unroll
            for (int q = 0; q < 8; ++q) {
                const int tt = t8 + q;
                float y0 = 0.f, y1 = 0.f;
#pragma unroll
                for (int j = 0; j < 5; ++j) { y0 += w0[j] * bflo(rowsv[q + j]); y1 += w1[j] * bfhi(rowsv[q + j]); }
                y0 = siluf(y0); y1 = siluf(y1);
                if (kind < 2) { const float ss = wave_sum(y0 * y0 + y1 * y1); float sc = rsqrtf(ss + EPS); if (kind == 0) sc *= 0.08838834764831845f; y0 *= sc; y1 *= sc; }
                const unsigned pk = pk2(y0, y1);
                *(unsigned*)(QKV + (size_t)(row0 + tt) * NQKV + col) = pk;
                if (kind >= 1) { kts16[(2 * lane) * 66 + tt] = (bf16_t)(pk & 0xffffu); kts16[(2 * lane + 1) * 66 + tt] = (bf16_t)(pk >> 16); }
            }
#pragma unroll
            for (int j = 0; j < 60; ++j) rowsv[j] = rowsv[j + 8];
        }
        if (kind >= 1) {
            LDS_WAIT();
            unsigned* dst = (unsigned*)((kind == 1 ? KT : VT) + ((size_t)ci * NH + (slab & 7)) * 128 * 64);
#pragma unroll 8
            for (int it = 0; it < 64; ++it) { const int dk = 2 * it + (lane >> 5), dw = lane & 31; dst[dk * 32 + dw] = kts[dk * 33 + dw]; }
            LDS_WAIT();
        }
    }
}

__device__ __forceinline__ void chunk_gates(Frame& F, int row0, int h, int dir, int lane, float& gc, float& beta, float& gtot) {
    const float* ab = (const float*)(F.ws + WS_AB) + (size_t)(row0 + lane) * 32 + dir * 16 + h;
    const float a = ab[0], bb = ab[8];
    const float g = -__expf(F.in[I_ALOG][dir * NH + h]) * softplusf(a + F.in[I_DTB][dir * NH + h]);
    beta = sigmoidf(bb);
    float s = g;
#pragma unroll
    for (int o = 1; o < 64; o <<= 1) { const float t = __builtin_bit_cast(float, __builtin_amdgcn_ds_bpermute((lane - o) << 2, __builtin_bit_cast(int, s))); if (lane >= o) s += t; }
    gtot = __builtin_bit_cast(float, __builtin_amdgcn_readlane(__builtin_bit_cast(int, s), 63));
    gc = dir ? (gtot - s + g) : s;
}

template <int V> __device__ __forceinline__ void phase_prep(Frame& F) {
    const bf16_t* QKV = (const bf16_t*)(F.ws + WS_QKV);
    LAS float* As = (LAS float*)(F.lds + F.wave * 17408);
    LAS float* gs = (LAS float*)(F.lds + F.wave * 17408 + 16384);
#pragma unroll 1
    for (int item = F.vcu * NWAVE + F.wave; item < NCHUNK * NH * 2; item += F.G * NWAVE) {
        const int ci = item >> 4, h = (item >> 1) & 7, dir = item & 1;
        int row0, t0, slen; chunk_rows(ci, row0, t0, slen);
        asm volatile("" ::: "memory");
        int lane_v; asm volatile("v_mbcnt_lo_u32_b32 %0, -1, 0\n\tv_mbcnt_hi_u32_b32 %0, -1, %0" : "=v"(lane_v));
        const int lane = lane_v, fr = lane & 15, fq = lane >> 4;
        const int d4 = 4 * (lane_v >> 4) - (lane_v & 15);
        const size_t dt = (size_t)(dir * NCHUNK + ci) * NH + h;
        const bf16_t* KTg = (const bf16_t*)(F.ws + WS_KT) + ((size_t)ci * NH + h) * 8192; const bf16_t* VTg = (const bf16_t*)(F.ws + WS_VT) + ((size_t)ci * NH + h) * 8192;
        {
            bf16x8 kf[4][4], qf[4][4];
#pragma unroll
            for (int mt = 0; mt < 4; ++mt)
#pragma unroll
                for (int ks = 0; ks < 4; ++ks) { const bf16_t* rp = QKV + (size_t)(row0 + 16 * mt + fr) * NQKV + h * 128 + 32 * ks + 8 * fq; kf[mt][ks] = *(const bf16x8*)(rp + 1024); qf[mt][ks] = *(const bf16x8*)rp; }
            float gc, beta, gtot; chunk_gates(F, row0, h, dir, lane, gc, beta, gtot);
            gs[lane] = gc; gs[64 + lane] = beta;
            { float* gcb = (float*)(F.ws + WS_GCB) + dt * 128; gcb[lane] = gc; gcb[64 + lane] = beta; }
            LDS_WAIT();
#pragma unroll
            for (int mi = 0; mi < (V == 3 ? 0 : 4); ++mi)
#pragma unroll
                for (int nj = 0; nj < 4; ++nj) {
                    if (dir == 0 ? (mi < nj) : (mi > nj)) continue;
                    f32x4 acc = {0.f, 0.f, 0.f, 0.f};
#pragma unroll
                    for (int ks = 0; ks < 4; ++ks) acc = __builtin_amdgcn_mfma_f32_16x16x32_bf16(kf[mi][ks], kf[nj][ks], acc, 0, 0, 0);
                    const int j = 16 * nj + fr; const float gj = gs[j];
#pragma unroll
                    for (int r = 0; r < 4; ++r) { const int i = 16 * mi + 4 * fq + r; const float gi = gs[i], bi = gs[64 + i];
                        const bool keep = (mi != nj) || (dir == 0 ? (d4 + r > 0) : (d4 + r < 0));
                        const float val = keep ? bi * acc[r] * __expf(gi - gj) : 0.f;
                        const int il = dir ? 63 - i : i, jl = dir ? 63 - j : j;
                        As[il * 64 + jl] = val; }
                }
            bf16_t* AT = (bf16_t*)(F.ws + WS_ATT) + dt * 4096;
#pragma unroll
            for (int mi = 0; mi < (V == 3 ? 0 : 4); ++mi) {
#pragma unroll
                for (int nj = 0; nj < 4; ++nj) {
                    const bool none = dir == 0 ? (mi < nj) : (mi > nj);
                    f32x4 acc = {0.f, 0.f, 0.f, 0.f};
                    if (!none) {
#pragma unroll
                        for (int ks = 0; ks < 4; ++ks) acc = __builtin_amdgcn_mfma_f32_16x16x32_bf16(kf[nj][ks], qf[mi][ks], acc, 0, 0, 0);
                    }
                    const int i = 16 * mi + fr; const float gi = gs[i];
                    float val[4];
#pragma unroll
                    for (int r = 0; r < 4; ++r) { const int j = 16 * nj + 4 * fq + r; const float gj = gs[j];
                        const bool keep = !none && ((mi != nj) || (dir == 0 ? (d4 + r <= 0) : (d4 + r >= 0)));
                        val[r] = keep ? acc[r] * __expf(gi - gj) : 0.f; }
                    u32x2 w; w.x = pk2(val[0], val[1]); w.y = pk2(val[2], val[3]);
                    *(u32x2*)(AT + i * 64 + 16 * nj + 4 * fq) = w;
                }
            }
        }
        bf16x8 ktf[8][2];
#pragma unroll
        for (int m8 = 0; m8 < 8; ++m8)
#pragma unroll
            for (int ks = 0; ks < 2; ++ks) ktf[m8][ks] = *(const bf16x8*)(KTg + (16 * m8 + fr) * 64 + 32 * ks + 8 * fq);
        LDS_WAIT();
        asm volatile("" ::: "memory");
        float t[64];
        const float lanef = (float)lane_v;
#pragma unroll
        for (int i = 0; i < 64; ++i) { float s0 = fmaxf(0.f, 1.f - fabsf(lanef - (float)i)), s1 = 0.f, s2 = 0.f, s3 = 0.f;
            asm volatile("" ::: "memory");
#pragma unroll
            for (int j = 0; j < (V == 1 ? 0 : i); ++j) { if (j == 32) asm volatile("" ::: "memory"); const float av = As[i * 64 + j];
                if ((j & 3) == 0) s0 -= av * t[j]; else if ((j & 3) == 1) s1 -= av * t[j]; else if ((j & 3) == 2) s2 -= av * t[j]; else s3 -= av * t[j]; }
            t[i] = (s0 + s1) + (s2 + s3); }
        bf16x8 vtf[8][2];
#pragma unroll
        for (int m8 = 0; m8 < 8; ++m8)
#pragma unroll
            for (int ks = 0; ks < 2; ++ks) vtf[m8][ks] = *(const bf16x8*)(VTg + (16 * m8 + fr) * 64 + 32 * ks + 8 * fq);
        {
            const int co = dir ? 63 - lane : lane;
            const float bco = gs[64 + co], sW = bco * __expf(gs[co]);
            LDS_WAIT();
            asm volatile("" ::: "memory");
            LAS unsigned char* Tl = (LAS unsigned char*)As;
#pragma unroll
            for (int i = 0; i < 64; ++i) { const int io = dir ? 63 - i : i;
                const int off = io * 128 + ((((co >> 3) ^ ((io >> 1) & 7))) << 4) + (co & 7) * 2;
                *(LAS bf16_t*)(Tl + off) = (bf16_t)f2bf(t[i] * sW); *(LAS bf16_t*)(Tl + 8192 + off) = (bf16_t)f2bf(t[i] * bco); }
            LDS_WAIT();
            asm volatile("" ::: "memory");
            bf16_t* Wg = (bf16_t*)(F.ws + WS_W) + dt * 8192; bf16_t* UTg = (bf16_t*)(F.ws + WS_UT) + dt * 8192;
            bf16x8 tf[4][2];
#pragma unroll
            for (int nt = 0; nt < 4; ++nt)
#pragma unroll
                for (int ks = 0; ks < 2; ++ks) { const int row = 16 * nt + fr, c = 4 * ks + fq; tf[nt][ks] = *(const LAS bf16x8*)(Tl + row * 128 + ((c ^ ((row >> 1) & 7)) << 4)); }
#pragma unroll
            for (int mtd = 0; mtd < (V == 2 ? 0 : 8); ++mtd) {
                const bf16x8 a0 = ktf[mtd][0], a1 = ktf[mtd][1];
#pragma unroll
                for (int nt = 0; nt < 4; ++nt) { f32x4 acc = {0.f, 0.f, 0.f, 0.f};
                    acc = __builtin_amdgcn_mfma_f32_16x16x32_bf16(a0, tf[nt][0], acc, 0, 0, 0); acc = __builtin_amdgcn_mfma_f32_16x16x32_bf16(a1, tf[nt][1], acc, 0, 0, 0);
                    u32x2 w; w.x = pk2(acc[0], acc[1]); w.y = pk2(acc[2], acc[3]);
                    if (V == 4) asm volatile("" :: "v"(w)); else *(u32x2*)(Wg + (16 * nt + fr) * 128 + 16 * mtd + 4 * fq) = w; }
            }
#pragma unroll
            for (int nt = 0; nt < 4; ++nt)
#pragma unroll
                for (int ks = 0; ks < 2; ++ks) { const int row = 16 * nt + fr, c = 4 * ks + fq; tf[nt][ks] = *(const LAS bf16x8*)(Tl + 8192 + row * 128 + ((c ^ ((row >> 1) & 7)) << 4)); }
#pragma unroll
            for (int ntd = 0; ntd < (V == 2 ? 0 : 8); ++ntd) {
                const bf16x8 b0 = vtf[ntd][0], b1 = vtf[ntd][1];
#pragma unroll
                for (int mt = 0; mt < 4; ++mt) { f32x4 acc = {0.f, 0.f, 0.f, 0.f};
                    acc = __builtin_amdgcn_mfma_f32_16x16x32_bf16(tf[mt][0], b0, acc, 0, 0, 0); acc = __builtin_amdgcn_mfma_f32_16x16x32_bf16(tf[mt][1], b1, acc, 0, 0, 0);
                    u32x2 w; w.x = pk2(acc[0], acc[1]); w.y = pk2(acc[2], acc[3]);
                    if (V == 4) asm volatile("" :: "v"(w)); else *(u32x2*)(UTg + (16 * ntd + fr) * 64 + 16 * mt + 4 * fq) = w; }
            }
        }
        LDS_WAIT();
    }
}

constexpr int SC_W = 0, SC_Q = 16384, SC_KT = 32768, SC_AT = 49152, SC_UT = 57344, SC_GC = 65536, SC_SLOT = 65792;
constexpr int SC_ST = 2 * SC_SLOT, ST_ROW = 272, SC_VN = SC_ST + 64 * ST_ROW, RT_ROW = 144, SC_END = SC_VN + 64 * RT_ROW;
static_assert(SC_END <= LDS_BYTES - 128, "scan LDS map");
#define SC_WAIT_V(n) asm volatile("s_waitcnt vmcnt(" #n ")" ::: "memory")
#define SC_BAR() do { asm volatile("s_waitcnt lgkmcnt(0)" ::: "memory"); __builtin_amdgcn_s_barrier(); asm volatile("" ::: "memory"); } while (0)
struct ScanCtx { int b, h, dir, half, mt, np, fr, fq, w, lane; unsigned offW[2], offQ[2], offK[2], offA; };
__device__ __forceinline__ int sc_chunk(const ScanCtx& c, int n) { return n < 4 ? 256 + c.b * 4 + (c.dir ? 3 - n : n) : c.b * 64 + (c.dir ? 67 - n : n - 4); }
__device__ __forceinline__ void sc_dma(Frame& F, const ScanCtx& c, int n, int slotoff) {
    const int ci = sc_chunk(c, n); int row0, t0, sl; chunk_rows(ci, row0, t0, sl);
    const size_t dt = ((size_t)(c.dir * NCHUNK + ci) * NH + c.h);
    const char* gW = (const char*)(F.ws + WS_W) + dt * 16384; const char* gQ = (const char*)(F.ws + WS_QKV) + ((size_t)row0 * NQKV + c.h * 128) * 2;
    const char* gK = (const char*)(F.ws + WS_KT) + ((size_t)ci * NH + c.h) * 16384; const char* gA = (const char*)(F.ws + WS_ATT) + dt * 8192;
    const char* gU = (const char*)(F.ws + WS_UT) + dt * 16384 + c.half * 8192; const char* gG = (const char*)(F.ws + WS_GCB) + dt * 512;
    LAS unsigned char* lds = F.lds + slotoff;
#pragma unroll
    for (int i = 0; i < 2; ++i) {
        __builtin_amdgcn_global_load_lds((const unsigned*)(gW + c.offW[i]), (LAS unsigned*)(lds + SC_W + (2 * c.w + i) * 1024), 16, 0, 0);
        __builtin_amdgcn_global_load_lds((const unsigned*)(gQ + c.offQ[i]), (LAS unsigned*)(lds + SC_Q + (2 * c.w + i) * 1024), 16, 0, 0);
        __builtin_amdgcn_global_load_lds((const unsigned*)(gK + c.offK[i]), (LAS unsigned*)(lds + SC_KT + (2 * c.w + i) * 1024), 16, 0, 0); }
    __builtin_amdgcn_global_load_lds((const unsigned*)(gA + c.offA), (LAS unsigned*)(lds + SC_AT + c.w * 1024), 16, 0, 0);
    __builtin_amdgcn_global_load_lds((const unsigned*)(gU + c.offA), (LAS unsigned*)(lds + SC_UT + c.w * 1024), 16, 0, 0);
    __builtin_amdgcn_global_load_lds((const unsigned*)(gG + c.lane * 4), (LAS unsigned*)(lds + SC_GC), 4, 0, 0);
}
__device__ __forceinline__ void sc_store_o(Frame& F, const ScanCtx& c, int n, const f32x4 (&o)[2]) {
    const int lc = c.dir ? 67 - n : n - 4;
    float* Obase = (float*)(F.ws + WS_O);
#pragma unroll
    for (int u = 0; u < 2; ++u) { float* op_ = Obase + ((size_t)c.dir * ML + (size_t)c.b * T + lc * 64 + 16 * c.mt + 4 * c.fq) * D + c.h * 128 + c.half * 64 + 16 * (2 * c.np + u) + c.fr;
#pragma unroll
        for (int r = 0; r < 4; ++r) op_[(size_t)r * D] = o[u][r]; }
}
__device__ __forceinline__ void moe_convert_queue(Frame& F) {
    unsigned* ctr = (unsigned*)(F.ws + WS_CTL) + 16384;
    LAS unsigned* slot = (LAS unsigned*)(F.lds + 65536);
    LAS unsigned char* scr = F.lds + F.wave * 8192;
    for (;;) {
        __syncthreads();
        if (F.tid == 0) slot[0] = __hip_atomic_fetch_add(ctr, 8u, __ATOMIC_RELAXED, __HIP_MEMORY_SCOPE_AGENT);
        __syncthreads();
        const unsigned t = slot[0] + (unsigned)F.wave;
        if (slot[0] >= 2u * TR_MOE) break;
        if (t < 2u * TR_MOE) tr_moe_job(F, t >= (unsigned)TR_MOE, (int)(t >= (unsigned)TR_MOE ? t - TR_MOE : t), scr);
    }
    __syncthreads();
}
__device__ __forceinline__ void phase_scan(Frame& F) {
    const int xcd = F.vcu >> 5, jcu = F.vcu & 31;
    if (F.G != 256 || jcu >= 16) {
        moe_convert_queue(F);
        if (F.G == 256) return;
    }
    ScanCtx c;
    c.lane = F.lane; c.fr = c.lane & 15; c.fq = c.lane >> 4; c.w = F.wave; c.mt = c.w >> 1; c.np = c.w & 1;
#pragma unroll
    for (int i = 0; i < 2; ++i) {
        { const int I = 2 * c.w + i, row = 4 * I + (c.lane >> 4), cc = (c.lane & 15) ^ (row & 15); c.offW[i] = (unsigned)(row * 256 + cc * 16); c.offQ[i] = (unsigned)(row * (NQKV * 2) + cc * 16); }
        { const int I = 2 * c.w + i, row = 8 * I + (c.lane >> 3), cc = (c.lane & 7) ^ ((row >> 1) & 7); c.offK[i] = (unsigned)(row * 128 + cc * 16); }
    }
    { const int row = 8 * c.w + (c.lane >> 3), cc = (c.lane & 7) ^ ((row >> 1) & 7); c.offA = (unsigned)(row * 128 + cc * 16); }
    const int lane = c.lane, fr = c.fr, fq = c.fq, mt = c.mt, np = c.np;
    LAS unsigned char* const lds = F.lds;
    const int item0 = (F.G == 256) ? xcd * 16 + jcu : F.vcu, nitem = (F.G == 256) ? 128 : F.G;
    for (int item = item0; item < 128; item += nitem) {
        c.half = item & 1; c.dir = (item >> 1) & 1; c.h = (item >> 2) & 7; c.b = item >> 5;
        for (int i = F.tid; i < 64 * ST_ROW / 4; i += NTHR) ((LAS unsigned*)(lds + SC_ST))[i] = 0u;
        f32x4 Sacc[2][2];
#pragma unroll
        for (int ud = 0; ud < 2; ++ud)
#pragma unroll
            for (int uv = 0; uv < 2; ++uv) Sacc[ud][uv] = (f32x4){0.f, 0.f, 0.f, 0.f};
        f32x4 Oprev[2] = {{0.f, 0.f, 0.f, 0.f}, {0.f, 0.f, 0.f, 0.f}};
        sc_dma(F, c, 0, 0);
        SC_WAIT_V(0);
        SC_BAR();
        sc_dma(F, c, 1, SC_SLOT);
#pragma unroll 1
        for (int n = 0; n < 68; ++n) {
            const bool latent = n >= 4;
            const int so = (n & 1) * SC_SLOT;
            LAS unsigned char* const slot = lds + so;
            LAS unsigned char* const St = lds + SC_ST;
            f32x4 xacc[2], oacc[2];
#pragma unroll
            for (int u = 0; u < 2; ++u) { xacc[u] = (f32x4){0.f, 0.f, 0.f, 0.f}; oacc[u] = (f32x4){0.f, 0.f, 0.f, 0.f}; }
            const int arow = 16 * mt + fr;
#pragma unroll
            for (int ks = 0; ks < 4; ++ks) {
                const int co = (((4 * ks + fq) ^ fr) << 4);
                const bf16x8 aW = *(const LAS bf16x8*)(slot + SC_W + arow * 256 + co), aQ = *(const LAS bf16x8*)(slot + SC_Q + arow * 256 + co);
#pragma unroll
                for (int u = 0; u < 2; ++u) { const bf16x8 bS = *(const LAS bf16x8*)(St + (16 * (2 * np + u) + fr) * ST_ROW + (32 * ks + 8 * fq) * 2);
                    xacc[u] = __builtin_amdgcn_mfma_f32_16x16x32_bf16(aW, bS, xacc[u], 0, 0, 0);
                    oacc[u] = __builtin_amdgcn_mfma_f32_16x16x32_bf16(aQ, bS, oacc[u], 0, 0, 0); } }
            const f32x4 gc4 = *(const LAS f32x4*)(slot + SC_GC + (16 * mt + 4 * fq) * 4);
            const float gtot = *(const LAS float*)(slot + SC_GC + (c.dir ? 0 : 63) * 4);
#pragma unroll
            for (int u = 0; u < 2; ++u) { const int urow = 16 * (2 * np + u) + fr, uc = 2 * mt + (fq >> 1);
              const u32x2 uw = *(const LAS u32x2*)(slot + SC_UT + urow * 128 + ((uc ^ ((urow >> 1) & 7)) << 4) + 8 * (fq & 1));
              u32x2 pw; pw.x = pk2(bflo(uw.x) - xacc[u][0], bfhi(uw.x) - xacc[u][1]); pw.y = pk2(bflo(uw.y) - xacc[u][2], bfhi(uw.y) - xacc[u][3]);
              *(LAS u32x2*)(lds + SC_VN + urow * RT_ROW + (16 * mt + 4 * fq) * 2) = pw; }
            bf16x8 aK[2][2], aA[2];
#pragma unroll
            for (int ks = 0; ks < 2; ++ks) {
                aA[ks] = *(const LAS bf16x8*)(slot + SC_AT + arow * 128 + ((((4 * ks + fq) ^ ((arow >> 1) & 7))) << 4));
                const f32x4 g0 = *(const LAS f32x4*)(slot + SC_GC + (32 * ks + 8 * fq) * 4), g1 = *(const LAS f32x4*)(slot + SC_GC + (32 * ks + 8 * fq + 4) * 4);
                float e[8];
#pragma unroll
                for (int j = 0; j < 4; ++j) { e[j] = __expf(gtot - g0[j]); e[4 + j] = __expf(gtot - g1[j]); }
#pragma unroll
                for (int ud = 0; ud < 2; ++ud) { const int krow = 16 * (2 * mt + ud) + fr;
                    const u32x4 kw = *(const LAS u32x4*)(slot + SC_KT + krow * 128 + ((((4 * ks + fq) ^ ((krow >> 1) & 7))) << 4));
                    u32x4 o; o.x = pk2(bflo(kw.x) * e[0], bfhi(kw.x) * e[1]); o.y = pk2(bflo(kw.y) * e[2], bfhi(kw.y) * e[3]); o.z = pk2(bflo(kw.z) * e[4], bfhi(kw.z) * e[5]); o.w = pk2(bflo(kw.w) * e[6], bfhi(kw.w) * e[7]);
                    aK[ud][ks] = __builtin_bit_cast(bf16x8, o); } }
            SC_BAR();
            if (n - 1 >= 4) sc_store_o(F, c, n - 1, Oprev);
            if (n + 2 < 68) sc_dma(F, c, n + 2, so);
            bf16x8 bV[2][2];
#pragma unroll
            for (int u = 0; u < 2; ++u)
#pragma unroll
                for (int ks = 0; ks < 2; ++ks) bV[u][ks] = *(const LAS bf16x8*)(lds + SC_VN + (16 * (2 * np + u) + fr) * RT_ROW + (32 * ks + 8 * fq) * 2);
            if (latent) {
#pragma unroll
                for (int u = 0; u < 2; ++u) {
#pragma unroll
                    for (int r = 0; r < 4; ++r) oacc[u][r] *= __expf(gc4[r]);
#pragma unroll
                    for (int ks = 0; ks < 2; ++ks) oacc[u] = __builtin_amdgcn_mfma_f32_16x16x32_bf16(aA[ks], bV[u][ks], oacc[u], 0, 0, 0);
                    Oprev[u] = oacc[u];
                }
            }
            const float egt = __expf(gtot);
#pragma unroll
            for (int ud = 0; ud < 2; ++ud)
#pragma unroll
                for (int uv = 0; uv < 2; ++uv) {
                    Sacc[ud][uv] *= egt;
#pragma unroll
                    for (int ks = 0; ks < 2; ++ks) Sacc[ud][uv] = __builtin_amdgcn_mfma_f32_16x16x32_bf16(aK[ud][ks], bV[uv][ks], Sacc[ud][uv], 0, 0, 0);
                    u32x2 pw; pw.x = pk2(Sacc[ud][uv][0], Sacc[ud][uv][1]); pw.y = pk2(Sacc[ud][uv][2], Sacc[ud][uv][3]);
                    *(LAS u32x2*)(St + (16 * (2 * np + uv) + fr) * ST_ROW + (16 * (2 * mt + ud) + 4 * fq) * 2) = pw;
                }
            if (n + 2 < 68) SC_WAIT_V(9); else SC_WAIT_V(0);
            SC_BAR();
        }
        sc_store_o(F, c, 67, Oprev);
        SC_WAIT_V(0);
        SC_BAR();
    }
    if (F.G == 256) moe_convert_queue(F);
}

__device__ __forceinline__ void phase_gdn_out(Frame& F) {
    const float* O0 = (const float*)(F.ws + WS_O); const float* O1 = O0 + (size_t)ML * D;
    const bf16_t* P = (const bf16_t*)(F.ws + WS_P);
    bf16_t* ON = (bf16_t*)(F.ws + WS_ON);
    const int lane = F.lane;
    const f32x4 gain = *(const f32x4*)(F.in[I_OGAIN] + ((4 * lane) & 127));
    f32x4 an[4], bn[4];
    { const int r0 = F.vcu * NWAVE + F.wave; if (r0 < ML) { load_row(O0 + (size_t)r0 * D, lane, an); load_row(O1 + (size_t)r0 * D, lane, bn); } }
    for (int row = F.vcu * NWAVE + F.wave; row < ML; row += F.G * NWAVE) {
        f32x4 a[4], b[4];
#pragma unroll
        for (int j = 0; j < 4; ++j) { a[j] = an[j]; b[j] = bn[j]; }
        { const int nr = row + F.G * NWAVE; if (nr < ML) { load_row(O0 + (size_t)nr * D, lane, an); load_row(O1 + (size_t)nr * D, lane, bn); } }
        f32x4 y[4];
#pragma unroll
        for (int j = 0; j < 4; ++j) { const f32x4 o = a[j] + b[j];
            float ss = (o[0] * o[0] + o[1] * o[1]) + (o[2] * o[2] + o[3] * o[3]);
            ss = row16_sum(ss); ss += __shfl_xor(ss, 16);
            const float rs = rsqrtf(ss * (1.f / DH) + EPS);
            const u32x2 zw = ((const u32x2*)(P + (size_t)row * NP + NQKV))[lane + 64 * j];
            const float z0 = bflo(zw.x), z1 = bfhi(zw.x), z2 = bflo(zw.y), z3 = bfhi(zw.y);
            y[j][0] = o[0] * rs * gain[0] * siluf(z0); y[j][1] = o[1] * rs * gain[1] * siluf(z1); y[j][2] = o[2] * rs * gain[2] * siluf(z2); y[j][3] = o[3] * rs * gain[3] * siluf(z3); }
        store_row_bf16(ON + (size_t)row * D, lane, y);
    }
}

__device__ __forceinline__ void phase_moe_pre(Frame& F, int l) {
    const float* MOD = (const float*)(F.ws + WS_MOD) + (size_t)l * 5 * 6144;
    const float* H = (const float*)(F.ws + WS_H);
    bf16_t* U = (bf16_t*)(F.ws + WS_U);
    float* AFF = (float*)(F.ws + WS_AFF);
    LAS float* wr = (LAS float*)F.lds;
    const float* wsrc = F.in[I_WR] + (size_t)l * D * NE;
    for (int i = F.tid; i < D * NE / 4; i += NTHR) { const int c = i >> 2, q = i & 3; *(LAS f32x4*)(wr + c * 16 + 4 * q + (c >> 2) * 4) = ((const f32x4*)wsrc)[i]; }
    __syncthreads();
    const int lane = F.lane;
    f32x4 vn[4];
    { const int r0 = F.vcu * NWAVE + F.wave; if (r0 < ML) load_row(H + (size_t)r0 * D, lane, vn); }
    for (int row = F.vcu * NWAVE + F.wave; row < ML; row += F.G * NWAVE) {
        const int b = row / T, t = row % T;
        f32x4 v[4], y[4];
#pragma unroll
        for (int j = 0; j < 4; ++j) v[j] = vn[j];
        { const int nr = row + F.G * NWAVE; if (nr < ML) load_row(H + (size_t)nr * D, lane, vn); }
        const float rstd = row_rstd(v);
        const float* m = MOD + (size_t)b * 6144;
        norm_mod(v, rstd, F.in[I_GFFN] + l * D, m + 3 * D, m + 4 * D, lane, y);
#pragma unroll
        for (int j = 0; j < 4; ++j) ((unsigned*)((unsigned char*)U + (size_t)row * D))[lane + 64 * j] = pk4_fp8(y[j][0], y[j][1], y[j][2], y[j][3]);
        float lg[16];
#pragma unroll
        for (int e = 0; e < 16; ++e) lg[e] = 0.f;
#pragma unroll
        for (int j = 0; j < 4; ++j) {
            asm volatile("" ::: "memory");
#pragma unroll
            for (int i = 0; i < 4; ++i) { const int c = 4 * lane + 256 * j + i; const float yv = y[j][i];
#pragma unroll
                for (int q = 0; q < 4; ++q) { const f32x4 wv = *(const LAS f32x4*)(wr + c * 16 + 4 * q + (c >> 2) * 4);
                    lg[4 * q] += yv * wv[0]; lg[4 * q + 1] += yv * wv[1]; lg[4 * q + 2] += yv * wv[2]; lg[4 * q + 3] += yv * wv[3]; } } }
        float mx = -1e30f;
#pragma unroll
        for (int e = 0; e < 16; ++e) { lg[e] = wave_sum(lg[e]); mx = fmaxf(mx, lg[e]); }
        float den = 0.f;
#pragma unroll
        for (int e = 0; e < 16; ++e) { lg[e] = __expf(lg[e] - mx); den += lg[e]; }
        const float inv = 1.f / den;
        float mine = 0.f;
#pragma unroll
        for (int e = 0; e < 16; ++e) mine = (lane == e) ? lg[e] * inv : mine;
        if (lane < 16) AFF[((size_t)b * NE + lane) * T + t] = mine;
    }
    __syncthreads();
}

__device__ __forceinline__ void phase_topk(Frame& F) {
    LAS unsigned* cnt = (LAS unsigned*)F.lds;
    const float* AFF = (const float*)(F.ws + WS_AFF);
    int* SLOT = (int*)(F.ws + WS_SLOT); int* IDX = (int*)(F.ws + WS_IDX); float* GATE = (float*)(F.ws + WS_GATE);
    for (int item = F.vcu; item < NB * NE; item += F.G) {
        const int b = item / NE, e = item % NE;
        unsigned key[8];
        { const u32x4* p = (const u32x4*)(AFF + (size_t)item * T + F.tid * 8); const u32x4 k0 = p[0], k1 = p[1];
          key[0] = k0.x; key[1] = k0.y; key[2] = k0.z; key[3] = k0.w; key[4] = k1.x; key[5] = k1.y; key[6] = k1.z; key[7] = k1.w; }
        unsigned thr = 0u;
        int par = 0;
        for (int bit = 30; bit >= 0; --bit) {
            const unsigned cand = thr | (1u << bit);
            int c = 0;
#pragma unroll
            for (int i = 0; i < 8; ++i) c += (key[i] >= cand) ? 1 : 0;
#pragma unroll
            for (int o = 1; o < 64; o <<= 1) c += __shfl_xor(c, o);
            if (F.lane == 0) cnt[par * 8 + F.wave] = (unsigned)c;
            __syncthreads();
            unsigned tot = 0;
#pragma unroll
            for (int w8 = 0; w8 < 8; ++w8) tot += cnt[par * 8 + w8];
            if (tot >= (unsigned)CAP) thr = cand;
            par ^= 1;
        }
        __syncthreads();
        int cg_ = 0, ce_ = 0;
#pragma unroll
        for (int i = 0; i < 8; ++i) { cg_ += key[i] > thr; ce_ += key[i] == thr; }
        unsigned pk = (unsigned)cg_ | ((unsigned)ce_ << 16), inc = pk;
#pragma unroll
        for (int o = 1; o < 64; o <<= 1) { const unsigned t = __shfl_up(inc, o); if (F.lane >= o) inc += t; }
        LAS unsigned* wtot = cnt + 64;
        if (F.lane == 63) wtot[F.wave] = inc;
        __syncthreads();
        unsigned base = 0, total = 0;
#pragma unroll
        for (int w8 = 0; w8 < 8; ++w8) { const unsigned v = wtot[w8]; if (w8 < F.wave) base += v; total += v; }
        const unsigned excl = base + inc - pk;
        int gt_before = excl & 0xffffu, eq_before = excl >> 16;
        const int need_eq = CAP - (int)(total & 0xffffu);
#pragma unroll
        for (int i = 0; i < 8; ++i) {
            const int t = F.tid * 8 + i;
            const bool isg = key[i] > thr, ise = key[i] == thr;
            const bool sel = isg || (ise && eq_before < need_eq);
            const int slot = gt_before + (eq_before < need_eq ? eq_before : need_eq);
            SLOT[(size_t)item * T + t] = sel ? slot : -1;
            if (sel) { IDX[item * CAP + slot] = t; GATE[(size_t)e * 2048 + b * CAP + slot] = __uint_as_float(key[i]); }
            gt_before += isg; eq_before += ise;
        }
        __syncthreads();
    }
}

__device__ __forceinline__ void phase_gather(Frame& F) {
    const unsigned char* U = (const unsigned char*)(F.ws + WS_U); unsigned char* XS = (unsigned char*)(F.ws + WS_XS); const int* IDX = (const int*)(F.ws + WS_IDX);
    for (int r = F.vcu * NWAVE + F.wave; r < MX; r += F.G * NWAVE) {
        const int e = r / 2048, b = (r % 2048) / CAP, s = r % CAP;
        const int t = IDX[(b * NE + e) * CAP + s];
        ((u32x4*)(XS + (size_t)r * D))[F.lane] = ((const u32x4*)(U + ((size_t)b * T + t) * D))[F.lane];
    }
}

__device__ __forceinline__ void phase_combine(Frame& F, int l) {
    const float* MOD = (const float*)(F.ws + WS_MOD);
    float* H = (float*)(F.ws + WS_H); const bf16_t* YS = (const bf16_t*)(F.ws + WS_YS); const int* SLOT = (const int*)(F.ws + WS_SLOT);
    bf16_t* U = (bf16_t*)(F.ws + WS_U);
    const int lane = F.lane, stride = F.G * NWAVE;
    int row = F.vcu * NWAVE + F.wave;
    f32x4 vn[4]; int slotn = -1;
    if (row < ML) { load_row(H + (size_t)row * D, lane, vn); slotn = lane < NE ? SLOT[((size_t)(row / T) * NE + lane) * T + row % T] : -1; }
    for (; row < ML; row += stride) {
        const int b = row / T;
        f32x4 v[4]; const int myslot = slotn;
#pragma unroll
        for (int j = 0; j < 4; ++j) v[j] = vn[j];
        { const int nr = row + stride; if (nr < ML) { load_row(H + (size_t)nr * D, lane, vn); slotn = lane < NE ? SLOT[((size_t)(nr / T) * NE + lane) * T + nr % T] : -1; } }
        f32x4 acc[4];
#pragma unroll
        for (int j = 0; j < 4; ++j) acc[j] = (f32x4){0.f, 0.f, 0.f, 0.f};
        unsigned long long mask = __ballot(myslot >= 0);
        while (mask) {
            u32x2 yv[4][4]; bool have[4];
#pragma unroll
            for (int k = 0; k < 4; ++k) { have[k] = mask != 0ull;
                if (have[k]) { const int e = __builtin_ctzll(mask); mask &= mask - 1ull; const int sl = __builtin_amdgcn_readlane(myslot, e);
                    const u32x2* yp = (const u32x2*)(YS + ((size_t)e * 2048 + b * CAP + sl) * D);
#pragma unroll
                    for (int j = 0; j < 4; ++j) yv[k][j] = yp[lane + 64 * j]; } }
#pragma unroll
            for (int k = 0; k < 4; ++k) if (have[k]) {
#pragma unroll
                for (int j = 0; j < 4; ++j) { const u32x2 w = yv[k][j]; acc[j][0] += bflo(w.x); acc[j][1] += bfhi(w.x); acc[j][2] += bflo(w.y); acc[j][3] += bfhi(w.y); } }
        }
        const float* gtf = MOD + ((size_t)l * 5 + b) * 6144 + 5 * D;
#pragma unroll
        for (int j = 0; j < 4; ++j) v[j] += ((const f32x4*)gtf)[lane + 64 * j] * acc[j];
        const float rstd = row_rstd(v);
        if (l == 0) {
#pragma unroll
            for (int j = 0; j < 4; ++j) ((f32x4*)(H + (size_t)row * D))[lane + 64 * j] = v[j];
            const float* m = MOD + ((size_t)5 + b) * 6144; f32x4 y[4];
            norm_mod(v, rstd, F.in[I_GMIX] + D, m, m + D, lane, y);
            store_row_bf16(U + (size_t)row * D, lane, y);
        } else {
#pragma unroll
            for (int j = 0; j < 4; ++j) ((f32x4*)(F.out + (size_t)row * D))[lane + 64 * j] = v[j] * rstd * ((const f32x4*)F.in[I_FING])[lane + 64 * j];
        }
    }
}

__device__ __forceinline__ void phase_pool(Frame& F) {
    const bf16_t* U = (const bf16_t*)(F.ws + WS_U); bf16_t* PD = (bf16_t*)(F.ws + WS_ON);
    LAS float* Vs = (LAS float*)F.lds;
    const int cp = F.tid & 127, cgp = F.tid >> 7;
    for (int item = F.vcu; item < 1024; item += F.G) {
        const int gi = item >> 8, b = (item >> 6) & 3, r = item & 63;
        const int w = 2 << gi, lo = w >> 1, hi = w - lo;
        const int r_lo = r - lo < 0 ? 0 : r - lo, r_hi = r + hi > 64 ? 64 : r + hi;
        float s0[16], s1[16]; unsigned self[16];
#pragma unroll
        for (int i = 0; i < 16; ++i) { s0[i] = 0.f; s1[i] = 0.f; }
        const bf16_t* base = U + ((size_t)b * T + cgp * 16) * D + gi * 256 + 2 * cp;
        for (int rr = r_lo; rr < r_hi; ++rr) {
#pragma unroll
            for (int i = 0; i < 16; ++i) { const unsigned x = *(const unsigned*)(base + ((size_t)rr * 64 + i) * D); s0[i] += bflo(x); s1[i] += bfhi(x); }
        }
#pragma unroll
        for (int i = 0; i < 16; ++i) { self[i] = *(const unsigned*)(base + ((size_t)r * 64 + i) * D); *(LAS f32x2*)(Vs + (cgp * 16 + i) * 256 + 2 * cp) = (f32x2){s0[i], s1[i]}; }
        __syncthreads();
        const float inv_r = 1.f / (float)(r_hi - r_lo);
#pragma unroll
        for (int i = 0; i < 16; ++i) { const int c = cgp * 16 + i;
            const int c_lo = c - lo < 0 ? 0 : c - lo, c_hi = c + hi > 64 ? 64 : c + hi;
            float a0 = 0.f, a1 = 0.f;
            for (int cc = c_lo; cc < c_hi; ++cc) { const f32x2 x = *(const LAS f32x2*)(Vs + cc * 256 + 2 * cp); a0 += x[0]; a1 += x[1]; }
            const float sc = inv_r / (float)(c_hi - c_lo);
            *(unsigned*)(PD + ((size_t)b * T + r * 64 + c) * D + gi * 256 + 2 * cp) = pk2(a0 * sc - bflo(self[i]), a1 * sc - bfhi(self[i])); }
        __syncthreads();
    }
}

constexpr int NPHASE = 22;
__global__ void __launch_bounds__(NTHR, 2) mega_fwd(Args args) {
    extern __shared__ __attribute__((aligned(16))) unsigned char lds_raw[];
    Frame F;
    F.lds = (LAS unsigned char*)lds_raw;
    F.tid = threadIdx.x; F.lane = F.tid & 63; F.wave = __builtin_amdgcn_readfirstlane(F.tid >> 6);
    F.G = gridDim.x; { const int bx = blockIdx.x; F.vcu = (F.G % 8 == 0) ? (bx % 8) * (F.G / 8) + bx / 8 : bx; }
#pragma unroll
    for (int i = 0; i < 21; ++i) F.in[i] = args.in[i];
    F.out = args.out; F.ws = args.ws;
    const int lo = args.ph_lo, hi = args.ph_hi;
    if (F.tid < 32) ((LAS unsigned*)(F.lds + MISC_OFF))[F.tid] = 0u;
    __syncthreads();
    XcdBarrier bar = xcd_barrier_post((unsigned*)(F.ws + WS_CTL) + 4096, (volatile LAS unsigned*)(F.lds + MISC_OFF));
#ifndef PHMASK
#define PHMASK 0x3fffff
#endif
#define IN(k) ((((PHMASK) >> (k)) & 1) && lo <= (k) && (k) < hi)
#define SEAM(k) do { if (IN(k) && IN((k) + 1)) { xcd_barrier(bar); } F.tid = threadIdx.x; asm volatile("" : "+v"(F.tid)); F.lane = F.tid & 63; F.wave = __builtin_amdgcn_readfirstlane(F.tid >> 6); } while (0)
    const int c = (int)blockIdx.x;

#ifndef REP_PHASE
#define REP_PHASE (-1)
#endif
#ifndef REP_N
#define REP_N 2
#endif
#define RUN(k, ...) for (int _r = 0; _r < ((k) == REP_PHASE ? 1 + REP_N : 1); ++_r) { if (IN(k)) { __VA_ARGS__ } SEAM(k); }
    RUN(0, {
        if (F.vcu < 192) mod_item(F, F.vcu);
        LAS unsigned char* scr = F.lds + F.wave * 8192;
        const int gw = F.vcu * NWAVE + F.wave, NGW = F.G * NWAVE;
        for (int t = gw; t < TR_SMALL; t += NGW) tr_small_job(F, t, scr);
    })
    RUN(1, phase_norm0(F);)
    RUN(2, {
        pg8::Gemm g{(const bf16_t*)(F.ws + WS_U), (const bf16_t*)(F.ws + WS_WIN), D, D};
        pg8::DenseOrder S; S.init(MA / 256, NPROJ_PAD / 256, F.G, c);
        pg8::EpiInProj E{(bf16_t*)(F.ws + WS_P), (float*)(F.ws + WS_AB)};
        pg8::gemm_phase(F.lds, g, S, E);
    })
    RUN(3, phase_conv(F);)
#ifndef PREPV
    RUN(4, phase_prep<0>(F);)
#else
    RUN(4, phase_prep<PREPV>(F); __syncthreads(); phase_prep<PREPV>(F); __syncthreads(); phase_prep<0>(F);)
#endif
    RUN(5, phase_scan(F);)
    RUN(6, phase_gdn_out(F);)
    RUN(7, {
        pg8::Gemm g{(const bf16_t*)(F.ws + WS_ON), (const bf16_t*)(F.ws + WS_WOUT), D, D};
        pg8::DenseOrder S; S.init(ML / 256, D / 256, F.G, c);
        pg8::EpiOutProj E{F.in[I_X], (float*)(F.ws + WS_H), (const float*)(F.ws + WS_MOD) + 2 * D};
        pg8::gemm_phase(F.lds, g, S, E);
    })
#pragma unroll
    for (int l = 0; l < 2; ++l) {
        if (l == 1) {
            RUN(14, phase_pool(F);)
            RUN(15, {
                pg8::Gemm g{(const bf16_t*)(F.ws + WS_ON), (const bf16_t*)(F.ws + WS_POOLW), D, 256};
                pg8::PoolOrder S{F.G, c};
                pg8::EpiPool E{(float*)(F.ws + WS_H), (const float*)(F.ws + WS_MOD) + 5 * 6144 + 2 * D, F.in[I_POOLS]};
                pg8::gemm_phase(F.lds, g, S, E);
            })
        }
        const int p0 = l == 0 ? 8 : 16;
        RUN(p0, {
            phase_moe_pre(F, l);

        })
        RUN(p0 + 1, phase_topk(F);)
        RUN(p0 + 2, phase_gather(F);)
        RUN(p0 + 3, {
            pg8::Gemm g{(const bf16_t*)(F.ws + WS_XS), (const bf16_t*)(F.ws + WS_WMOE + (size_t)l * WMOE_LAYER), D, D};
            pg8::MoeUpOrder S{F.G, c};
            pg8::EpiSwiglu E{(unsigned char*)(F.ws + WS_HID)};
            pg8::gemm_phase<pg8::EpiSwiglu, pg8::MoeUpOrder, true>(F.lds, g, S, E);
        })
        RUN(p0 + 4, {
            pg8::Gemm g{(const bf16_t*)(F.ws + WS_HID), (const bf16_t*)(F.ws + WS_W2T + (size_t)l * WMOE_LAYER), DF, DF};
            pg8::MoeDownOrder S{F.G, c};
            pg8::EpiDown E{(bf16_t*)(F.ws + WS_YS), (const float*)(F.ws + WS_GATE)};
            pg8::gemm_phase<pg8::EpiDown, pg8::MoeDownOrder, true>(F.lds, g, S, E);
        })
        RUN(p0 + 5, phase_combine(F, l);)
    }
#undef IN
#undef SEAM
#undef RUN
}

extern "C" void kernel_launch(void* const* d_in, const int* in_sizes, int n_in, void* d_out, int out_size, void* d_ws, size_t ws_size, hipStream_t stream) {
    static int grid = 0;
    if (grid == 0) {
        if (n_in != 21 || ws_size < WS_END) { fprintf(stderr, "kernel_launch: unexpected inputs (n_in %d, ws %zu)\n", n_in, ws_size); grid = -1; return; }
        int dev = 0, cus = 0, per_cu = 0;
        hipGetDevice(&dev);
        hipDeviceGetAttribute(&cus, hipDeviceAttributeMultiprocessorCount, dev);
        hipFuncSetAttribute((const void*)mega_fwd, hipFuncAttributeMaxDynamicSharedMemorySize, LDS_BYTES);
        hipOccupancyMaxActiveBlocksPerMultiprocessor(&per_cu, (const void*)mega_fwd, NTHR, LDS_BYTES);
        if (per_cu < 1) { fprintf(stderr, "kernel_launch: occupancy query says %d blocks per CU\n", per_cu); per_cu = 1; }
        grid = cus;
        (void)hipGetLastError();
    }
    if (grid < 0) return;
    hipMemsetAsync((char*)d_ws + WS_CTL, 0, 1 * MiB, stream);
    Args a{};
    for (int i = 0; i < 21; ++i) a.in[i] = (const float*)d_in[i];
    a.out = (float*)d_out; a.ws = (unsigned char*)d_ws;
#if MK_N_LAUNCHES == 1
    a.ph_lo = 0; a.ph_hi = NPHASE;
    void* params[] = {&a};
    (void)params;
    hipLaunchKernelGGL(mega_fwd, dim3(grid), dim3(NTHR), LDS_BYTES, stream, a);
    hipError_t e = hipPeekAtLastError();
    if (e != hipSuccess) fprintf(stderr, "launch failed: %s (grid %d)\n", hipGetErrorString(e), grid);
#else
    for (int p = 0; p < NPHASE; ++p) {
        a.ph_lo = p; a.ph_hi = p + 1;
        void* params[] = {&a};
        hipError_t e = hipLaunchCooperativeKernel((const void*)mega_fwd, dim3(grid), dim3(NTHR), params, LDS_BYTES, stream);
        if (e != hipSuccess) { fprintf(stderr, "launch %d failed: %s (grid %d)\n", p, hipGetErrorString(e), grid); break; }
    }
#endif
}
```

```cpp
#include <hip/hip_runtime.h>
#include <hip/hip_cooperative_groups.h>
#include <cstdio>
namespace cg = cooperative_groups;

#ifndef MK_N_LAUNCHES
#define MK_N_LAUNCHES 1
#endif

#define LAS __attribute__((address_space(3)))
typedef unsigned short bf16_t;
typedef short bf16x8 __attribute__((ext_vector_type(8)));
typedef float f32x4 __attribute__((ext_vector_type(4)));
typedef float f32x2 __attribute__((ext_vector_type(2)));
typedef unsigned u32x4 __attribute__((ext_vector_type(4)));
typedef unsigned u32x2 __attribute__((ext_vector_type(2)));

constexpr int NB = 4, T = 4096, D = 1024, TC = 256, NH = 8, DH = 128, NE = 16, CAP = 512, DF = 2048;
constexpr int ML = NB * T;
constexpr int MC = NB * TC;
constexpr int MA = ML + MC;
constexpr int NPROJ = 4128, NPROJ_PAD = 4352, NQKV = 3072, NP = 4096;
constexpr int NCHUNK = MA / 64;
constexpr int MX = NB * NE * CAP;
constexpr float EPS = 1e-6f;
constexpr int NTHR = 512, NWAVE = 8;

constexpr size_t MiB = 1u << 20;
constexpr size_t WS_CTL = 0;
constexpr size_t WS_MOD = 1 * MiB;
constexpr size_t WS_AB = 2 * MiB;
constexpr size_t WS_GCB = 5 * MiB;
constexpr size_t WS_AFF = 5 * MiB;
constexpr size_t WS_SLOT = 6 * MiB;
constexpr size_t WS_IDX = 7 * MiB;
constexpr size_t WS_GATE = 7 * MiB + 256 * 1024;
constexpr size_t WS_WIN = 8 * MiB;
constexpr size_t WS_WOUT = 17 * MiB;
constexpr size_t WS_POOLW = 19 * MiB;
constexpr size_t WS_WMOE = 20 * MiB;
constexpr size_t WS_W2T = WS_WMOE + 64 * MiB;
constexpr size_t WMOE_LAYER = 96 * MiB;
constexpr size_t WS_H = 212 * MiB;
constexpr size_t WS_U = 276 * MiB;
constexpr size_t WS_ON = 310 * MiB;
constexpr size_t WS_G = 342 * MiB;
constexpr size_t WS_P = WS_G;
constexpr size_t WS_QKV = WS_G + 136 * MiB;
constexpr size_t WS_KT = WS_G + 238 * MiB;
constexpr size_t WS_VT = WS_G + 272 * MiB;
constexpr size_t WS_W = WS_G + 306 * MiB;
constexpr size_t WS_UT = WS_G + 374 * MiB;
constexpr size_t WS_ATT = WS_G + 442 * MiB;
constexpr size_t WS_O = WS_G + 476 * MiB;
constexpr size_t WS_XS = WS_G;
constexpr size_t WS_HID = WS_G + 64 * MiB;
constexpr size_t WS_YS = WS_G + 192 * MiB;
constexpr size_t WS_END = WS_G + 604 * MiB;

constexpr int LDS_BYTES = 163840;

typedef __bf16 bf16v2 __attribute__((ext_vector_type(2)));
__device__ __forceinline__ unsigned pk2(float lo, float hi) { const f32x2 v = {lo, hi}; return __builtin_bit_cast(unsigned, __builtin_convertvector(v, bf16v2)); }
__device__ __forceinline__ unsigned f2bf(float f) { return pk2(f, 0.f) & 0xffffu; }
__device__ __forceinline__ float bflo(unsigned w) { return __uint_as_float(w << 16); }
__device__ __forceinline__ float bfhi(unsigned w) { return __uint_as_float(w & 0xffff0000u); }
__device__ __forceinline__ float bf1(bf16_t b) { return __uint_as_float(((unsigned)b) << 16); }
#define DPP_ADD(v, ctrl) ((v) + __builtin_bit_cast(float, __builtin_amdgcn_update_dpp(0, __builtin_bit_cast(int, (v)), (ctrl), 0xf, 0xf, true)))
__device__ __forceinline__ float row16_sum(float v) {
    v = DPP_ADD(v, 0xB1); v = DPP_ADD(v, 0x4E); v = DPP_ADD(v, 0x141); v = DPP_ADD(v, 0x140); return v;
}
__device__ __forceinline__ float wave_sum(float v) { v = row16_sum(v); v += __shfl_xor(v, 16); v += __shfl_xor(v, 32); return v; }
__device__ __forceinline__ float siluf(float x) { return x * __builtin_amdgcn_rcpf(1.f + __expf(-x)); }
__device__ __forceinline__ float sigmoidf(float x) { return __builtin_amdgcn_rcpf(1.f + __expf(-x)); }
__device__ __forceinline__ float softplusf(float x) { return fmaxf(x, 0.f) + log1pf(__expf(-fabsf(x))); }
__device__ __forceinline__ float rnd_fp8(float x) { const int p = __builtin_amdgcn_cvt_pk_fp8_f32(x, x, 0, false); return __builtin_amdgcn_cvt_f32_fp8(p, 0); }
__device__ __forceinline__ unsigned pk4_fp8(float a, float b, float c, float d) { int p = __builtin_amdgcn_cvt_pk_fp8_f32(a, b, 0, false); p = __builtin_amdgcn_cvt_pk_fp8_f32(c, d, p, true); return (unsigned)p; }
#define LDS_WAIT() asm volatile("s_waitcnt lgkmcnt(0)" ::: "memory")

namespace pg8 {
constexpr int BM = 256, BK = 64, HALF = 128, HTB = HALF * BK * 2, STAGE_BYTES = 8 * HTB;
__device__ __forceinline__ int lds_byte(int r, int c) { const int st = (r >> 4) * 2 + (c >> 5), rr = r & 15, cc = c & 31, ob = rr * 64 + cc * 2; return st * 1024 + (ob ^ (((ob >> 9) & 1) << 5)); }
__device__ __forceinline__ void stage_rc(int b, int& R, int& C) { const int st = b / 1024, sb = b % 1024, swz = sb ^ (((sb >> 9) & 1) << 5); R = (st >> 1) * 16 + swz / 64; C = (st & 1) * 32 + (swz % 64) / 2; }

struct Unit { int pm, pn, pb, ak; };
struct Gemm { const bf16_t* A; const bf16_t* Bt; int lda, K; };

#ifndef PG8_SP2
#define PG8_SP2 true
#endif
#ifndef PG8_ALIGN
#define PG8_ALIGN true
#endif
typedef int v8i32 __attribute__((ext_vector_type(8)));
__device__ __forceinline__ v8i32 cat8(const bf16x8 lo, const bf16x8 hi) { const u32x4 a = __builtin_bit_cast(u32x4, lo), b = __builtin_bit_cast(u32x4, hi); return (v8i32){(int)a.x, (int)a.y, (int)a.z, (int)a.w, (int)b.x, (int)b.y, (int)b.z, (int)b.w}; }
template <class Epi, class Sched, bool FP8 = false, bool ALIGN_EPI = PG8_ALIGN, bool SP2 = PG8_SP2>
__device__ __forceinline__ void gemm_phase(LAS unsigned char* lds, const Gemm g, const Sched& S, const Epi& E) {
    constexpr int ES = FP8 ? 1 : 2;
    int tid = threadIdx.x; asm volatile("" : "+v"(tid));
    const int wid = __builtin_amdgcn_readfirstlane(tid >> 6), lane = tid & 63, wr = wid >> 2, wc = wid & 3, fr = lane & 15, fq = lane >> 4;
    int K = g.K, lda = g.lda; asm volatile("" : "+s"(K), "+s"(lda));
    const int nt = K * ES / (BK * 2);
    unsigned voffA[2], voffB[2];
#pragma unroll
    for (int i = 0; i < 2; ++i) { int R, C; stage_rc(tid * 16 + i * 8192, R, C); voffA[i] = (unsigned)(R * lda * ES + C * 2); voffB[i] = (unsigned)(R * K * ES + C * 2); }
    const size_t kstep = (size_t)(BK * 2);
    const size_t hsA = (size_t)HALF * lda * ES, hsB = (size_t)HALF * K * ES;
    const unsigned ldsw = (unsigned)wid * 1024u;
    const int aoff0 = FP8 ? lds_byte(wr * 64 + fr, fq * 16) : lds_byte(wr * 64 + fr, fq * 8), aoff1 = FP8 ? aoff0 + 16 : aoff0 + 1024;
    const int boff0 = FP8 ? lds_byte(wc * 32 + fr, fq * 16) : lds_byte(wc * 32 + fr, fq * 8), boff1 = FP8 ? boff0 + 16 : boff0 + 1024;
#define PG8_SA(b, h) (((b) * 2 + (h)) * HTB)
#define PG8_SB(b, h) ((4 + (b) * 2 + (h)) * HTB)
#define PG8_STAGE(bufoff, gbase, voff) do { _Pragma("unroll") for (int _i = 0; _i < 2; ++_i) \
        __builtin_amdgcn_global_load_lds((const unsigned*)((const char*)(gbase) + (voff)[_i]), (LAS unsigned*)(lds + (bufoff) + ldsw + _i * 8192), 16, 0, 0); } while (0)
#define PG8_LD2(dst, off0, off1) do { if constexpr (FP8) { dst.v = *(const LAS v8i32*)(lds + (off0)); } else { const u32x4 _lo = *(const LAS u32x4*)(lds + (off0)), _hi = *(const LAS u32x4*)(lds + (off1)); \
        dst.v = (v8i32){(int)_lo.x, (int)_lo.y, (int)_lo.z, (int)_lo.w, (int)_hi.x, (int)_hi.y, (int)_hi.z, (int)_hi.w}; } } while (0)
#define PG8_LDA(dst, b, h) do { if constexpr (FP8) { _Pragma("unroll") for (int m = 0; m < 4; ++m) PG8_INS8(A32, m, *(const LAS v8i32*)(lds + PG8_SA(b, h) + aoff0 + m * 2048)); } \
        else { _Pragma("unroll") for (int m = 0; m < 4; ++m) PG8_LD2(dst[m], PG8_SA(b, h) + aoff0 + m * 2048, PG8_SA(b, h) + aoff1 + m * 2048); } } while (0)
#define PG8_LDB(dst, b, h) do { if constexpr (FP8) { _Pragma("unroll") for (int n = 0; n < 2; ++n) PG8_INS8(B32, 2 * (h) + n, *(const LAS v8i32*)(lds + PG8_SB(b, h) + boff0 + n * 2048)); } \
        else { _Pragma("unroll") for (int n = 0; n < 2; ++n) PG8_LD2(dst[n], PG8_SB(b, h) + boff0 + n * 2048, PG8_SB(b, h) + boff1 + n * 2048); } } while (0)
#define PG8_MMA(ai, bj, At, Bt) do { __builtin_amdgcn_s_setprio(1); _Pragma("unroll") for (int m = 0; m < 4; ++m) _Pragma("unroll") for (int n = 0; n < 2; ++n) { \
        if constexpr (FP8) { const v8i32 _b = PG8_SUB8(B32, 2 * (bj) + n), _a = PG8_SUB8(A32, m); \
            asm volatile("v_mfma_scale_f32_16x16x128_f8f6f4 %0, %1, %2, %0, %3, %3 op_sel_hi:[0,0,0]" : "+v"(acc[ai][bj][m][n]) : "v"(_b), "v"(_a), "v"(sc1)); } \
        else { acc[ai][bj][m][n] = __builtin_amdgcn_mfma_f32_16x16x32_bf16(Bt[n].lo(), At[m].lo(), acc[ai][bj][m][n], 0, 0, 0); acc[ai][bj][m][n] = __builtin_amdgcn_mfma_f32_16x16x32_bf16(Bt[n].hi(), At[m].hi(), acc[ai][bj][m][n], 0, 0, 0); } } \
        __builtin_amdgcn_s_setprio(0); } while (0)
#define PG8_WAIT_V(n) asm volatile("s_waitcnt vmcnt(" #n ")" ::: "memory")
#define PG8_WAIT_L(n) asm volatile("s_waitcnt lgkmcnt(" #n ")" ::: "memory")
#define PG8_BAR __builtin_amdgcn_s_barrier()
#define PG8_SCHED __builtin_amdgcn_sched_barrier(0)
    Unit cur, nxt; int ui = 0;
    if (!S.next(0, cur)) return;
    f32x4 acc[2][2][4][2];
#pragma unroll
    for (int a = 0; a < 2; ++a)
#pragma unroll
        for (int b = 0; b < 2; ++b)
#pragma unroll
            for (int m = 0; m < 4; ++m)
#pragma unroll
                for (int n = 0; n < 2; ++n) acc[a][b][m][n] = (f32x4){0.f, 0.f, 0.f, 0.f};
    struct Frag2 { v8i32 v;
        __device__ __forceinline__ bf16x8 lo() const { const u32x4 t = {(unsigned)v[0], (unsigned)v[1], (unsigned)v[2], (unsigned)v[3]}; return __builtin_bit_cast(bf16x8, t); }
        __device__ __forceinline__ bf16x8 hi() const { const u32x4 t = {(unsigned)v[4], (unsigned)v[5], (unsigned)v[6], (unsigned)v[7]}; return __builtin_bit_cast(bf16x8, t); } };
    Frag2 At[4], B0[2], B1[2];
    typedef int v32i32 __attribute__((ext_vector_type(32)));
    int sc1 = 0x7f7f7f7f; asm volatile("" : "+v"(sc1));
    v32i32 A32, B32;
#define PG8_SUB8(V, i) ((v8i32){V[8 * (i)], V[8 * (i) + 1], V[8 * (i) + 2], V[8 * (i) + 3], V[8 * (i) + 4], V[8 * (i) + 5], V[8 * (i) + 6], V[8 * (i) + 7]})
#define PG8_INS8(V, i, X) do { const v8i32 _x = (X); _Pragma("unroll") for (int _e = 0; _e < 8; ++_e) V[8 * (i) + _e] = _x[_e]; } while (0)
    const char* cA = (const char*)g.A + ((size_t)cur.pm * BM * lda + cur.ak) * ES; const char* cB = (const char*)g.Bt + (size_t)cur.pb * BM * K * ES;
    if constexpr (SP2) {
        PG8_STAGE(PG8_SB(0, 0), cB, voffB); PG8_STAGE(PG8_SB(0, 1), cB + hsB, voffB); PG8_STAGE(PG8_SA(0, 0), cA, voffA); PG8_STAGE(PG8_SA(0, 1), cA + hsA, voffA);
        if (wr == 1) PG8_BAR;
        PG8_WAIT_V(2); PG8_BAR;
        PG8_STAGE(PG8_SB(1, 0), cB + kstep, voffB); PG8_STAGE(PG8_SA(1, 0), cA + kstep, voffA); PG8_STAGE(PG8_SB(1, 1), cB + hsB + kstep, voffB);
        PG8_WAIT_V(6); PG8_BAR;
    } else {
        PG8_STAGE(PG8_SB(0, 0), cB, voffB); PG8_STAGE(PG8_SA(0, 0), cA, voffA); PG8_STAGE(PG8_SB(0, 1), cB + hsB, voffB); PG8_STAGE(PG8_SA(0, 1), cA + hsA, voffA);
        if (wr == 1) PG8_BAR;
        PG8_WAIT_V(4); PG8_BAR;
        PG8_STAGE(PG8_SB(1, 0), cB + kstep, voffB); PG8_STAGE(PG8_SA(1, 0), cA + kstep, voffA); PG8_STAGE(PG8_SB(1, 1), cB + hsB + kstep, voffB);
        PG8_WAIT_V(6); PG8_BAR;
    }
    for (;;) {
        const bool has_next = S.next(ui + 1, nxt);
        const char* nA = has_next ? (const char*)g.A + ((size_t)nxt.pm * BM * lda + nxt.ak) * ES : cA; const char* nB = has_next ? (const char*)g.Bt + (size_t)nxt.pb * BM * K * ES : cB;
#pragma unroll 1
        for (int t = 0; t < nt; t += 2) {
            const bool last = (t == nt - 2);
            const char* a1 = cA + (size_t)(t + 1) * kstep;
            const char* a2 = last ? nA : cA + (size_t)(t + 2) * kstep; const char* b2 = last ? nB : cB + (size_t)(t + 2) * kstep;
            const char* a3 = a2 + kstep; const char* b3 = b2 + kstep;
            if constexpr (SP2) {
            PG8_LDB(B0, 0, 0); PG8_LDB(B1, 0, 1); PG8_SCHED; PG8_LDA(At, 0, 0); PG8_STAGE(PG8_SA(1, 1), a1 + hsA, voffA);
            PG8_WAIT_V(8); PG8_WAIT_L(0); PG8_BAR; PG8_MMA(0, 0, At, B0); PG8_MMA(0, 1, At, B1); PG8_BAR; PG8_SCHED;
            PG8_LDA(At, 0, 1); PG8_STAGE(PG8_SB(0, 0), b2, voffB); PG8_STAGE(PG8_SB(0, 1), b2 + hsB, voffB); PG8_STAGE(PG8_SA(0, 0), a2, voffA);
            PG8_WAIT_V(8); PG8_WAIT_L(0); PG8_BAR; PG8_MMA(1, 0, At, B0); PG8_MMA(1, 1, At, B1); PG8_BAR; PG8_SCHED;
            PG8_LDB(B0, 1, 0); PG8_LDB(B1, 1, 1); PG8_SCHED; PG8_LDA(At, 1, 0); PG8_STAGE(PG8_SA(0, 1), a2 + hsA, voffA);
            PG8_WAIT_V(8); PG8_WAIT_L(0); PG8_BAR; PG8_MMA(0, 0, At, B0); PG8_MMA(0, 1, At, B1); PG8_BAR; PG8_SCHED;
            PG8_LDA(At, 1, 1); PG8_STAGE(PG8_SB(1, 0), b3, voffB); PG8_STAGE(PG8_SB(1, 1), b3 + hsB, voffB); PG8_STAGE(PG8_SA(1, 0), a3, voffA);
            PG8_WAIT_V(8); PG8_WAIT_L(0); PG8_BAR; PG8_MMA(1, 0, At, B0); PG8_MMA(1, 1, At, B1); PG8_BAR; PG8_SCHED;
            } else {
            PG8_LDB(B0, 0, 0); PG8_SCHED; PG8_LDA(At, 0, 0); PG8_STAGE(PG8_SA(1, 1), a1 + hsA, voffA);
            PG8_WAIT_L(8); PG8_BAR; PG8_WAIT_L(0); PG8_MMA(0, 0, At, B0); PG8_BAR; PG8_SCHED;
            PG8_LDB(B1, 0, 1); PG8_STAGE(PG8_SB(0, 0), b2, voffB);
            PG8_BAR; PG8_WAIT_L(0); PG8_MMA(0, 1, At, B1); PG8_BAR;
            PG8_LDA(At, 0, 1); PG8_STAGE(PG8_SA(0, 0), a2, voffA);
            PG8_BAR; PG8_WAIT_L(0); PG8_MMA(1, 0, At, B0); PG8_BAR; PG8_SCHED;
            PG8_STAGE(PG8_SB(0, 1), b2 + hsB, voffB);
            PG8_WAIT_V(6); PG8_BAR; PG8_MMA(1, 1, At, B1); PG8_BAR;
            PG8_LDB(B0, 1, 0); PG8_SCHED; PG8_LDA(At, 1, 0); PG8_STAGE(PG8_SA(0, 1), a2 + hsA, voffA);
            PG8_WAIT_L(8); PG8_BAR; PG8_WAIT_L(0); PG8_MMA(0, 0, At, B0); PG8_BAR; PG8_SCHED;
            PG8_LDB(B1, 1, 1); PG8_STAGE(PG8_SB(1, 0), b3, voffB);
            PG8_BAR; PG8_WAIT_L(0); PG8_MMA(0, 1, At, B1); PG8_BAR;
            PG8_LDA(At, 1, 1); PG8_STAGE(PG8_SA(1, 0), a3, voffA);
            PG8_BAR; PG8_WAIT_L(0); PG8_MMA(1, 0, At, B0); PG8_BAR; PG8_SCHED;
            PG8_STAGE(PG8_SB(1, 1), b3 + hsB, voffB);
            PG8_WAIT_V(6); PG8_BAR; PG8_MMA(1, 1, At, B1); PG8_BAR;
            }
        }
        if constexpr (ALIGN_EPI) { if (wr == 0) PG8_BAR; }
        if constexpr (FP8) asm volatile("s_nop 15\n\ts_nop 15" ::: "memory");
        E(acc, cur, wr, wc, fr, fq);
        if (!has_next) break;
#pragma unroll
        for (int a = 0; a < 2; ++a)
#pragma unroll
            for (int b = 0; b < 2; ++b)
#pragma unroll
                for (int m = 0; m < 4; ++m)
#pragma unroll
                    for (int n = 0; n < 2; ++n) acc[a][b][m][n] = (f32x4){0.f, 0.f, 0.f, 0.f};
        cur = nxt; cA = nA; cB = nB; ++ui;
        if constexpr (ALIGN_EPI) { if (wr == 1) PG8_BAR; }
    }
    PG8_WAIT_V(0);
    if constexpr (!ALIGN_EPI) { if (wr == 0) PG8_BAR; }
    PG8_BAR;
#undef PG8_SA
#undef PG8_SB
#undef PG8_STAGE
#undef PG8_LDA
#undef PG8_LDB
#undef PG8_MMA
#undef PG8_WAIT_V
#undef PG8_WAIT_L
#undef PG8_BAR
#undef PG8_SCHED
#undef PG8_SUB8
#undef PG8_INS8
}

struct DenseOrder {
    int nM, nN, nwg, G, c;
    __device__ __forceinline__ void init(int nM_, int nN_, int G_, int c_) { nM = nM_; nN = nN_; nwg = nM * nN; G = G_; c = c_; }
    __device__ __forceinline__ bool next(int i, Unit& u) const {
        const long L = (long)i * G + c; if (L >= nwg) return false;
        int wgid = (int)L; { const int q = nwg / 8, r = nwg % 8, xcd = wgid % 8, off = wgid / 8; wgid = (xcd < r ? xcd * (q + 1) : r * (q + 1) + (xcd - r) * q) + off; }
        const int nig = 8 * nN, gid = wgid / nig, fm = gid * 8, gsz = (nM - fm) < 8 ? (nM - fm) : 8;
        u.pm = fm + ((wgid % nig) % gsz); u.pn = (wgid % nig) / gsz; u.pb = u.pn; u.ak = 0; return true;
    }
};
struct MoeUpOrder {
    int G, c;
    __device__ __forceinline__ bool next(int i, Unit& u) const {
        const int L = i * G + c; if (L >= 2048) return false;
        const int r = L / 256, cc = L % 256, x = cc % 8, j = cc / 8;
        const int e = 2 * x + (r >> 2); u.pm = e * 8 + (j & 7); u.pn = 4 * (r & 3) + (j >> 3); u.pb = e * 16 + u.pn; u.ak = 0; return true;
    }
};
struct MoeDownOrder {
    int G, c;
    __device__ __forceinline__ bool next(int i, Unit& u) const {
        const int L = i * G + c; if (L >= 512) return false;
        const int r = L / 256, cc = L % 256, x = cc % 8, j = cc / 8;
        const int e = 8 * r + x; u.pm = e * 8 + (j & 7); u.pn = j >> 3; u.pb = e * 4 + u.pn; u.ak = 0; return true;
    }
};
struct PoolOrder {
    int G, c;
    __device__ __forceinline__ bool next(int i, Unit& u) const {
        const int L = i * G + c; if (L >= 256) return false;
        const int x = L % 8, j = L / 8; u.pm = x * 8 + (j & 7); u.pn = j >> 3; u.pb = u.pn; u.ak = u.pn * 256; return true;
    }
};

struct EpiInProj {
    bf16_t* P; float* AB;
    __device__ __forceinline__ void operator()(const f32x4 (&acc)[2][2][4][2], const Unit& u, int wr, int wc, int fr, int fq) const {
        const int row0 = u.pm * BM + wr * 64 + fr;
        if (u.pn < 16) {
            const int col0 = u.pn * BM + wc * 32 + 4 * fq;
#pragma unroll
            for (int ai = 0; ai < 2; ++ai)
#pragma unroll
                for (int m = 0; m < 4; ++m) { bf16_t* rowp = P + (size_t)(row0 + ai * HALF + m * 16) * NP + col0;
#pragma unroll
                    for (int bj = 0; bj < 2; ++bj)
#pragma unroll
                        for (int n = 0; n < 2; ++n) { const f32x4 v = acc[ai][bj][m][n]; u32x2 w; w.x = pk2(v[0], v[1]); w.y = pk2(v[2], v[3]); *(u32x2*)(rowp + bj * HALF + n * 16) = w; } }
        } else if (wc == 0) {
#pragma unroll
            for (int ai = 0; ai < 2; ++ai)
#pragma unroll
                for (int m = 0; m < 4; ++m) { float* rowp = AB + (size_t)(row0 + ai * HALF + m * 16) * 32 + 4 * fq;
#pragma unroll
                    for (int n = 0; n < 2; ++n) *(f32x4*)(rowp + n * 16) = acc[ai][0][m][n]; }
        }
    }
};
struct EpiOutProj {
    const float* X; float* H; const float* gate;
    __device__ __forceinline__ void operator()(const f32x4 (&acc)[2][2][4][2], const Unit& u, int wr, int wc, int fr, int fq) const {
        const int row0 = u.pm * BM + wr * 64 + fr, col0 = u.pn * BM + wc * 32 + 4 * fq;
        const float* gp = gate + (size_t)(u.pm * BM / T) * 6144 + col0;
        f32x4 gv[2][2];
#pragma unroll
        for (int bj = 0; bj < 2; ++bj)
#pragma unroll
            for (int n = 0; n < 2; ++n) gv[bj][n] = *(const f32x4*)(gp + bj * HALF + n * 16);
#pragma unroll
        for (int ai = 0; ai < 2; ++ai)
#pragma unroll
            for (int m = 0; m < 4; ++m) { const size_t off = (size_t)(row0 + ai * HALF + m * 16) * D + col0;
#pragma unroll
                for (int bj = 0; bj < 2; ++bj)
#pragma unroll
                    for (int n = 0; n < 2; ++n) { const f32x4 xv = *(const f32x4*)(X + off + bj * HALF + n * 16); *(f32x4*)(H + off + bj * HALF + n * 16) = xv + gv[bj][n] * acc[ai][bj][m][n]; }
                asm volatile("" ::: "memory"); }
    }
};
struct EpiSwiglu {
    unsigned char* HID;
    __device__ __forceinline__ void operator()(const f32x4 (&acc)[2][2][4][2], const Unit& u, int wr, int wc, int fr, int fq) const {
        asm volatile("" : "+v"(fr), "+v"(fq));
        const int row0 = u.pm * BM + wr * 64 + fr, col0 = u.pn * HALF + wc * 32 + 4 * fq;
#pragma unroll
        for (int ai = 0; ai < 2; ++ai)
#pragma unroll
            for (int m = 0; m < 4; ++m) { unsigned char* rowp = HID + (size_t)(row0 + ai * HALF + m * 16) * DF + col0;
#pragma unroll
                for (int n = 0; n < 2; ++n) { const f32x4 g = acc[ai][0][m][n], up = acc[ai][1][m][n]; float h[4];
#pragma unroll
                    for (int j = 0; j < 4; ++j) h[j] = siluf(g[j] * 0.03125f) * (up[j] * 0.03125f);
                    *(unsigned*)(rowp + n * 16) = pk4_fp8(h[0], h[1], h[2], h[3]); } }
    }
};
struct EpiDown {
    bf16_t* YS; const float* gates;
    __device__ __forceinline__ void operator()(const f32x4 (&acc)[2][2][4][2], const Unit& u, int wr, int wc, int fr, int fq) const {
        asm volatile("" : "+v"(fr), "+v"(fq));
        const int row0 = u.pm * BM + wr * 64 + fr, col0 = u.pn * BM + wc * 32 + 4 * fq;
#pragma unroll
        for (int ai = 0; ai < 2; ++ai)
#pragma unroll
            for (int m = 0; m < 4; ++m) { const int row = row0 + ai * HALF + m * 16; const float gt = gates[row] * 0.03125f; bf16_t* rowp = YS + (size_t)row * D + col0;
#pragma unroll
                for (int bj = 0; bj < 2; ++bj)
#pragma unroll
                    for (int n = 0; n < 2; ++n) { const f32x4 v = acc[ai][bj][m][n] * gt; u32x2 w; w.x = pk2(v[0], v[1]); w.y = pk2(v[2], v[3]); *(u32x2*)(rowp + bj * HALF + n * 16) = w; } }
    }
};
struct EpiPool {
    float* H; const float* gate; const float* scale;
    __device__ __forceinline__ void operator()(const f32x4 (&acc)[2][2][4][2], const Unit& u, int wr, int wc, int fr, int fq) const {
        const int row0 = u.pm * BM + wr * 64 + fr, col0 = u.pn * BM + wc * 32 + 4 * fq;
        const float* gp = gate + (size_t)(u.pm * BM / T) * 6144 + col0;
        f32x4 gv[2][2];
#pragma unroll
        for (int bj = 0; bj < 2; ++bj)
#pragma unroll
            for (int n = 0; n < 2; ++n) gv[bj][n] = *(const f32x4*)(gp + bj * HALF + n * 16) * *(const f32x4*)(scale + col0 + bj * HALF + n * 16);
#pragma unroll
        for (int ai = 0; ai < 2; ++ai)
#pragma unroll
            for (int m = 0; m < 4; ++m) { const size_t off = (size_t)(row0 + ai * HALF + m * 16) * D + col0;
#pragma unroll
                for (int bj = 0; bj < 2; ++bj)
#pragma unroll
                    for (int n = 0; n < 2; ++n) { float* p = H + off + bj * HALF + n * 16; const f32x4 hv = *(const f32x4*)p; *(f32x4*)p = hv + gv[bj][n] * acc[ai][bj][m][n]; }
                asm volatile("" ::: "memory"); }
    }
};
}


#define XB_TMO      128
#define XB_XCNT(j)  (256  + 64 * (j))
#define XB_XSUB(j)  (1280 + 64 * (j))
#define XB_XGEN(j)  (2304 + 64 * (j))
#define XB_TOP      3328
#define XB_TOPGEN   3392
#define XCD_BAR_WORDS 3456
#define XB_SPIN_CAP (1u << 20)
__device__ __forceinline__ unsigned xb_ld(unsigned* p)              { return __hip_atomic_load(p, __ATOMIC_RELAXED, __HIP_MEMORY_SCOPE_AGENT); }
__device__ __forceinline__ unsigned xb_add(unsigned* p, unsigned v) { return __hip_atomic_fetch_add(p, v, __ATOMIC_RELAXED, __HIP_MEMORY_SCOPE_AGENT); }
__device__ __forceinline__ unsigned xb_xcc_id() { return (unsigned)__builtin_amdgcn_s_getreg((3 << 11) | 20) & 0xFu; }
#define XB_SPIN(cond, bar) do { unsigned _sp = 0; while (cond) { __builtin_amdgcn_s_sleep(1); \
    if ((++_sp & 255u) == 0u) { if (xb_ld(&(bar)[XB_TMO])) break; if (_sp > XB_SPIN_CAP) { atomicAdd(&(bar)[XB_TMO], 1u); break; } } } } while (0)
struct XcdBarrier { unsigned* bar; unsigned x; volatile LAS unsigned* st; };
__device__ __forceinline__ XcdBarrier xcd_barrier_post(unsigned* bar, volatile LAS unsigned* st) {
    XcdBarrier b; b.bar = bar; b.x = xb_xcc_id(); b.st = st;
    if (threadIdx.x == 0) (void)xb_add(&bar[XB_XCNT(b.x)], 1u);
    return b;
}
__device__ __forceinline__ void xcd_barrier_complete(unsigned* bar, unsigned x, unsigned& nloc, unsigned& nx) {
    const unsigned G = gridDim.x * gridDim.y * gridDim.z;
    unsigned sum, cnt, mine, sp = 0u;
    for (;;) {
        sum = 0u; cnt = 0u; mine = 0u;
#pragma unroll
        for (unsigned j = 0; j < 16; ++j) { const unsigned c = xb_ld(&bar[XB_XCNT(j)]); sum += c; cnt += (c > 0u) ? 1u : 0u; mine = (j == x) ? c : mine; }
        if (sum == G) break;
        __builtin_amdgcn_s_sleep(1);
        if ((++sp & 255u) == 0u) { if (xb_ld(&bar[XB_TMO])) break; if (sp > XB_SPIN_CAP) { atomicAdd(&bar[XB_TMO], 1u); break; } }
    }
    nloc = mine > 0u ? mine : 1u; nx = cnt > 0u ? cnt : 1u;
}
__device__ __forceinline__ void xcd_barrier(const XcdBarrier& b) {
    asm volatile("s_waitcnt vmcnt(0)" ::: "memory");
    __syncthreads();
    if (threadIdx.x == 0) {
        unsigned* bar = b.bar;
        __builtin_amdgcn_s_waitcnt(0);
        unsigned nloc = b.st[0], nx = b.st[1];
        if (nloc == 0u) { xcd_barrier_complete(bar, b.x, nloc, nx); b.st[0] = nloc; b.st[1] = nx; }
        const unsigned old = xb_add(&bar[XB_XSUB(b.x)], 1u);
        const unsigned gen = old / nloc;
        if (old + 1u == (gen + 1u) * nloc) {
            __builtin_amdgcn_fence(__ATOMIC_RELEASE, "agent");
            asm volatile("s_waitcnt vmcnt(0)" ::: "memory");
            const unsigned og = xb_add(&bar[XB_TOP], 1u);
            const unsigned tg = og / nx;
            if (og + 1u == (tg + 1u) * nx) xb_add(&bar[XB_TOPGEN], 1u);
            else XB_SPIN(xb_ld(&bar[XB_TOPGEN]) == tg, bar);
            __builtin_amdgcn_fence(__ATOMIC_ACQUIRE, "agent");
            xb_add(&bar[XB_XGEN(b.x)], 1u);
            asm volatile("s_waitcnt vmcnt(0)" ::: "memory");
        } else {
            XB_SPIN(xb_ld(&bar[XB_XGEN(b.x)]) == gen, bar);
            __builtin_amdgcn_fence(__ATOMIC_ACQUIRE, "agent");
            asm volatile("s_waitcnt vmcnt(0)" ::: "memory");
        }
    }
    __syncthreads();
}
constexpr int MISC_OFF = LDS_BYTES - 128;

struct Args { const float* in[21]; float* out; unsigned char* ws; int ph_lo, ph_hi; };
enum { I_X = 0, I_C, I_CTX, I_CCTX, I_WMOD, I_BMOD, I_GMIX, I_GFFN, I_WIN, I_CONVW, I_ALOG, I_DTB, I_OGAIN, I_WOUT, I_POOLW, I_POOLS, I_WR, I_WG, I_WU, I_WD, I_FING };

struct Frame {
    LAS unsigned char* lds;
    int tid, lane, wave, G, vcu;
    const float* in[21]; float* out; unsigned char* ws;
};

__device__ __forceinline__ void tr_tile(const float* __restrict__ src, int ld_src, int n_valid, bf16_t* dst_row0, int ld_dst, int k0, LAS unsigned char* scr, int lane, float q8 = 0.f) {
    const int nq = lane & 15, g = lane >> 4;
    f32x4 v[2][8];
    const bool ok = 4 * nq < n_valid;
#pragma unroll
    for (int i1 = 0; i1 < 2; ++i1)
#pragma unroll
        for (int i2 = 0; i2 < 8; ++i2) { const int k = 32 * i1 + 8 * g + i2;
            v[i1][i2] = ok ? *(const f32x4*)(src + (size_t)(k0 + k) * ld_src + 4 * nq) : (f32x4){0.f, 0.f, 0.f, 0.f}; }
#ifdef EMU_FP8
    if (q8 > 0.f) { const float iq = 1.f / q8;
#pragma unroll
        for (int i1 = 0; i1 < 2; ++i1)
#pragma unroll
            for (int i2 = 0; i2 < 8; ++i2)
#pragma unroll
                for (int j = 0; j < 4; ++j) v[i1][i2][j] = rnd_fp8(v[i1][i2][j] * q8) * iq; }
#endif
#pragma unroll
    for (int j = 0; j < 4; ++j)
#pragma unroll
        for (int i1 = 0; i1 < 2; ++i1) {
            u32x4 w; w.x = pk2(v[i1][0][j], v[i1][1][j]); w.y = pk2(v[i1][2][j], v[i1][3][j]); w.z = pk2(v[i1][4][j], v[i1][5][j]); w.w = pk2(v[i1][6][j], v[i1][7][j]);
            const int n = 4 * nq + j, c = 4 * i1 + g;
            *(LAS u32x4*)(scr + n * 128 + ((c ^ (nq & 7)) * 16)) = w; }
    LDS_WAIT();
#pragma unroll
    for (int it = 0; it < 8; ++it) { const int n = (lane >> 3) + 8 * it, c = lane & 7;
        const u32x4 w = *(const LAS u32x4*)(scr + n * 128 + ((c ^ ((n >> 2) & 7)) * 16));
        *(u32x4*)(dst_row0 + (size_t)n * ld_dst + k0 + 8 * c) = w; }
    LDS_WAIT();
}

__device__ __forceinline__ void tr_tile8(const float* __restrict__ src, int ld_src, unsigned char* dst_row0, int ld_dst, int k0, LAS unsigned char* scr, int lane) {
    const int nq = lane & 15, g = lane >> 4;
    f32x4 v[2][8];
#pragma unroll
    for (int i1 = 0; i1 < 2; ++i1)
#pragma unroll
        for (int i2 = 0; i2 < 8; ++i2) { const int k = 32 * i1 + 8 * g + i2; v[i1][i2] = *(const f32x4*)(src + (size_t)(k0 + k) * ld_src + 4 * nq) * 32.f; }
#pragma unroll
    for (int j = 0; j < 4; ++j)
#pragma unroll
        for (int i1 = 0; i1 < 2; ++i1) {
            u32x2 w; w.x = pk4_fp8(v[i1][0][j], v[i1][1][j], v[i1][2][j], v[i1][3][j]); w.y = pk4_fp8(v[i1][4][j], v[i1][5][j], v[i1][6][j], v[i1][7][j]);
            const int n = 4 * nq + j, c = 4 * i1 + g;
            *(LAS u32x2*)(scr + n * 64 + ((((c >> 1) ^ (nq & 3))) << 4) + (c & 1) * 8) = w; }
    LDS_WAIT();
#pragma unroll
    for (int it = 0; it < 4; ++it) { const int n = (lane >> 2) + 16 * it, p = lane & 3;
        const u32x4 w = *(const LAS u32x4*)(scr + n * 64 + ((p ^ ((n >> 2) & 3)) << 4));
        *(u32x4*)(dst_row0 + (size_t)n * ld_dst + k0 + 16 * p) = w; }
    LDS_WAIT();
}

constexpr int TR_SMALL = 16 * 68 + 256 + 64;
__device__ __forceinline__ void tr_small_job(Frame& F, int t, LAS unsigned char* scr) {
    if (t < 1088) { const int nt = t / 16, kt = t % 16; int nv = NPROJ - 64 * nt; nv = nv < 0 ? 0 : (nv > 64 ? 64 : nv);
        tr_tile(F.in[I_WIN] + 64 * nt, NPROJ, nv, (bf16_t*)(F.ws + WS_WIN) + (size_t)64 * nt * D, D, 64 * kt, scr, F.lane); return; }
    t -= 1088;
    if (t < 256) { const int nt = t / 16, kt = t % 16;
        tr_tile(F.in[I_WOUT] + 64 * nt, D, 64, (bf16_t*)(F.ws + WS_WOUT) + (size_t)64 * nt * D, D, 64 * kt, scr, F.lane); return; }
    t -= 256;
    { const int gi = t / 16, nt = (t % 16) / 4, kt = t % 4;
        tr_tile(F.in[I_POOLW] + (size_t)gi * 65536 + 64 * nt, 256, 64, (bf16_t*)(F.ws + WS_POOLW) + (size_t)gi * 65536 + (size_t)64 * nt * 256, 256, 64 * kt, scr, F.lane); }
}
constexpr int TR_MOE = 24576;
#ifndef FILL_CONV
#define FILL_CONV 2
#endif
#ifndef FILL_PREP
#define FILL_PREP 4
#endif
#ifndef FILL_INPROJ
#define FILL_INPROJ 3
#endif
__device__ __forceinline__ void tr_moe_job(Frame& F, int l, int t, LAS unsigned char* scr) {
    if (t < 16384) { const int e = t / 1024, r = t % 1024, which = r / 512, r2 = r % 512, nt = r2 / 16, kt = r2 % 16;
        const float* src = F.in[which ? I_WU : I_WG] + (size_t)(l * NE + e) * D * DF + 64 * nt;
        unsigned char* dst = (unsigned char*)(F.ws + WS_WMOE) + (size_t)l * WMOE_LAYER + ((size_t)e * 4096 + (nt >> 1) * 256 + which * 128 + (nt & 1) * 64) * D;
        tr_tile8(src, DF, dst, D, 64 * kt, scr, F.lane); return; }
    t -= 16384;
    { const int e = t / 512, r = t % 512, nt = r / 32, kt = r % 32;
        const float* src = F.in[I_WD] + (size_t)(l * NE + e) * DF * D + 64 * nt;
        unsigned char* dst = (unsigned char*)(F.ws + WS_W2T) + (size_t)l * WMOE_LAYER + ((size_t)e * D + 64 * nt) * DF;
        tr_tile8(src, D, dst, DF, 64 * kt, scr, F.lane); }
}

__device__ __forceinline__ void moe_convert_wave(Frame& F, int n, LAS unsigned char* scr) {
    unsigned* ctr = (unsigned*)(F.ws + WS_CTL) + 16384;
    for (int i = 0; i < n; ++i) {
        unsigned t = 0u;
        if (F.lane == 0) t = __hip_atomic_fetch_add(ctr, 1u, __ATOMIC_RELAXED, __HIP_MEMORY_SCOPE_AGENT);
        t = (unsigned)__builtin_amdgcn_readfirstlane((int)t);
        if (t >= 2u * TR_MOE) break;
        tr_moe_job(F, t >= (unsigned)TR_MOE, (int)(t >= (unsigned)TR_MOE ? t - TR_MOE : t), scr);
    }
}

__device__ __forceinline__ void mod_item(Frame& F, int item) {
    LAS float* act = (LAS float*)(F.lds + 65536);
    LAS float* part = (LAS float*)(F.lds + 65536 + 20480);
    const int l = item / 96, cgp = item % 96;
    for (int i = F.tid; i < 5 * D; i += NTHR) { const int r = i >> 10, k = i & 1023; const float x = r < 4 ? F.in[I_C][r * D + k] : F.in[I_CCTX][k]; act[i] = siluf(x); }
    __syncthreads();
    const int j = cgp * 64 + F.lane;
    const float* w = F.in[I_WMOD] + (size_t)l * D * 6144 + j;
    float a0 = 0.f, a1 = 0.f, a2 = 0.f, a3 = 0.f, a4 = 0.f;
    const int kb = F.wave * 128;
#pragma unroll 1
    for (int k0 = 0; k0 < 128; k0 += 32) {
        float wv[32];
#pragma unroll
        for (int k = 0; k < 32; ++k) wv[k] = w[(size_t)(kb + k0 + k) * 6144];
#pragma unroll
        for (int k = 0; k < 32; ++k) { const int kk = kb + k0 + k;
            a0 += act[kk] * wv[k]; a1 += act[D + kk] * wv[k]; a2 += act[2 * D + kk] * wv[k]; a3 += act[3 * D + kk] * wv[k]; a4 += act[4 * D + kk] * wv[k]; } }
    LAS float* pp = part + F.wave * 320 + F.lane;
    pp[0] = a0; pp[64] = a1; pp[128] = a2; pp[192] = a3; pp[256] = a4;
    __syncthreads();
    if (F.tid < 320) { const int r = F.tid >> 6, ln = F.tid & 63; float s = 0.f;
#pragma unroll
        for (int w8 = 0; w8 < 8; ++w8) s += part[w8 * 320 + r * 64 + ln];
        const int jj = cgp * 64 + ln;
        ((float*)(F.ws + WS_MOD))[(size_t)(l * 5 + r) * 6144 + jj] = s + F.in[I_BMOD][l * 6144 + jj]; }
    __syncthreads();
}

__device__ __forceinline__ void load_row(const float* p, int lane, f32x4 (&v)[4]) {
#pragma unroll
    for (int j = 0; j < 4; ++j) v[j] = ((const f32x4*)p)[lane + 64 * j];
}
__device__ __forceinline__ float row_rstd(const f32x4 (&v)[4]) {
    float s = 0.f;
#pragma unroll
    for (int j = 0; j < 4; ++j) s += (v[j][0] * v[j][0] + v[j][1] * v[j][1]) + (v[j][2] * v[j][2] + v[j][3] * v[j][3]);
    return rsqrtf(wave_sum(s) * (1.f / D) + EPS);
}
__device__ __forceinline__ void norm_mod(const f32x4 (&v)[4], float rstd, const float* g, const float* sh, const float* sc, int lane, f32x4 (&y)[4]) {
#pragma unroll
    for (int j = 0; j < 4; ++j) { const f32x4 gv = ((const f32x4*)g)[lane + 64 * j], shv = ((const f32x4*)sh)[lane + 64 * j], scv = ((const f32x4*)sc)[lane + 64 * j];
        y[j] = v[j] * rstd * gv * (1.f + scv) + shv; }
}
__device__ __forceinline__ void store_row_bf16(bf16_t* p, int lane, const f32x4 (&y)[4]) {
#pragma unroll
    for (int j = 0; j < 4; ++j) { u32x2 w; w.x = pk2(y[j][0], y[j][1]); w.y = pk2(y[j][2], y[j][3]); ((u32x2*)p)[lane + 64 * j] = w; }
}

__device__ __forceinline__ void phase_norm0(Frame& F) {
    const float* MOD = (const float*)(F.ws + WS_MOD);
    bf16_t* U = (bf16_t*)(F.ws + WS_U);
    for (int row = F.vcu * NWAVE + F.wave; row < MA; row += F.G * NWAVE) {
        const float* src; int mr;
        if (row < ML) { src = F.in[I_X] + (size_t)row * D; mr = row / T; } else { src = F.in[I_CTX] + (size_t)(row - ML) * D; mr = 4; }
        f32x4 v[4], y[4]; load_row(src, F.lane, v);
        const float rstd = row_rstd(v);
        const float* m = MOD + (size_t)mr * 6144;
        norm_mod(v, rstd, F.in[I_GMIX], m, m + D, F.lane, y);
        store_row_bf16(U + (size_t)row * D, F.lane, y);
    }
}

__device__ __forceinline__ void chunk_rows(int ci, int& row0, int& t0, int& slen) {
    if (ci < 256) { row0 = ci * 64; t0 = (ci & 63) * 64; slen = T; } else { const int cc = ci - 256; row0 = ML + cc * 64; t0 = (cc & 3) * 64; slen = TC; }
}
__device__ __forceinline__ void phase_conv(Frame& F) {
    const bf16_t* P = (const bf16_t*)(F.ws + WS_P);
    bf16_t* QKV = (bf16_t*)(F.ws + WS_QKV);
    bf16_t* KT = (bf16_t*)(F.ws + WS_KT);
    bf16_t* VT = (bf16_t*)(F.ws + WS_VT);
    LAS unsigned* kts = (LAS unsigned*)(F.lds + F.wave * 16896);
    LAS bf16_t* kts16 = (LAS bf16_t*)kts;
    const int lane = F.lane;
    for (int item = F.vcu * NWAVE + F.wave; item < NCHUNK * 24; item += F.G * NWAVE) {
        const int ci = item / 24, slab = item % 24;
        int row0, t0, slen; chunk_rows(ci, row0, t0, slen);
        const int col = slab * 128 + 2 * lane;
        float w0[5], w1[5];
#pragma unroll
        for (int j = 0; j < 5; ++j) { const f32x2 wv = *(const f32x2*)(F.in[I_CONVW] + (size_t)j * NQKV + col); w0[j] = wv[0]; w1[j] = wv[1]; }
        const bf16_t* src = P + (size_t)row0 * NP + col;
        unsigned rowsv[68];
#pragma unroll
        for (int j = 0; j < 68; ++j) { const int tt = j - 2; rowsv[j] = (t0 + tt >= 0 && t0 + tt < slen) ? *(const unsigned*)(src + (long)tt * NP) : 0u; }
        const int kind = slab >> 3;
#pragma unroll 1
        for (int t8 = 0; t8 < 64; t8 += 8) {
#pragma unroll
            for (int q = 0; q < 8; ++q) {
                const int tt = t8 + q;
                float y0 = 0.f, y1 = 0.f;
#pragma unroll
                for (int j = 0; j < 5; ++j) { y0 += w0[j] * bflo(rowsv[q + j]); y1 += w1[j] * bfhi(rowsv[q + j]); }
                y0 = siluf(y0); y1 = siluf(y1);
                if (kind < 2) { const float ss = wave_sum(y0 * y0 + y1 * y1); float sc = rsqrtf(ss + EPS); if (kind == 0) sc *= 0.08838834764831845f; y0 *= sc; y1 *= sc; }
                const unsigned pk = pk2(y0, y1);
                *(unsigned*)(QKV + (size_t)(row0 + tt) * NQKV + col) = pk;
                if (kind >= 1) { kts16[(2 * lane) * 66 + tt] = (bf16_t)(pk & 0xffffu); kts16[(2 * lane + 1) * 66 + tt] = (bf16_t)(pk >> 16); }
            }
#pragma unroll
            for (int j = 0; j < 60; ++j) rowsv[j] = rowsv[j + 8];
        }
        if (kind >= 1) {
            LDS_WAIT();
            unsigned* dst = (unsigned*)((kind == 1 ? KT : VT) + ((size_t)ci * NH + (slab & 7)) * 128 * 64);
#pragma unroll 8
            for (int it = 0; it < 64; ++it) { const int dk = 2 * it + (lane >> 5), dw = lane & 31; dst[dk * 32 + dw] = kts[dk * 33 + dw]; }
            LDS_WAIT();
        }
    }
#ifndef NO_FILL
    if (F.G == 256 && F.vcu * NWAVE + F.wave >= NCHUNK * 24 - 3 * 2048) moe_convert_wave(F, FILL_CONV, (LAS unsigned char*)kts);
#endif
}

__device__ __forceinline__ void chunk_gates(Frame& F, int row0, int h, int dir, int lane, float& gc, float& beta, float& gtot) {
    const float* ab = (const float*)(F.ws + WS_AB) + (size_t)(row0 + lane) * 32 + dir * 16 + h;
    const float a = ab[0], bb = ab[8];
    const float g = -__expf(F.in[I_ALOG][dir * NH + h]) * softplusf(a + F.in[I_DTB][dir * NH + h]);
    beta = sigmoidf(bb);
    float s = g;
#pragma unroll
    for (int o = 1; o < 64; o <<= 1) { const float t = __builtin_bit_cast(float, __builtin_amdgcn_ds_bpermute((lane - o) << 2, __builtin_bit_cast(int, s))); if (lane >= o) s += t; }
    gtot = __builtin_bit_cast(float, __builtin_amdgcn_readlane(__builtin_bit_cast(int, s), 63));
    gc = dir ? (gtot - s + g) : s;
}

template <int V> __device__ __forceinline__ void phase_prep(Frame& F) {
    const bf16_t* QKV = (const bf16_t*)(F.ws + WS_QKV);
    LAS float* As = (LAS float*)(F.lds + F.wave * 17408);
    LAS float* gs = (LAS float*)(F.lds + F.wave * 17408 + 16384);
#pragma unroll 1
    for (int item = F.vcu * NWAVE + F.wave; item < NCHUNK * NH * 2; item += F.G * NWAVE) {
        const int ci = item >> 4, h = (item >> 1) & 7, dir = item & 1;
        int row0, t0, slen; chunk_rows(ci, row0, t0, slen);
        asm volatile("" ::: "memory");
        int lane_v; asm volatile("v_mbcnt_lo_u32_b32 %0, -1, 0\n\tv_mbcnt_hi_u32_b32 %0, -1, %0" : "=v"(lane_v));
        const int lane = lane_v, fr = lane & 15, fq = lane >> 4;
        const int d4 = 4 * (lane_v >> 4) - (lane_v & 15);
        const size_t dt = (size_t)(dir * NCHUNK + ci) * NH + h;
        const bf16_t* KTg = (const bf16_t*)(F.ws + WS_KT) + ((size_t)ci * NH + h) * 8192; const bf16_t* VTg = (const bf16_t*)(F.ws + WS_VT) + ((size_t)ci * NH + h) * 8192;
        {
            bf16x8 kf[4][4], qf[4][4];
#pragma unroll
            for (int mt = 0; mt < 4; ++mt)
#pragma unroll
                for (int ks = 0; ks < 4; ++ks) { const bf16_t* rp = QKV + (size_t)(row0 + 16 * mt + fr) * NQKV + h * 128 + 32 * ks + 8 * fq; kf[mt][ks] = *(const bf16x8*)(rp + 1024); qf[mt][ks] = *(const bf16x8*)rp; }
            float gc, beta, gtot; chunk_gates(F, row0, h, dir, lane, gc, beta, gtot);
            gs[lane] = gc; gs[64 + lane] = beta;
            { float* gcb = (float*)(F.ws + WS_GCB) + dt * 128; gcb[lane] = gc; gcb[64 + lane] = beta; }
            LDS_WAIT();
#pragma unroll
            for (int mi = 0; mi < (V == 3 ? 0 : 4); ++mi)
#pragma unroll
                for (int nj = 0; nj < 4; ++nj) {
                    if (dir == 0 ? (mi < nj) : (mi > nj)) continue;
                    f32x4 acc = {0.f, 0.f, 0.f, 0.f};
#pragma unroll
                    for (int ks = 0; ks < 4; ++ks) acc = __builtin_amdgcn_mfma_f32_16x16x32_bf16(kf[mi][ks], kf[nj][ks], acc, 0, 0, 0);
                    const int j = 16 * nj + fr; const float gj = gs[j];
#pragma unroll
                    for (int r = 0; r < 4; ++r) { const int i = 16 * mi + 4 * fq + r; const float gi = gs[i], bi = gs[64 + i];
                        const bool keep = (mi != nj) || (dir == 0 ? (d4 + r > 0) : (d4 + r < 0));
                        const float val = keep ? bi * acc[r] * __expf(gi - gj) : 0.f;
                        const int il = dir ? 63 - i : i, jl = dir ? 63 - j : j;
                        As[il * 64 + jl] = val; }
                }
            bf16_t* AT = (bf16_t*)(F.ws + WS_ATT) + dt * 4096;
#pragma unroll
            for (int mi = 0; mi < (V == 3 ? 0 : 4); ++mi) {
#pragma unroll
                for (int nj = 0; nj < 4; ++nj) {
                    const bool none = dir == 0 ? (mi < nj) : (mi > nj);
                    f32x4 acc = {0.f, 0.f, 0.f, 0.f};
                    if (!none) {
#pragma unroll
                        for (int ks = 0; ks < 4; ++ks) acc = __builtin_amdgcn_mfma_f32_16x16x32_bf16(kf[nj][ks], qf[mi][ks], acc, 0, 0, 0);
                    }
                    const int i = 16 * mi + fr; const float gi = gs[i];
                    float val[4];
#pragma unroll
                    for (int r = 0; r < 4; ++r) { const int j = 16 * nj + 4 * fq + r; const float gj = gs[j];
                        const bool keep = !none && ((mi != nj) || (dir == 0 ? (d4 + r <= 0) : (d4 + r >= 0)));
                        val[r] = keep ? acc[r] * __expf(gi - gj) : 0.f; }
                    u32x2 w; w.x = pk2(val[0], val[1]); w.y = pk2(val[2], val[3]);
                    *(u32x2*)(AT + i * 64 + 16 * nj + 4 * fq) = w;
                }
            }
        }
        bf16x8 ktf[8][2];
#pragma unroll
        for (int m8 = 0; m8 < 8; ++m8)
#pragma unroll
            for (int ks = 0; ks < 2; ++ks) ktf[m8][ks] = *(const bf16x8*)(KTg + (16 * m8 + fr) * 64 + 32 * ks + 8 * fq);
        LDS_WAIT();
        asm volatile("" ::: "memory");
        float t[64];
        const float lanef = (float)lane_v;
#pragma unroll
        for (int i = 0; i < 64; ++i) { float s0 = fmaxf(0.f, 1.f - fabsf(lanef - (float)i)), s1 = 0.f, s2 = 0.f, s3 = 0.f;
            asm volatile("" ::: "memory");
#pragma unroll
            for (int j = 0; j < (V == 1 ? 0 : i); ++j) { if (j == 32) asm volatile("" ::: "memory"); const float av = As[i * 64 + j];
                if ((j & 3) == 0) s0 -= av * t[j]; else if ((j & 3) == 1) s1 -= av * t[j]; else if ((j & 3) == 2) s2 -= av * t[j]; else s3 -= av * t[j]; }
            t[i] = (s0 + s1) + (s2 + s3); }
        bf16x8 vtf[8][2];
#pragma unroll
        for (int m8 = 0; m8 < 8; ++m8)
#pragma unroll
            for (int ks = 0; ks < 2; ++ks) vtf[m8][ks] = *(const bf16x8*)(VTg + (16 * m8 + fr) * 64 + 32 * ks + 8 * fq);
        {
            const int co = dir ? 63 - lane : lane;
            const float bco = gs[64 + co], sW = bco * __expf(gs[co]);
            LDS_WAIT();
            asm volatile("" ::: "memory");
            LAS unsigned char* Tl = (LAS unsigned char*)As;
#pragma unroll
            for (int i = 0; i < 64; ++i) { const int io = dir ? 63 - i : i;
                const int off = io * 128 + ((((co >> 3) ^ ((io >> 1) & 7))) << 4) + (co & 7) * 2;
                *(LAS bf16_t*)(Tl + off) = (bf16_t)f2bf(t[i] * sW); *(LAS bf16_t*)(Tl + 8192 + off) = (bf16_t)f2bf(t[i] * bco); }
            LDS_WAIT();
            asm volatile("" ::: "memory");
            bf16_t* Wg = (bf16_t*)(F.ws + WS_W) + dt * 8192; bf16_t* UTg = (bf16_t*)(F.ws + WS_UT) + dt * 8192;
            bf16x8 tf[4][2];
#pragma unroll
            for (int nt = 0; nt < 4; ++nt)
#pragma unroll
                for (int ks = 0; ks < 2; ++ks) { const int row = 16 * nt + fr, c = 4 * ks + fq; tf[nt][ks] = *(const LAS bf16x8*)(Tl + row * 128 + ((c ^ ((row >> 1) & 7)) << 4)); }
#pragma unroll
            for (int mtd = 0; mtd < (V == 2 ? 0 : 8); ++mtd) {
                const bf16x8 a0 = ktf[mtd][0], a1 = ktf[mtd][1];
#pragma unroll
                for (int nt = 0; nt < 4; ++nt) { f32x4 acc = {0.f, 0.f, 0.f, 0.f};
                    acc = __builtin_amdgcn_mfma_f32_16x16x32_bf16(a0, tf[nt][0], acc, 0, 0, 0); acc = __builtin_amdgcn_mfma_f32_16x16x32_bf16(a1, tf[nt][1], acc, 0, 0, 0);
                    u32x2 w; w.x = pk2(acc[0], acc[1]); w.y = pk2(acc[2], acc[3]);
                    if (V == 4) asm volatile("" :: "v"(w)); else *(u32x2*)(Wg + (16 * nt + fr) * 128 + 16 * mtd + 4 * fq) = w; }
            }
#pragma unroll
            for (int nt = 0; nt < 4; ++nt)
#pragma unroll
                for (int ks = 0; ks < 2; ++ks) { const int row = 16 * nt + fr, c = 4 * ks + fq; tf[nt][ks] = *(const LAS bf16x8*)(Tl + 8192 + row * 128 + ((c ^ ((row >> 1) & 7)) << 4)); }
#pragma unroll
            for (int ntd = 0; ntd < (V == 2 ? 0 : 8); ++ntd) {
                const bf16x8 b0 = vtf[ntd][0], b1 = vtf[ntd][1];
#pragma unroll
                for (int mt = 0; mt < 4; ++mt) { f32x4 acc = {0.f, 0.f, 0.f, 0.f};
                    acc = __builtin_amdgcn_mfma_f32_16x16x32_bf16(tf[mt][0], b0, acc, 0, 0, 0); acc = __builtin_amdgcn_mfma_f32_16x16x32_bf16(tf[mt][1], b1, acc, 0, 0, 0);
                    u32x2 w; w.x = pk2(acc[0], acc[1]); w.y = pk2(acc[2], acc[3]);
                    if (V == 4) asm volatile("" :: "v"(w)); else *(u32x2*)(UTg + (16 * ntd + fr) * 64 + 16 * mt + 4 * fq) = w; }
            }
        }
        LDS_WAIT();
    }
#ifndef NO_FILL
    if (F.G == 256 && F.vcu * NWAVE + F.wave >= NCHUNK * NH * 2 - 2 * 2048) moe_convert_wave(F, FILL_PREP, F.lds + F.wave * 17408);
#endif
}

constexpr int SC_W = 0, SC_Q = 16384, SC_KT = 32768, SC_AT = 49152, SC_UT = 57344, SC_GC = 65536, SC_SLOT = 65792;
constexpr int SC_ST = 2 * SC_SLOT, ST_ROW = 272, SC_VN = SC_ST + 64 * ST_ROW, RT_ROW = 144, SC_END = SC_VN + 64 * RT_ROW;
static_assert(SC_END <= LDS_BYTES - 128, "scan LDS map");
#define SC_WAIT_V(n) asm volatile("s_waitcnt vmcnt(" #n ")" ::: "memory")
#define SC_BAR() do { asm volatile("s_waitcnt lgkmcnt(0)" ::: "memory"); __builtin_amdgcn_s_barrier(); asm volatile("" ::: "memory"); } while (0)
struct ScanCtx { int b, h, dir, half, mt, np, fr, fq, w, lane; unsigned offW[2], offQ[2], offK[2], offA; };
__device__ __forceinline__ int sc_chunk(const ScanCtx& c, int n) { return n < 4 ? 256 + c.b * 4 + (c.dir ? 3 - n : n) : c.b * 64 + (c.dir ? 67 - n : n - 4); }
__device__ __forceinline__ void sc_dma(Frame& F, const ScanCtx& c, int n, int slotoff) {
    const int ci = sc_chunk(c, n); int row0, t0, sl; chunk_rows(ci, row0, t0, sl);
    const size_t dt = ((size_t)(c.dir * NCHUNK + ci) * NH + c.h);
    const char* gW = (const char*)(F.ws + WS_W) + dt * 16384; const char* gQ = (const char*)(F.ws + WS_QKV) + ((size_t)row0 * NQKV + c.h * 128) * 2;
    const char* gK = (const char*)(F.ws + WS_KT) + ((size_t)ci * NH + c.h) * 16384; const char* gA = (const char*)(F.ws + WS_ATT) + dt * 8192;
    const char* gU = (const char*)(F.ws + WS_UT) + dt * 16384 + c.half * 8192; const char* gG = (const char*)(F.ws + WS_GCB) + dt * 512;
    LAS unsigned char* lds = F.lds + slotoff;
#pragma unroll
    for (int i = 0; i < 2; ++i) {
        __builtin_amdgcn_global_load_lds((const unsigned*)(gW + c.offW[i]), (LAS unsigned*)(lds + SC_W + (2 * c.w + i) * 1024), 16, 0, 0);
        __builtin_amdgcn_global_load_lds((const unsigned*)(gQ + c.offQ[i]), (LAS unsigned*)(lds + SC_Q + (2 * c.w + i) * 1024), 16, 0, 0);
        __builtin_amdgcn_global_load_lds((const unsigned*)(gK + c.offK[i]), (LAS unsigned*)(lds + SC_KT + (2 * c.w + i) * 1024), 16, 0, 0); }
    __builtin_amdgcn_global_load_lds((const unsigned*)(gA + c.offA), (LAS unsigned*)(lds + SC_AT + c.w * 1024), 16, 0, 0);
    __builtin_amdgcn_global_load_lds((const unsigned*)(gU + c.offA), (LAS unsigned*)(lds + SC_UT + c.w * 1024), 16, 0, 0);
    __builtin_amdgcn_global_load_lds((const unsigned*)(gG + c.lane * 4), (LAS unsigned*)(lds + SC_GC), 4, 0, 0);
}
__device__ __forceinline__ void sc_store_o(Frame& F, const ScanCtx& c, int n, const f32x4 (&o)[2]) {
    const int lc = c.dir ? 67 - n : n - 4;
    float* Obase = (float*)(F.ws + WS_O);
#pragma unroll
    for (int u = 0; u < 2; ++u) { float* op_ = Obase + ((size_t)c.dir * ML + (size_t)c.b * T + lc * 64 + 16 * c.mt + 4 * c.fq) * D + c.h * 128 + c.half * 64 + 16 * (2 * c.np + u) + c.fr;
#pragma unroll
        for (int r = 0; r < 4; ++r) op_[(size_t)r * D] = o[u][r]; }
}
__device__ __forceinline__ void moe_convert_queue(Frame& F) {
    unsigned* ctr = (unsigned*)(F.ws + WS_CTL) + 16384;
    LAS unsigned* slot = (LAS unsigned*)(F.lds + 65536);
    LAS unsigned char* scr = F.lds + F.wave * 8192;
    for (;;) {
        __syncthreads();
        if (F.tid == 0) slot[0] = __hip_atomic_fetch_add(ctr, 8u, __ATOMIC_RELAXED, __HIP_MEMORY_SCOPE_AGENT);
        __syncthreads();
        const unsigned t = slot[0] + (unsigned)F.wave;
        if (slot[0] >= 2u * TR_MOE) break;
        if (t < 2u * TR_MOE) tr_moe_job(F, t >= (unsigned)TR_MOE, (int)(t >= (unsigned)TR_MOE ? t - TR_MOE : t), scr);
    }
    __syncthreads();
}
__device__ __forceinline__ void phase_scan(Frame& F) {
    const int xcd = F.vcu >> 5, jcu = F.vcu & 31;
    if (F.G != 256 || jcu >= 16) {
        moe_convert_queue(F);
        if (F.G == 256) return;
    }
    ScanCtx c;
    c.lane = F.lane; c.fr = c.lane & 15; c.fq = c.lane >> 4; c.w = F.wave; c.mt = c.w >> 1; c.np = c.w & 1;
#pragma unroll
    for (int i = 0; i < 2; ++i) {
        { const int I = 2 * c.w + i, row = 4 * I + (c.lane >> 4), cc = (c.lane & 15) ^ (row & 15); c.offW[i] = (unsigned)(row * 256 + cc * 16); c.offQ[i] = (unsigned)(row * (NQKV * 2) + cc * 16); }
        { const int I = 2 * c.w + i, row = 8 * I + (c.lane >> 3), cc = (c.lane & 7) ^ ((row >> 1) & 7); c.offK[i] = (unsigned)(row * 128 + cc * 16); }
    }
    { const int row = 8 * c.w + (c.lane >> 3), cc = (c.lane & 7) ^ ((row >> 1) & 7); c.offA = (unsigned)(row * 128 + cc * 16); }
    const int lane = c.lane, fr = c.fr, fq = c.fq, mt = c.mt, np = c.np;
    LAS unsigned char* const lds = F.lds;
    const int item0 = (F.G == 256) ? xcd * 16 + jcu : F.vcu, nitem = (F.G == 256) ? 128 : F.G;
    for (int item = item0; item < 128; item += nitem) {
        c.half = item & 1; c.dir = (item >> 1) & 1; c.h = (item >> 2) & 7; c.b = item >> 5;
        for (int i = F.tid; i < 64 * ST_ROW / 4; i += NTHR) ((LAS unsigned*)(lds + SC_ST))[i] = 0u;
        f32x4 Sacc[2][2];
#pragma unroll
        for (int ud = 0; ud < 2; ++ud)
#pragma unroll
            for (int uv = 0; uv < 2; ++uv) Sacc[ud][uv] = (f32x4){0.f, 0.f, 0.f, 0.f};
        f32x4 Oprev[2] = {{0.f, 0.f, 0.f, 0.f}, {0.f, 0.f, 0.f, 0.f}};
        sc_dma(F, c, 0, 0);
        SC_WAIT_V(0);
        SC_BAR();
        sc_dma(F, c, 1, SC_SLOT);
#pragma unroll 1
        for (int n = 0; n < 68; ++n) {
            const bool latent = n >= 4;
            const int so = (n & 1) * SC_SLOT;
            LAS unsigned char* const slot = lds + so;
            LAS unsigned char* const St = lds + SC_ST;
            f32x4 xacc[2], oacc[2];
#pragma unroll
            for (int u = 0; u < 2; ++u) { xacc[u] = (f32x4){0.f, 0.f, 0.f, 0.f}; oacc[u] = (f32x4){0.f, 0.f, 0.f, 0.f}; }
            const int arow = 16 * mt + fr;
#pragma unroll
            for (int ks = 0; ks < 4; ++ks) {
                const int co = (((4 * ks + fq) ^ fr) << 4);
                const bf16x8 aW = *(const LAS bf16x8*)(slot + SC_W + arow * 256 + co), aQ = *(const LAS bf16x8*)(slot + SC_Q + arow * 256 + co);
#pragma unroll
                for (int u = 0; u < 2; ++u) { const bf16x8 bS = *(const LAS bf16x8*)(St + (16 * (2 * np + u) + fr) * ST_ROW + (32 * ks + 8 * fq) * 2);
                    xacc[u] = __builtin_amdgcn_mfma_f32_16x16x32_bf16(aW, bS, xacc[u], 0, 0, 0);
                    oacc[u] = __builtin_amdgcn_mfma_f32_16x16x32_bf16(aQ, bS, oacc[u], 0, 0, 0); } }
            const f32x4 gc4 = *(const LAS f32x4*)(slot + SC_GC + (16 * mt + 4 * fq) * 4);
            const float gtot = *(const LAS float*)(slot + SC_GC + (c.dir ? 0 : 63) * 4);
#pragma unroll
            for (int u = 0; u < 2; ++u) { const int urow = 16 * (2 * np + u) + fr, uc = 2 * mt + (fq >> 1);
              const u32x2 uw = *(const LAS u32x2*)(slot + SC_UT + urow * 128 + ((uc ^ ((urow >> 1) & 7)) << 4) + 8 * (fq & 1));
              u32x2 pw; pw.x = pk2(bflo(uw.x) - xacc[u][0], bfhi(uw.x) - xacc[u][1]); pw.y = pk2(bflo(uw.y) - xacc[u][2], bfhi(uw.y) - xacc[u][3]);
              *(LAS u32x2*)(lds + SC_VN + urow * RT_ROW + (16 * mt + 4 * fq) * 2) = pw; }
            bf16x8 aK[2][2], aA[2];
#pragma unroll
            for (int ks = 0; ks < 2; ++ks) {
                aA[ks] = *(const LAS bf16x8*)(slot + SC_AT + arow * 128 + ((((4 * ks + fq) ^ ((arow >> 1) & 7))) << 4));
                const f32x4 g0 = *(const LAS f32x4*)(slot + SC_GC + (32 * ks + 8 * fq) * 4), g1 = *(const LAS f32x4*)(slot + SC_GC + (32 * ks + 8 * fq + 4) * 4);
                float e[8];
#pragma unroll
                for (int j = 0; j < 4; ++j) { e[j] = __expf(gtot - g0[j]); e[4 + j] = __expf(gtot - g1[j]); }
#pragma unroll
                for (int ud = 0; ud < 2; ++ud) { const int krow = 16 * (2 * mt + ud) + fr;
                    const u32x4 kw = *(const LAS u32x4*)(slot + SC_KT + krow * 128 + ((((4 * ks + fq) ^ ((krow >> 1) & 7))) << 4));
                    u32x4 o; o.x = pk2(bflo(kw.x) * e[0], bfhi(kw.x) * e[1]); o.y = pk2(bflo(kw.y) * e[2], bfhi(kw.y) * e[3]); o.z = pk2(bflo(kw.z) * e[4], bfhi(kw.z) * e[5]); o.w = pk2(bflo(kw.w) * e[6], bfhi(kw.w) * e[7]);
                    aK[ud][ks] = __builtin_bit_cast(bf16x8, o); } }
            SC_BAR();
            if (n - 1 >= 4) sc_store_o(F, c, n - 1, Oprev);
            if (n + 2 < 68) sc_dma(F, c, n + 2, so);
            bf16x8 bV[2][2];
#pragma unroll
            for (int u = 0; u < 2; ++u)
#pragma unroll
                for (int ks = 0; ks < 2; ++ks) bV[u][ks] = *(const LAS bf16x8*)(lds + SC_VN + (16 * (2 * np + u) + fr) * RT_ROW + (32 * ks + 8 * fq) * 2);
            if (latent) {
#pragma unroll
                for (int u = 0; u < 2; ++u) {
#pragma unroll
                    for (int r = 0; r < 4; ++r) oacc[u][r] *= __expf(gc4[r]);
#pragma unroll
                    for (int ks = 0; ks < 2; ++ks) oacc[u] = __builtin_amdgcn_mfma_f32_16x16x32_bf16(aA[ks], bV[u][ks], oacc[u], 0, 0, 0);
                    Oprev[u] = oacc[u];
                }
            }
            const float egt = __expf(gtot);
#pragma unroll
            for (int ud = 0; ud < 2; ++ud)
#pragma unroll
                for (int uv = 0; uv < 2; ++uv) {
                    Sacc[ud][uv] *= egt;
#pragma unroll
                    for (int ks = 0; ks < 2; ++ks) Sacc[ud][uv] = __builtin_amdgcn_mfma_f32_16x16x32_bf16(aK[ud][ks], bV[uv][ks], Sacc[ud][uv], 0, 0, 0);
                    u32x2 pw; pw.x = pk2(Sacc[ud][uv][0], Sacc[ud][uv][1]); pw.y = pk2(Sacc[ud][uv][2], Sacc[ud][uv][3]);
                    *(LAS u32x2*)(St + (16 * (2 * np + uv) + fr) * ST_ROW + (16 * (2 * mt + ud) + 4 * fq) * 2) = pw;
                }
            if (n + 2 < 68) SC_WAIT_V(9); else SC_WAIT_V(0);
            SC_BAR();
        }
        sc_store_o(F, c, 67, Oprev);
        SC_WAIT_V(0);
        SC_BAR();
    }
    if (F.G == 256) moe_convert_queue(F);
}

__device__ __forceinline__ void phase_gdn_out(Frame& F) {
    const float* O0 = (const float*)(F.ws + WS_O); const float* O1 = O0 + (size_t)ML * D;
    const bf16_t* P = (const bf16_t*)(F.ws + WS_P);
    bf16_t* ON = (bf16_t*)(F.ws + WS_ON);
    const int lane = F.lane;
    const f32x4 gain = *(const f32x4*)(F.in[I_OGAIN] + ((4 * lane) & 127));
    f32x4 an[4], bn[4];
    { const int r0 = F.vcu * NWAVE + F.wave; if (r0 < ML) { load_row(O0 + (size_t)r0 * D, lane, an); load_row(O1 + (size_t)r0 * D, lane, bn); } }
    for (int row = F.vcu * NWAVE + F.wave; row < ML; row += F.G * NWAVE) {
        f32x4 a[4], b[4];
#pragma unroll
        for (int j = 0; j < 4; ++j) { a[j] = an[j]; b[j] = bn[j]; }
        { const int nr = row + F.G * NWAVE; if (nr < ML) { load_row(O0 + (size_t)nr * D, lane, an); load_row(O1 + (size_t)nr * D, lane, bn); } }
        f32x4 y[4];
#pragma unroll
        for (int j = 0; j < 4; ++j) { const f32x4 o = a[j] + b[j];
            float ss = (o[0] * o[0] + o[1] * o[1]) + (o[2] * o[2] + o[3] * o[3]);
            ss = row16_sum(ss); ss += __shfl_xor(ss, 16);
            const float rs = rsqrtf(ss * (1.f / DH) + EPS);
            const u32x2 zw = ((const u32x2*)(P + (size_t)row * NP + NQKV))[lane + 64 * j];
            const float z0 = bflo(zw.x), z1 = bfhi(zw.x), z2 = bflo(zw.y), z3 = bfhi(zw.y);
            y[j][0] = o[0] * rs * gain[0] * siluf(z0); y[j][1] = o[1] * rs * gain[1] * siluf(z1); y[j][2] = o[2] * rs * gain[2] * siluf(z2); y[j][3] = o[3] * rs * gain[3] * siluf(z3); }
        store_row_bf16(ON + (size_t)row * D, lane, y);
    }
}

#define DPP_MAX(v, ctrl) fmaxf((v), __builtin_bit_cast(float, __builtin_amdgcn_update_dpp(0, __builtin_bit_cast(int, (v)), (ctrl), 0xf, 0xf, true)))
__device__ __forceinline__ float row16_max(float v) { v = DPP_MAX(v, 0xB1); v = DPP_MAX(v, 0x4E); v = DPP_MAX(v, 0x141); v = DPP_MAX(v, 0x140); return v; }
__device__ __forceinline__ float router_softmax(float (&lg)[16], int lane) {
    float mine = 0.f;
#pragma unroll
    for (int e = 0; e < 16; ++e) { const float s = row16_sum(lg[e]); mine = ((lane & 15) == e) ? s : mine; }
    mine += __shfl_xor(mine, 16); mine += __shfl_xor(mine, 32);
    const float mx = row16_max(mine), ex = __expf(mine - mx), den = row16_sum(ex);
    return ex * __builtin_amdgcn_rcpf(den);
}
__device__ __forceinline__ void phase_moe_pre(Frame& F, int l) {
    const float* MOD = (const float*)(F.ws + WS_MOD) + (size_t)l * 5 * 6144;
    const float* H = (const float*)(F.ws + WS_H);
    bf16_t* U = (bf16_t*)(F.ws + WS_U);
    float* AFF = (float*)(F.ws + WS_AFF);
    LAS float* wr = (LAS float*)F.lds;
    const float* wsrc = F.in[I_WR] + (size_t)l * D * NE;
    for (int i = F.tid; i < D * NE / 4; i += NTHR) { const int c = i >> 2, q = i & 3; *(LAS f32x4*)(wr + c * 16 + 4 * q + (c >> 2) * 4) = ((const f32x4*)wsrc)[i]; }
    __syncthreads();
    const int lane = F.lane, stride = F.G * NWAVE;
    for (int row = F.vcu * NWAVE + F.wave; row < ML; row += 2 * stride) {
        const int row1 = row + stride; const bool has1 = row1 < ML;
        f32x4 v0[4], v1[4], y0[4], y1[4];
        load_row(H + (size_t)row * D, lane, v0); load_row(H + (size_t)(has1 ? row1 : row) * D, lane, v1);
        const float rs0 = row_rstd(v0), rs1 = row_rstd(v1);
        norm_mod(v0, rs0, F.in[I_GFFN] + l * D, MOD + (size_t)(row / T) * 6144 + 3 * D, MOD + (size_t)(row / T) * 6144 + 4 * D, lane, y0);
        { const int r1 = has1 ? row1 : row; norm_mod(v1, rs1, F.in[I_GFFN] + l * D, MOD + (size_t)(r1 / T) * 6144 + 3 * D, MOD + (size_t)(r1 / T) * 6144 + 4 * D, lane, y1); }
#pragma unroll
        for (int j = 0; j < 4; ++j) { ((unsigned*)((unsigned char*)U + (size_t)row * D))[lane + 64 * j] = pk4_fp8(y0[j][0], y0[j][1], y0[j][2], y0[j][3]);
            if (has1) ((unsigned*)((unsigned char*)U + (size_t)row1 * D))[lane + 64 * j] = pk4_fp8(y1[j][0], y1[j][1], y1[j][2], y1[j][3]); }
        float lg0[16], lg1[16];
#pragma unroll
        for (int e = 0; e < 16; ++e) { lg0[e] = 0.f; lg1[e] = 0.f; }
#pragma unroll
        for (int j = 0; j < 4; ++j) {
            asm volatile("" ::: "memory");
#pragma unroll
            for (int i = 0; i < 4; ++i) { const int c = 4 * lane + 256 * j + i; const float a = y0[j][i], bq = y1[j][i];
#pragma unroll
                for (int q = 0; q < 4; ++q) { const f32x4 wv = *(const LAS f32x4*)(wr + c * 16 + 4 * q + (c >> 2) * 4);
                    lg0[4 * q] += a * wv[0]; lg0[4 * q + 1] += a * wv[1]; lg0[4 * q + 2] += a * wv[2]; lg0[4 * q + 3] += a * wv[3];
                    lg1[4 * q] += bq * wv[0]; lg1[4 * q + 1] += bq * wv[1]; lg1[4 * q + 2] += bq * wv[2]; lg1[4 * q + 3] += bq * wv[3]; } } }
        const float a0 = router_softmax(lg0, lane), a1 = router_softmax(lg1, lane);
        if (lane < 16) { AFF[((size_t)(row / T) * NE + lane) * T + row % T] = a0; if (has1) AFF[((size_t)(row1 / T) * NE + lane) * T + row1 % T] = a1; }
    }
    __syncthreads();
}

__device__ __forceinline__ void phase_topk(Frame& F) {
    LAS unsigned* cnt = (LAS unsigned*)F.lds;
    const float* AFF = (const float*)(F.ws + WS_AFF);
    int* SLOT = (int*)(F.ws + WS_SLOT); int* IDX = (int*)(F.ws + WS_IDX); float* GATE = (float*)(F.ws + WS_GATE);
    for (int item = F.vcu; item < NB * NE; item += F.G) {
        const int b = item / NE, e = item % NE;
        unsigned key[8];
        { const u32x4* p = (const u32x4*)(AFF + (size_t)item * T + F.tid * 8); const u32x4 k0 = p[0], k1 = p[1];
          key[0] = k0.x; key[1] = k0.y; key[2] = k0.z; key[3] = k0.w; key[4] = k1.x; key[5] = k1.y; key[6] = k1.z; key[7] = k1.w; }
        unsigned thr = 0u;
        int par = 0;
        for (int bit = 30; bit >= 0; --bit) {
            const unsigned cand = thr | (1u << bit);
            int c = 0;
#pragma unroll
            for (int i = 0; i < 8; ++i) c += (key[i] >= cand) ? 1 : 0;
#pragma unroll
            for (int o = 1; o < 64; o <<= 1) c += __shfl_xor(c, o);
            if (F.lane == 0) cnt[par * 8 + F.wave] = (unsigned)c;
            __syncthreads();
            unsigned tot = 0;
#pragma unroll
            for (int w8 = 0; w8 < 8; ++w8) tot += cnt[par * 8 + w8];
            if (tot >= (unsigned)CAP) thr = cand;
            par ^= 1;
        }
        __syncthreads();
        int cg_ = 0, ce_ = 0;
#pragma unroll
        for (int i = 0; i < 8; ++i) { cg_ += key[i] > thr; ce_ += key[i] == thr; }
        unsigned pk = (unsigned)cg_ | ((unsigned)ce_ << 16), inc = pk;
#pragma unroll
        for (int o = 1; o < 64; o <<= 1) { const unsigned t = __shfl_up(inc, o); if (F.lane >= o) inc += t; }
        LAS unsigned* wtot = cnt + 64;
        if (F.lane == 63) wtot[F.wave] = inc;
        __syncthreads();
        unsigned base = 0, total = 0;
#pragma unroll
        for (int w8 = 0; w8 < 8; ++w8) { const unsigned v = wtot[w8]; if (w8 < F.wave) base += v; total += v; }
        const unsigned excl = base + inc - pk;
        int gt_before = excl & 0xffffu, eq_before = excl >> 16;
        const int need_eq = CAP - (int)(total & 0xffffu);
#pragma unroll
        for (int i = 0; i < 8; ++i) {
            const int t = F.tid * 8 + i;
            const bool isg = key[i] > thr, ise = key[i] == thr;
            const bool sel = isg || (ise && eq_before < need_eq);
            const int slot = gt_before + (eq_before < need_eq ? eq_before : need_eq);
            SLOT[(size_t)item * T + t] = sel ? slot : -1;
            if (sel) { IDX[item * CAP + slot] = t; GATE[(size_t)e * 2048 + b * CAP + slot] = __uint_as_float(key[i]); }
            gt_before += isg; eq_before += ise;
        }
        __syncthreads();
    }
}

__device__ __forceinline__ void phase_gather(Frame& F) {
    const unsigned char* U = (const unsigned char*)(F.ws + WS_U); unsigned char* XS = (unsigned char*)(F.ws + WS_XS); const int* IDX = (const int*)(F.ws + WS_IDX);
    for (int r = F.vcu * NWAVE + F.wave; r < MX; r += F.G * NWAVE) {
        const int e = r / 2048, b = (r % 2048) / CAP, s = r % CAP;
        const int t = IDX[(b * NE + e) * CAP + s];
        ((u32x4*)(XS + (size_t)r * D))[F.lane] = ((const u32x4*)(U + ((size_t)b * T + t) * D))[F.lane];
    }
}

__device__ __forceinline__ void phase_combine(Frame& F, int l) {
    const float* MOD = (const float*)(F.ws + WS_MOD);
    float* H = (float*)(F.ws + WS_H); const bf16_t* YS = (const bf16_t*)(F.ws + WS_YS); const int* SLOT = (const int*)(F.ws + WS_SLOT);
    bf16_t* U = (bf16_t*)(F.ws + WS_U);
    const int lane = F.lane, stride = F.G * NWAVE;
    int row = F.vcu * NWAVE + F.wave;
    f32x4 vn[4]; int slotn = -1;
    if (row < ML) { load_row(H + (size_t)row * D, lane, vn); slotn = lane < NE ? SLOT[((size_t)(row / T) * NE + lane) * T + row % T] : -1; }
    for (; row < ML; row += stride) {
        const int b = row / T;
        f32x4 v[4]; const int myslot = slotn;
#pragma unroll
        for (int j = 0; j < 4; ++j) v[j] = vn[j];
        { const int nr = row + stride; if (nr < ML) { load_row(H + (size_t)nr * D, lane, vn); slotn = lane < NE ? SLOT[((size_t)(nr / T) * NE + lane) * T + nr % T] : -1; } }
        f32x4 acc[4];
#pragma unroll
        for (int j = 0; j < 4; ++j) acc[j] = (f32x4){0.f, 0.f, 0.f, 0.f};
        unsigned long long mask = __ballot(myslot >= 0);
        while (mask) {
            u32x2 yv[4][4]; bool have[4];
#pragma unroll
            for (int k = 0; k < 4; ++k) { have[k] = mask != 0ull;
                if (have[k]) { const int e = __builtin_ctzll(mask); mask &= mask - 1ull; const int sl = __builtin_amdgcn_readlane(myslot, e);
                    const u32x2* yp = (const u32x2*)(YS + ((size_t)e * 2048 + b * CAP + sl) * D);
#pragma unroll
                    for (int j = 0; j < 4; ++j) yv[k][j] = yp[lane + 64 * j]; } }
#pragma unroll
            for (int k = 0; k < 4; ++k) if (have[k]) {
#pragma unroll
                for (int j = 0; j < 4; ++j) { const u32x2 w = yv[k][j]; acc[j][0] += bflo(w.x); acc[j][1] += bfhi(w.x); acc[j][2] += bflo(w.y); acc[j][3] += bfhi(w.y); } }
        }
        const float* gtf = MOD + ((size_t)l * 5 + b) * 6144 + 5 * D;
#pragma unroll
        for (int j = 0; j < 4; ++j) v[j] += ((const f32x4*)gtf)[lane + 64 * j] * acc[j];
        const float rstd = row_rstd(v);
        if (l == 0) {
#pragma unroll
            for (int j = 0; j < 4; ++j) ((f32x4*)(H + (size_t)row * D))[lane + 64 * j] = v[j];
            const float* m = MOD + ((size_t)5 + b) * 6144; f32x4 y[4];
            norm_mod(v, rstd, F.in[I_GMIX] + D, m, m + D, lane, y);
            store_row_bf16(U + (size_t)row * D, lane, y);
        } else {
#pragma unroll
            for (int j = 0; j < 4; ++j) ((f32x4*)(F.out + (size_t)row * D))[lane + 64 * j] = v[j] * rstd * ((const f32x4*)F.in[I_FING])[lane + 64 * j];
        }
    }
}

template <int GI>
__device__ __forceinline__ void pool_item(Frame& F, int b, int r, LAS float* Vs, int cp, int cgp) {
    constexpr int W = 2 << GI, LO = W >> 1, HI = W - LO;
    const bf16_t* U = (const bf16_t*)(F.ws + WS_U); bf16_t* PD = (bf16_t*)(F.ws + WS_ON);
    const int r_lo = r - LO < 0 ? 0 : r - LO, r_hi = r + HI > 64 ? 64 : r + HI;
    float s0[16], s1[16]; unsigned self[16];
#pragma unroll
    for (int i = 0; i < 16; ++i) { s0[i] = 0.f; s1[i] = 0.f; }
    const bf16_t* base = U + ((size_t)b * T + cgp * 16) * D + GI * 256 + 2 * cp;
    int rr = r_lo;
    for (; rr + 4 <= r_hi; rr += 4) {
        unsigned x[4][16];
#pragma unroll
        for (int q = 0; q < 4; ++q)
#pragma unroll
            for (int i = 0; i < 16; ++i) x[q][i] = *(const unsigned*)(base + ((size_t)(rr + q) * 64 + i) * D);
#pragma unroll
        for (int q = 0; q < 4; ++q)
#pragma unroll
            for (int i = 0; i < 16; ++i) { s0[i] += bflo(x[q][i]); s1[i] += bfhi(x[q][i]); }
    }
    for (; rr < r_hi; ++rr) {
#pragma unroll
        for (int i = 0; i < 16; ++i) { const unsigned x = *(const unsigned*)(base + ((size_t)rr * 64 + i) * D); s0[i] += bflo(x); s1[i] += bfhi(x); }
    }
#pragma unroll
    for (int i = 0; i < 16; ++i) { self[i] = *(const unsigned*)(base + ((size_t)r * 64 + i) * D); *(LAS f32x2*)(Vs + (8 + cgp * 16 + i) * 256 + 2 * cp) = (f32x2){s0[i], s1[i]}; }
    __syncthreads();
    const float inv_r = 1.f / (float)(r_hi - r_lo);
    const int c0 = cgp * 16;
    f32x2 first[W], add[15], sub[15];
#pragma unroll
    for (int k = 0; k < W; ++k) first[k] = *(const LAS f32x2*)(Vs + (8 + c0 - LO + k) * 256 + 2 * cp);
#pragma unroll
    for (int i = 1; i < 16; ++i) { add[i - 1] = *(const LAS f32x2*)(Vs + (8 + c0 + i + HI - 1) * 256 + 2 * cp); sub[i - 1] = *(const LAS f32x2*)(Vs + (8 + c0 + i - LO - 1) * 256 + 2 * cp); }
    f32x2 run = {0.f, 0.f};
#pragma unroll
    for (int k = 0; k < W; ++k) run += first[k];
#pragma unroll
    for (int i = 0; i < 16; ++i) { const int c = c0 + i;
        if (i > 0) run += add[i - 1] - sub[i - 1];
        const int c_lo = c - LO < 0 ? 0 : c - LO, c_hi = c + HI > 64 ? 64 : c + HI;
        const float sc = inv_r / (float)(c_hi - c_lo);
        *(unsigned*)(PD + ((size_t)b * T + r * 64 + c) * D + GI * 256 + 2 * cp) = pk2(run[0] * sc - bflo(self[i]), run[1] * sc - bfhi(self[i])); }
    __syncthreads();
}
__device__ __forceinline__ void phase_pool(Frame& F) {
    LAS float* Vs = (LAS float*)F.lds;
    const int cp = F.tid & 127, cgp = F.tid >> 7;
    for (int i = F.tid; i < 8 * 256; i += NTHR) { Vs[i] = 0.f; Vs[72 * 256 + i] = 0.f; }
    __syncthreads();
    for (int item = F.vcu; item < 1024; item += F.G) {
        const int gi = item >> 8, b = (item >> 6) & 3, r = item & 63;
        if (gi == 0) pool_item<0>(F, b, r, Vs, cp, cgp); else if (gi == 1) pool_item<1>(F, b, r, Vs, cp, cgp); else if (gi == 2) pool_item<2>(F, b, r, Vs, cp, cgp); else pool_item<3>(F, b, r, Vs, cp, cgp);
    }
}

constexpr int NPHASE = 22;
__global__ void __launch_bounds__(NTHR, 2) mega_fwd(Args args) {
    extern __shared__ __attribute__((aligned(16))) unsigned char lds_raw[];
    Frame F;
    F.lds = (LAS unsigned char*)lds_raw;
    F.tid = threadIdx.x; F.lane = F.tid & 63; F.wave = __builtin_amdgcn_readfirstlane(F.tid >> 6);
    F.G = gridDim.x; { const int bx = blockIdx.x; F.vcu = (F.G % 8 == 0) ? (bx % 8) * (F.G / 8) + bx / 8 : bx; }
#pragma unroll
    for (int i = 0; i < 21; ++i) F.in[i] = args.in[i];
    F.out = args.out; F.ws = args.ws;
    const int lo = args.ph_lo, hi = args.ph_hi;
    if (F.tid < 32) ((LAS unsigned*)(F.lds + MISC_OFF))[F.tid] = 0u;
    __syncthreads();
    XcdBarrier bar = xcd_barrier_post((unsigned*)(F.ws + WS_CTL) + 4096, (volatile LAS unsigned*)(F.lds + MISC_OFF));
#ifndef PHMASK
#define PHMASK 0x3fffff
#endif
#define IN(k) ((((PHMASK) >> (k)) & 1) && lo <= (k) && (k) < hi)
#define SEAM(k) do { if (IN(k) && IN((k) + 1)) { xcd_barrier(bar); } F.tid = threadIdx.x; asm volatile("" : "+v"(F.tid)); F.lane = F.tid & 63; F.wave = __builtin_amdgcn_readfirstlane(F.tid >> 6); } while (0)
    const int c = (int)blockIdx.x;

#ifndef REP_PHASE
#define REP_PHASE (-1)
#endif
#ifndef REP_N
#define REP_N 2
#endif
#define RUN(k, ...) for (int _r = 0; _r < ((k) == REP_PHASE ? 1 + REP_N : 1); ++_r) { if (IN(k)) { __VA_ARGS__ } SEAM(k); }
    RUN(0, {
        if (F.vcu < 192) mod_item(F, F.vcu);
        LAS unsigned char* scr = F.lds + F.wave * 8192;
        const int gw = F.vcu * NWAVE + F.wave, NGW = F.G * NWAVE;
        for (int t = gw; t < TR_SMALL; t += NGW) tr_small_job(F, t, scr);
    })
    RUN(1, phase_norm0(F);)
    RUN(2, {
        pg8::Gemm g{(const bf16_t*)(F.ws + WS_U), (const bf16_t*)(F.ws + WS_WIN), D, D};
        pg8::DenseOrder S; S.init(MA / 256, NPROJ_PAD / 256, F.G, c);
        pg8::EpiInProj E{(bf16_t*)(F.ws + WS_P), (float*)(F.ws + WS_AB)};
        pg8::gemm_phase(F.lds, g, S, E);
#ifndef NO_FILL
        if (F.G == 256 && c >= (MA / 256) * (NPROJ_PAD / 256) - 4 * 256) moe_convert_wave(F, FILL_INPROJ, F.lds + F.wave * 8192);
#endif
    })
    RUN(3, phase_conv(F);)
#ifndef PREPV
    RUN(4, phase_prep<0>(F);)
#else
    RUN(4, phase_prep<PREPV>(F); __syncthreads(); phase_prep<PREPV>(F); __syncthreads(); phase_prep<0>(F);)
#endif
    RUN(5, phase_scan(F);)
    RUN(6, phase_gdn_out(F);)
    RUN(7, {
        pg8::Gemm g{(const bf16_t*)(F.ws + WS_ON), (const bf16_t*)(F.ws + WS_WOUT), D, D};
        pg8::DenseOrder S; S.init(ML / 256, D / 256, F.G, c);
        pg8::EpiOutProj E{F.in[I_X], (float*)(F.ws + WS_H), (const float*)(F.ws + WS_MOD) + 2 * D};
        pg8::gemm_phase(F.lds, g, S, E);
    })
#pragma unroll
    for (int l = 0; l < 2; ++l) {
        if (l == 1) {
            RUN(14, phase_pool(F);)
            RUN(15, {
                pg8::Gemm g{(const bf16_t*)(F.ws + WS_ON), (const bf16_t*)(F.ws + WS_POOLW), D, 256};
                pg8::PoolOrder S{F.G, c};
                pg8::EpiPool E{(float*)(F.ws + WS_H), (const float*)(F.ws + WS_MOD) + 5 * 6144 + 2 * D, F.in[I_POOLS]};
                pg8::gemm_phase(F.lds, g, S, E);
            })
        }
        const int p0 = l == 0 ? 8 : 16;
        RUN(p0, {
            phase_moe_pre(F, l);

        })
        RUN(p0 + 1, phase_topk(F);)
        RUN(p0 + 2, phase_gather(F);)
        RUN(p0 + 3, {
            pg8::Gemm g{(const bf16_t*)(F.ws + WS_XS), (const bf16_t*)(F.ws + WS_WMOE + (size_t)l * WMOE_LAYER), D, D};
            pg8::MoeUpOrder S{F.G, c};
            pg8::EpiSwiglu E{(unsigned char*)(F.ws + WS_HID)};
            pg8::gemm_phase<pg8::EpiSwiglu, pg8::MoeUpOrder, true>(F.lds, g, S, E);
        })
        RUN(p0 + 4, {
            pg8::Gemm g{(const bf16_t*)(F.ws + WS_HID), (const bf16_t*)(F.ws + WS_W2T + (size_t)l * WMOE_LAYER), DF, DF};
            pg8::MoeDownOrder S{F.G, c};
            pg8::EpiDown E{(bf16_t*)(F.ws + WS_YS), (const float*)(F.ws + WS_GATE)};
            pg8::gemm_phase<pg8::EpiDown, pg8::MoeDownOrder, true>(F.lds, g, S, E);
        })
        RUN(p0 + 5, phase_combine(F, l);)
    }
#undef IN
#undef SEAM
#undef RUN
}

extern "C" void kernel_launch(void* const* d_in, const int* in_sizes, int n_in, void* d_out, int out_size, void* d_ws, size_t ws_size, hipStream_t stream) {
    static int grid = 0;
    if (grid == 0) {
        if (n_in != 21 || ws_size < WS_END) { fprintf(stderr, "kernel_launch: unexpected inputs (n_in %d, ws %zu)\n", n_in, ws_size); grid = -1; return; }
        int dev = 0, cus = 0, per_cu = 0;
        hipGetDevice(&dev);
        hipDeviceGetAttribute(&cus, hipDeviceAttributeMultiprocessorCount, dev);
        hipFuncSetAttribute((const void*)mega_fwd, hipFuncAttributeMaxDynamicSharedMemorySize, LDS_BYTES);
        hipOccupancyMaxActiveBlocksPerMultiprocessor(&per_cu, (const void*)mega_fwd, NTHR, LDS_BYTES);
        if (per_cu < 1) { fprintf(stderr, "kernel_launch: occupancy query says %d blocks per CU\n", per_cu); per_cu = 1; }
        grid = cus;
        (void)hipGetLastError();
    }
    if (grid < 0) return;
    hipMemsetAsync((char*)d_ws + WS_CTL, 0, 1 * MiB, stream);
    Args a{};
    for (int i = 0; i < 21; ++i) a.in[i] = (const float*)d_in[i];
    a.out = (float*)d_out; a.ws = (unsigned char*)d_ws;
#if MK_N_LAUNCHES == 1
    a.ph_lo = 0; a.ph_hi = NPHASE;
    void* params[] = {&a};
    (void)params;
    hipLaunchKernelGGL(mega_fwd, dim3(grid), dim3(NTHR), LDS_BYTES, stream, a);
    hipError_t e = hipPeekAtLastError();
    if (e != hipSuccess) fprintf(stderr, "launch failed: %s (grid %d)\n", hipGetErrorString(e), grid);
#else
    for (int p = 0; p < NPHASE; ++p) {
        a.ph_lo = p; a.ph_hi = p + 1;
        void* params[] = {&a};
        hipError_t e = hipLaunchCooperativeKernel((const void*)mega_fwd, dim3(grid), dim3(NTHR), params, LDS_BYTES, stream);
        if (e != hipSuccess) { fprintf(stderr, "launch %d failed: %s (grid %d)\n", p, hipGetErrorString(e), grid); break; }
    }
#endif
}
```

```cpp
#include <hip/hip_runtime.h>
#include <hip/hip_cooperative_groups.h>
#include <cstdio>
namespace cg = cooperative_groups;

#ifndef MK_N_LAUNCHES
#define MK_N_LAUNCHES 1
#endif

#define LAS __attribute__((address_space(3)))
typedef unsigned short bf16_t;
typedef short bf16x8 __attribute__((ext_vector_type(8)));
typedef float f32x4 __attribute__((ext_vector_type(4)));
typedef float f32x2 __attribute__((ext_vector_type(2)));
typedef unsigned u32x4 __attribute__((ext_vector_type(4)));
typedef unsigned u32x2 __attribute__((ext_vector_type(2)));

constexpr int NB = 4, T = 4096, D = 1024, TC = 256, NH = 8, DH = 128, NE = 16, CAP = 512, DF = 2048;
constexpr int ML = NB * T;
constexpr int MC = NB * TC;
constexpr int MA = ML + MC;
constexpr int NPROJ = 4128, NPROJ_PAD = 4352, NQKV = 3072, NP = 4096;
constexpr int NCHUNK = MA / 64;
constexpr int MX = NB * NE * CAP;
constexpr float EPS = 1e-6f;
constexpr int NTHR = 512, NWAVE = 8;

constexpr size_t MiB = 1u << 20;
constexpr size_t WS_CTL = 0;
constexpr size_t WS_MOD = 1 * MiB;
constexpr size_t WS_AB = 2 * MiB;
constexpr size_t WS_GCB = 5 * MiB;
constexpr size_t WS_AFF = 5 * MiB;
constexpr size_t WS_SLOT = 6 * MiB;
constexpr size_t WS_IDX = 7 * MiB;
constexpr size_t WS_GATE = 7 * MiB + 256 * 1024;
constexpr size_t WS_WIN = 8 * MiB;
constexpr size_t WS_WOUT = 17 * MiB;
constexpr size_t WS_POOLW = 19 * MiB;
constexpr size_t WS_WMOE = 20 * MiB;
constexpr size_t WS_W2T = WS_WMOE + 64 * MiB;
constexpr size_t WMOE_LAYER = 96 * MiB;
constexpr size_t WS_H = 212 * MiB;
constexpr size_t WS_U = 276 * MiB;
constexpr size_t WS_ON = 310 * MiB;
constexpr size_t WS_G = 342 * MiB;
constexpr size_t WS_P = WS_G;
constexpr size_t WS_QKV = WS_G + 136 * MiB;
constexpr size_t WS_KT = WS_G + 238 * MiB;
constexpr size_t WS_VT = WS_G + 272 * MiB;
constexpr size_t WS_W = WS_G + 306 * MiB;
constexpr size_t WS_UT = WS_G + 374 * MiB;
constexpr size_t WS_ATT = WS_G + 442 * MiB;
constexpr size_t WS_O = WS_G + 476 * MiB;
constexpr size_t WS_XS = WS_G;
constexpr size_t WS_HID = WS_G + 64 * MiB;
constexpr size_t WS_YS = WS_G + 192 * MiB;
constexpr size_t WS_END = WS_G + 604 * MiB;

constexpr int LDS_BYTES = 163840;

typedef __bf16 bf16v2 __attribute__((ext_vector_type(2)));
__device__ __forceinline__ unsigned pk2(float lo, float hi) { const f32x2 v = {lo, hi}; return __builtin_bit_cast(unsigned, __builtin_convertvector(v, bf16v2)); }
__device__ __forceinline__ unsigned f2bf(float f) { return pk2(f, 0.f) & 0xffffu; }
__device__ __forceinline__ float bflo(unsigned w) { return __uint_as_float(w << 16); }
__device__ __forceinline__ float bfhi(unsigned w) { return __uint_as_float(w & 0xffff0000u); }
__device__ __forceinline__ float bf1(bf16_t b) { return __uint_as_float(((unsigned)b) << 16); }
#define DPP_ADD(v, ctrl) ((v) + __builtin_bit_cast(float, __builtin_amdgcn_update_dpp(0, __builtin_bit_cast(int, (v)), (ctrl), 0xf, 0xf, true)))
__device__ __forceinline__ float row16_sum(float v) {
    v = DPP_ADD(v, 0xB1); v = DPP_ADD(v, 0x4E); v = DPP_ADD(v, 0x141); v = DPP_ADD(v, 0x140); return v;
}
__device__ __forceinline__ float wave_sum(float v) { v = row16_sum(v); v += __shfl_xor(v, 16); v += __shfl_xor(v, 32); return v; }
__device__ __forceinline__ float siluf(float x) { return x * __builtin_amdgcn_rcpf(1.f + __expf(-x)); }
__device__ __forceinline__ float sigmoidf(float x) { return __builtin_amdgcn_rcpf(1.f + __expf(-x)); }
__device__ __forceinline__ float softplusf(float x) { return fmaxf(x, 0.f) + log1pf(__expf(-fabsf(x))); }
__device__ __forceinline__ float rnd_fp8(float x) { const int p = __builtin_amdgcn_cvt_pk_fp8_f32(x, x, 0, false); return __builtin_amdgcn_cvt_f32_fp8(p, 0); }
__device__ __forceinline__ unsigned pk4_fp8(float a, float b, float c, float d) { int p = __builtin_amdgcn_cvt_pk_fp8_f32(a, b, 0, false); p = __builtin_amdgcn_cvt_pk_fp8_f32(c, d, p, true); return (unsigned)p; }
#define LDS_WAIT() asm volatile("s_waitcnt lgkmcnt(0)" ::: "memory")

namespace pg8 {
constexpr int BM = 256, BK = 64, HALF = 128, HTB = HALF * BK * 2, STAGE_BYTES = 8 * HTB;
__device__ __forceinline__ int lds_byte(int r, int c) { const int st = (r >> 4) * 2 + (c >> 5), rr = r & 15, cc = c & 31, ob = rr * 64 + cc * 2; return st * 1024 + (ob ^ (((ob >> 9) & 1) << 5)); }
__device__ __forceinline__ void stage_rc(int b, int& R, int& C) { const int st = b / 1024, sb = b % 1024, swz = sb ^ (((sb >> 9) & 1) << 5); R = (st >> 1) * 16 + swz / 64; C = (st & 1) * 32 + (swz % 64) / 2; }

struct Unit { int pm, pn, pb, ak; };
struct Gemm { const bf16_t* A; const bf16_t* Bt; int lda, K; };

#ifndef PG8_SP2
#define PG8_SP2 true
#endif
#ifndef PG8_ALIGN
#define PG8_ALIGN true
#endif
typedef int v8i32 __attribute__((ext_vector_type(8)));
__device__ __forceinline__ v8i32 cat8(const bf16x8 lo, const bf16x8 hi) { const u32x4 a = __builtin_bit_cast(u32x4, lo), b = __builtin_bit_cast(u32x4, hi); return (v8i32){(int)a.x, (int)a.y, (int)a.z, (int)a.w, (int)b.x, (int)b.y, (int)b.z, (int)b.w}; }
template <class Epi, class Sched, bool FP8 = false, bool ALIGN_EPI = PG8_ALIGN, bool SP2 = PG8_SP2>
__device__ __forceinline__ void gemm_phase(LAS unsigned char* lds, const Gemm g, const Sched& S, const Epi& E) {
    constexpr int ES = FP8 ? 1 : 2;
    int tid = threadIdx.x; asm volatile("" : "+v"(tid));
    const int wid = __builtin_amdgcn_readfirstlane(tid >> 6), lane = tid & 63, wr = wid >> 2, wc = wid & 3, fr = lane & 15, fq = lane >> 4;
    int K = g.K, lda = g.lda; asm volatile("" : "+s"(K), "+s"(lda));
    const int nt = K * ES / (BK * 2);
    unsigned voffA[2], voffB[2];
#pragma unroll
    for (int i = 0; i < 2; ++i) { int R, C; stage_rc(tid * 16 + i * 8192, R, C); voffA[i] = (unsigned)(R * lda * ES + C * 2); voffB[i] = (unsigned)(R * K * ES + C * 2); }
    const size_t kstep = (size_t)(BK * 2);
    const size_t hsA = (size_t)HALF * lda * ES, hsB = (size_t)HALF * K * ES;
    const unsigned ldsw = (unsigned)wid * 1024u;
    const int aoff0 = FP8 ? lds_byte(wr * 64 + fr, fq * 16) : lds_byte(wr * 64 + fr, fq * 8), aoff1 = FP8 ? aoff0 + 16 : aoff0 + 1024;
    const int boff0 = FP8 ? lds_byte(wc * 32 + fr, fq * 16) : lds_byte(wc * 32 + fr, fq * 8), boff1 = FP8 ? boff0 + 16 : boff0 + 1024;
#define PG8_SA(b, h) (((b) * 2 + (h)) * HTB)
#define PG8_SB(b, h) ((4 + (b) * 2 + (h)) * HTB)
#define PG8_STAGE(bufoff, gbase, voff) do { _Pragma("unroll") for (int _i = 0; _i < 2; ++_i) \
        __builtin_amdgcn_global_load_lds((const unsigned*)((const char*)(gbase) + (voff)[_i]), (LAS unsigned*)(lds + (bufoff) + ldsw + _i * 8192), 16, 0, 0); } while (0)
#define PG8_LD2(dst, off0, off1) do { if constexpr (FP8) { dst.v = *(const LAS v8i32*)(lds + (off0)); } else { const u32x4 _lo = *(const LAS u32x4*)(lds + (off0)), _hi = *(const LAS u32x4*)(lds + (off1)); \
        dst.v = (v8i32){(int)_lo.x, (int)_lo.y, (int)_lo.z, (int)_lo.w, (int)_hi.x, (int)_hi.y, (int)_hi.z, (int)_hi.w}; } } while (0)
#define PG8_LDA(dst, b, h) do { if constexpr (FP8) { _Pragma("unroll") for (int m = 0; m < 4; ++m) PG8_INS8(A32, m, *(const LAS v8i32*)(lds + PG8_SA(b, h) + aoff0 + m * 2048)); } \
        else { _Pragma("unroll") for (int m = 0; m < 4; ++m) PG8_LD2(dst[m], PG8_SA(b, h) + aoff0 + m * 2048, PG8_SA(b, h) + aoff1 + m * 2048); } } while (0)
#define PG8_LDB(dst, b, h) do { if constexpr (FP8) { _Pragma("unroll") for (int n = 0; n < 2; ++n) PG8_INS8(B32, 2 * (h) + n, *(const LAS v8i32*)(lds + PG8_SB(b, h) + boff0 + n * 2048)); } \
        else { _Pragma("unroll") for (int n = 0; n < 2; ++n) PG8_LD2(dst[n], PG8_SB(b, h) + boff0 + n * 2048, PG8_SB(b, h) + boff1 + n * 2048); } } while (0)
#define PG8_MMA(ai, bj, At, Bt) do { __builtin_amdgcn_s_setprio(1); _Pragma("unroll") for (int m = 0; m < 4; ++m) _Pragma("unroll") for (int n = 0; n < 2; ++n) { \
        if constexpr (FP8) { const v8i32 _b = PG8_SUB8(B32, 2 * (bj) + n), _a = PG8_SUB8(A32, m); \
            asm volatile("v_mfma_scale_f32_16x16x128_f8f6f4 %0, %1, %2, %0, %3, %3 op_sel_hi:[0,0,0]" : "+v"(acc[ai][bj][m][n]) : "v"(_b), "v"(_a), "v"(sc1)); } \
        else { acc[ai][bj][m][n] = __builtin_amdgcn_mfma_f32_16x16x32_bf16(Bt[n].lo(), At[m].lo(), acc[ai][bj][m][n], 0, 0, 0); acc[ai][bj][m][n] = __builtin_amdgcn_mfma_f32_16x16x32_bf16(Bt[n].hi(), At[m].hi(), acc[ai][bj][m][n], 0, 0, 0); } } \
        __builtin_amdgcn_s_setprio(0); } while (0)
#define PG8_WAIT_V(n) asm volatile("s_waitcnt vmcnt(" #n ")" ::: "memory")
#define PG8_WAIT_L(n) asm volatile("s_waitcnt lgkmcnt(" #n ")" ::: "memory")
#define PG8_BAR __builtin_amdgcn_s_barrier()
#define PG8_SCHED __builtin_amdgcn_sched_barrier(0)
    Unit cur, nxt; int ui = 0;
    if (!S.next(0, cur)) return;
    f32x4 acc[2][2][4][2];
#pragma unroll
    for (int a = 0; a < 2; ++a)
#pragma unroll
        for (int b = 0; b < 2; ++b)
#pragma unroll
            for (int m = 0; m < 4; ++m)
#pragma unroll
                for (int n = 0; n < 2; ++n) acc[a][b][m][n] = (f32x4){0.f, 0.f, 0.f, 0.f};
    struct Frag2 { v8i32 v;
        __device__ __forceinline__ bf16x8 lo() const { const u32x4 t = {(unsigned)v[0], (unsigned)v[1], (unsigned)v[2], (unsigned)v[3]}; return __builtin_bit_cast(bf16x8, t); }
        __device__ __forceinline__ bf16x8 hi() const { const u32x4 t = {(unsigned)v[4], (unsigned)v[5], (unsigned)v[6], (unsigned)v[7]}; return __builtin_bit_cast(bf16x8, t); } };
    Frag2 At[4], B0[2], B1[2];
    typedef int v32i32 __attribute__((ext_vector_type(32)));
    int sc1 = 0x7f7f7f7f; asm volatile("" : "+v"(sc1));
    v32i32 A32, B32;
#define PG8_SUB8(V, i) ((v8i32){V[8 * (i)], V[8 * (i) + 1], V[8 * (i) + 2], V[8 * (i) + 3], V[8 * (i) + 4], V[8 * (i) + 5], V[8 * (i) + 6], V[8 * (i) + 7]})
#define PG8_INS8(V, i, X) do { const v8i32 _x = (X); _Pragma("unroll") for (int _e = 0; _e < 8; ++_e) V[8 * (i) + _e] = _x[_e]; } while (0)
    const char* cA = (const char*)g.A + ((size_t)cur.pm * BM * lda + cur.ak) * ES; const char* cB = (const char*)g.Bt + (size_t)cur.pb * BM * K * ES;
    if constexpr (SP2) {
        PG8_STAGE(PG8_SB(0, 0), cB, voffB); PG8_STAGE(PG8_SB(0, 1), cB + hsB, voffB); PG8_STAGE(PG8_SA(0, 0), cA, voffA); PG8_STAGE(PG8_SA(0, 1), cA + hsA, voffA);
        if (wr == 1) PG8_BAR;
        PG8_WAIT_V(2); PG8_BAR;
        PG8_STAGE(PG8_SB(1, 0), cB + kstep, voffB); PG8_STAGE(PG8_SA(1, 0), cA + kstep, voffA); PG8_STAGE(PG8_SB(1, 1), cB + hsB + kstep, voffB);
        PG8_WAIT_V(6); PG8_BAR;
    } else {
        PG8_STAGE(PG8_SB(0, 0), cB, voffB); PG8_STAGE(PG8_SA(0, 0), cA, voffA); PG8_STAGE(PG8_SB(0, 1), cB + hsB, voffB); PG8_STAGE(PG8_SA(0, 1), cA + hsA, voffA);
        if (wr == 1) PG8_BAR;
        PG8_WAIT_V(4); PG8_BAR;
        PG8_STAGE(PG8_SB(1, 0), cB + kstep, voffB); PG8_STAGE(PG8_SA(1, 0), cA + kstep, voffA); PG8_STAGE(PG8_SB(1, 1), cB + hsB + kstep, voffB);
        PG8_WAIT_V(6); PG8_BAR;
    }
    for (;;) {
        const bool has_next = S.next(ui + 1, nxt);
        const char* nA = has_next ? (const char*)g.A + ((size_t)nxt.pm * BM * lda + nxt.ak) * ES : cA; const char* nB = has_next ? (const char*)g.Bt + (size_t)nxt.pb * BM * K * ES : cB;
#pragma unroll 1
        for (int t = 0; t < nt; t += 2) {
            const bool last = (t == nt - 2);
            const char* a1 = cA + (size_t)(t + 1) * kstep;
            const char* a2 = last ? nA : cA + (size_t)(t + 2) * kstep; const char* b2 = last ? nB : cB + (size_t)(t + 2) * kstep;
            const char* a3 = a2 + kstep; const char* b3 = b2 + kstep;
            if constexpr (SP2) {
            PG8_LDB(B0, 0, 0); PG8_LDB(B1, 0, 1); PG8_SCHED; PG8_LDA(At, 0, 0); PG8_STAGE(PG8_SA(1, 1), a1 + hsA, voffA);
            PG8_WAIT_V(8); PG8_WAIT_L(0); PG8_BAR; PG8_MMA(0, 0, At, B0); PG8_MMA(0, 1, At, B1); PG8_BAR; PG8_SCHED;
            PG8_LDA(At, 0, 1); PG8_STAGE(PG8_SB(0, 0), b2, voffB); PG8_STAGE(PG8_SB(0, 1), b2 + hsB, voffB); PG8_STAGE(PG8_SA(0, 0), a2, voffA);
            PG8_WAIT_V(8); PG8_WAIT_L(0); PG8_BAR; PG8_MMA(1, 0, At, B0); PG8_MMA(1, 1, At, B1); PG8_BAR; PG8_SCHED;
            PG8_LDB(B0, 1, 0); PG8_LDB(B1, 1, 1); PG8_SCHED; PG8_LDA(At, 1, 0); PG8_STAGE(PG8_SA(0, 1), a2 + hsA, voffA);
            PG8_WAIT_V(8); PG8_WAIT_L(0); PG8_BAR; PG8_MMA(0, 0, At, B0); PG8_MMA(0, 1, At, B1); PG8_BAR; PG8_SCHED;
            PG8_LDA(At, 1, 1); PG8_STAGE(PG8_SB(1, 0), b3, voffB); PG8_STAGE(PG8_SB(1, 1), b3 + hsB, voffB); PG8_STAGE(PG8_SA(1, 0), a3, voffA);
            PG8_WAIT_V(8); PG8_WAIT_L(0); PG8_BAR; PG8_MMA(1, 0, At, B0); PG8_MMA(1, 1, At, B1); PG8_BAR; PG8_SCHED;
            } else {
            PG8_LDB(B0, 0, 0); PG8_SCHED; PG8_LDA(At, 0, 0); PG8_STAGE(PG8_SA(1, 1), a1 + hsA, voffA);
            PG8_WAIT_L(8); PG8_BAR; PG8_WAIT_L(0); PG8_MMA(0, 0, At, B0); PG8_BAR; PG8_SCHED;
            PG8_LDB(B1, 0, 1); PG8_STAGE(PG8_SB(0, 0), b2, voffB);
            PG8_BAR; PG8_WAIT_L(0); PG8_MMA(0, 1, At, B1); PG8_BAR;
            PG8_LDA(At, 0, 1); PG8_STAGE(PG8_SA(0, 0), a2, voffA);
            PG8_BAR; PG8_WAIT_L(0); PG8_MMA(1, 0, At, B0); PG8_BAR; PG8_SCHED;
            PG8_STAGE(PG8_SB(0, 1), b2 + hsB, voffB);
            PG8_WAIT_V(6); PG8_BAR; PG8_MMA(1, 1, At, B1); PG8_BAR;
            PG8_LDB(B0, 1, 0); PG8_SCHED; PG8_LDA(At, 1, 0); PG8_STAGE(PG8_SA(0, 1), a2 + hsA, voffA);
            PG8_WAIT_L(8); PG8_BAR; PG8_WAIT_L(0); PG8_MMA(0, 0, At, B0); PG8_BAR; PG8_SCHED;
            PG8_LDB(B1, 1, 1); PG8_STAGE(PG8_SB(1, 0), b3, voffB);
            PG8_BAR; PG8_WAIT_L(0); PG8_MMA(0, 1, At, B1); PG8_BAR;
            PG8_LDA(At, 1, 1); PG8_STAGE(PG8_SA(1, 0), a3, voffA);
            PG8_BAR; PG8_WAIT_L(0); PG8_MMA(1, 0, At, B0); PG8_BAR; PG8_SCHED;
            PG8_STAGE(PG8_SB(1, 1), b3 + hsB, voffB);
            PG8_WAIT_V(6); PG8_BAR; PG8_MMA(1, 1, At, B1); PG8_BAR;
            }
        }
        if constexpr (ALIGN_EPI) { if (wr == 0) PG8_BAR; }
        if constexpr (FP8) asm volatile("s_nop 15\n\ts_nop 15" ::: "memory");
        E(acc, cur, wr, wc, fr, fq);
        if (!has_next) break;
#pragma unroll
        for (int a = 0; a < 2; ++a)
#pragma unroll
            for (int b = 0; b < 2; ++b)
#pragma unroll
                for (int m = 0; m < 4; ++m)
#pragma unroll
                    for (int n = 0; n < 2; ++n) acc[a][b][m][n] = (f32x4){0.f, 0.f, 0.f, 0.f};
        cur = nxt; cA = nA; cB = nB; ++ui;
        if constexpr (ALIGN_EPI) { if (wr == 1) PG8_BAR; }
    }
    PG8_WAIT_V(0);
    if constexpr (!ALIGN_EPI) { if (wr == 0) PG8_BAR; }
    PG8_BAR;
#undef PG8_SA
#undef PG8_SB
#undef PG8_STAGE
#undef PG8_LDA
#undef PG8_LDB
#undef PG8_MMA
#undef PG8_WAIT_V
#undef PG8_WAIT_L
#undef PG8_BAR
#undef PG8_SCHED
#undef PG8_SUB8
#undef PG8_INS8
}

struct DenseOrder {
    int nM, nN, nwg, G, c;
    __device__ __forceinline__ void init(int nM_, int nN_, int G_, int c_) { nM = nM_; nN = nN_; nwg = nM * nN; G = G_; c = c_; }
    __device__ __forceinline__ bool next(int i, Unit& u) const {
        const long L = (long)i * G + c; if (L >= nwg) return false;
        int wgid = (int)L; { const int q = nwg / 8, r = nwg % 8, xcd = wgid % 8, off = wgid / 8; wgid = (xcd < r ? xcd * (q + 1) : r * (q + 1) + (xcd - r) * q) + off; }
        const int nig = 8 * nN, gid = wgid / nig, fm = gid * 8, gsz = (nM - fm) < 8 ? (nM - fm) : 8;
        u.pm = fm + ((wgid % nig) % gsz); u.pn = (wgid % nig) / gsz; u.pb = u.pn; u.ak = 0; return true;
    }
};
struct MoeUpOrder {
    int G, c;
    __device__ __forceinline__ bool next(int i, Unit& u) const {
        const int L = i * G + c; if (L >= 2048) return false;
        const int r = L / 256, cc = L % 256, x = cc % 8, j = cc / 8;
        const int e = 2 * x + (r >> 2); u.pm = e * 8 + (j & 7); u.pn = 4 * (r & 3) + (j >> 3); u.pb = e * 16 + u.pn; u.ak = 0; return true;
    }
};
struct MoeDownOrder {
    int G, c;
    __device__ __forceinline__ bool next(int i, Unit& u) const {
        const int L = i * G + c; if (L >= 512) return false;
        const int r = L / 256, cc = L % 256, x = cc % 8, j = cc / 8;
        const int e = 8 * r + x; u.pm = e * 8 + (j & 7); u.pn = j >> 3; u.pb = e * 4 + u.pn; u.ak = 0; return true;
    }
};
struct PoolOrder {
    int G, c;
    __device__ __forceinline__ bool next(int i, Unit& u) const {
        const int L = i * G + c; if (L >= 256) return false;
        const int x = L % 8, j = L / 8; u.pm = x * 8 + (j & 7); u.pn = j >> 3; u.pb = u.pn; u.ak = u.pn * 256; return true;
    }
};

struct EpiInProj {
    bf16_t* P; float* AB;
    __device__ __forceinline__ void operator()(const f32x4 (&acc)[2][2][4][2], const Unit& u, int wr, int wc, int fr, int fq) const {
        const int row0 = u.pm * BM + wr * 64 + fr;
        if (u.pn < 16) {
            const int col0 = u.pn * BM + wc * 32 + 4 * fq;
#pragma unroll
            for (int ai = 0; ai < 2; ++ai)
#pragma unroll
                for (int m = 0; m < 4; ++m) { bf16_t* rowp = P + (size_t)(row0 + ai * HALF + m * 16) * NP + col0;
#pragma unroll
                    for (int bj = 0; bj < 2; ++bj)
#pragma unroll
                        for (int n = 0; n < 2; ++n) { const f32x4 v = acc[ai][bj][m][n]; u32x2 w; w.x = pk2(v[0], v[1]); w.y = pk2(v[2], v[3]); *(u32x2*)(rowp + bj * HALF + n * 16) = w; } }
        } else if (wc == 0) {
#pragma unroll
            for (int ai = 0; ai < 2; ++ai)
#pragma unroll
                for (int m = 0; m < 4; ++m) { float* rowp = AB + (size_t)(row0 + ai * HALF + m * 16) * 32 + 4 * fq;
#pragma unroll
                    for (int n = 0; n < 2; ++n) *(f32x4*)(rowp + n * 16) = acc[ai][0][m][n]; }
        }
    }
};
struct EpiOutProj {
    const float* X; bf16_t* H; const float* gate;
    __device__ __forceinline__ void operator()(const f32x4 (&acc)[2][2][4][2], const Unit& u, int wr, int wc, int fr, int fq) const {
        const int row0 = u.pm * BM + wr * 64 + fr, col0 = u.pn * BM + wc * 32 + 4 * fq;
        const float* gp = gate + (size_t)(u.pm * BM / T) * 6144 + col0;
        f32x4 gv[2][2];
#pragma unroll
        for (int bj = 0; bj < 2; ++bj)
#pragma unroll
            for (int n = 0; n < 2; ++n) gv[bj][n] = *(const f32x4*)(gp + bj * HALF + n * 16);
#pragma unroll
        for (int ai = 0; ai < 2; ++ai)
#pragma unroll
            for (int m = 0; m < 4; ++m) { const size_t off = (size_t)(row0 + ai * HALF + m * 16) * D + col0;
#pragma unroll
                for (int bj = 0; bj < 2; ++bj)
#pragma unroll
                    for (int n = 0; n < 2; ++n) { const f32x4 xv = *(const f32x4*)(X + off + bj * HALF + n * 16); const f32x4 hv = xv + gv[bj][n] * acc[ai][bj][m][n];
                        u32x2 w; w.x = pk2(hv[0], hv[1]); w.y = pk2(hv[2], hv[3]); *(u32x2*)(H + off + bj * HALF + n * 16) = w; }
                asm volatile("" ::: "memory"); }
    }
};
struct EpiSwiglu {
    unsigned char* HID;
    __device__ __forceinline__ void operator()(const f32x4 (&acc)[2][2][4][2], const Unit& u, int wr, int wc, int fr, int fq) const {
        asm volatile("" : "+v"(fr), "+v"(fq));
        const int row0 = u.pm * BM + wr * 64 + fr, col0 = u.pn * HALF + wc * 32 + 4 * fq;
#pragma unroll
        for (int ai = 0; ai < 2; ++ai)
#pragma unroll
            for (int m = 0; m < 4; ++m) { unsigned char* rowp = HID + (size_t)(row0 + ai * HALF + m * 16) * DF + col0;
#pragma unroll
                for (int n = 0; n < 2; ++n) { const f32x4 g = acc[ai][0][m][n], up = acc[ai][1][m][n]; float h[4];
#pragma unroll
                    for (int j = 0; j < 4; ++j) h[j] = siluf(g[j] * 0.03125f) * (up[j] * 0.03125f);
                    *(unsigned*)(rowp + n * 16) = pk4_fp8(h[0], h[1], h[2], h[3]); } }
    }
};
struct EpiDown {
    bf16_t* YS; const float* gates;
    __device__ __forceinline__ void operator()(const f32x4 (&acc)[2][2][4][2], const Unit& u, int wr, int wc, int fr, int fq) const {
        asm volatile("" : "+v"(fr), "+v"(fq));
        const int row0 = u.pm * BM + wr * 64 + fr, col0 = u.pn * BM + wc * 32 + 4 * fq;
#pragma unroll
        for (int ai = 0; ai < 2; ++ai)
#pragma unroll
            for (int m = 0; m < 4; ++m) { const int row = row0 + ai * HALF + m * 16; const float gt = gates[row] * 0.03125f; bf16_t* rowp = YS + (size_t)row * D + col0;
#pragma unroll
                for (int bj = 0; bj < 2; ++bj)
#pragma unroll
                    for (int n = 0; n < 2; ++n) { const f32x4 v = acc[ai][bj][m][n] * gt; u32x2 w; w.x = pk2(v[0], v[1]); w.y = pk2(v[2], v[3]); *(u32x2*)(rowp + bj * HALF + n * 16) = w; } }
    }
};
struct EpiPool {
    bf16_t* H; const float* gate; const float* scale;
    __device__ __forceinline__ void operator()(const f32x4 (&acc)[2][2][4][2], const Unit& u, int wr, int wc, int fr, int fq) const {
        const int row0 = u.pm * BM + wr * 64 + fr, col0 = u.pn * BM + wc * 32 + 4 * fq;
        const float* gp = gate + (size_t)(u.pm * BM / T) * 6144 + col0;
        f32x4 gv[2][2];
#pragma unroll
        for (int bj = 0; bj < 2; ++bj)
#pragma unroll
            for (int n = 0; n < 2; ++n) gv[bj][n] = *(const f32x4*)(gp + bj * HALF + n * 16) * *(const f32x4*)(scale + col0 + bj * HALF + n * 16);
#pragma unroll
        for (int ai = 0; ai < 2; ++ai)
#pragma unroll
            for (int m = 0; m < 4; ++m) { const size_t off = (size_t)(row0 + ai * HALF + m * 16) * D + col0;
#pragma unroll
                for (int bj = 0; bj < 2; ++bj)
#pragma unroll
                    for (int n = 0; n < 2; ++n) { bf16_t* p = H + off + bj * HALF + n * 16; const u32x2 hw = *(const u32x2*)p; const f32x4 hv = (f32x4){bflo(hw.x), bfhi(hw.x), bflo(hw.y), bfhi(hw.y)} + gv[bj][n] * acc[ai][bj][m][n];
                        u32x2 w; w.x = pk2(hv[0], hv[1]); w.y = pk2(hv[2], hv[3]); *(u32x2*)p = w; }
                asm volatile("" ::: "memory"); }
    }
};
}


#define XB_TMO      128
#define XB_XCNT(j)  (256  + 64 * (j))
#define XB_XSUB(j)  (1280 + 64 * (j))
#define XB_XGEN(j)  (2304 + 64 * (j))
#define XB_TOP      3328
#define XB_TOPGEN   3392
#define XCD_BAR_WORDS 3456
#define XB_SPIN_CAP (1u << 20)
__device__ __forceinline__ unsigned xb_ld(unsigned* p)              { return __hip_atomic_load(p, __ATOMIC_RELAXED, __HIP_MEMORY_SCOPE_AGENT); }
__device__ __forceinline__ unsigned xb_add(unsigned* p, unsigned v) { return __hip_atomic_fetch_add(p, v, __ATOMIC_RELAXED, __HIP_MEMORY_SCOPE_AGENT); }
__device__ __forceinline__ unsigned xb_xcc_id() { return (unsigned)__builtin_amdgcn_s_getreg((3 << 11) | 20) & 0xFu; }
#define XB_SPIN(cond, bar) do { unsigned _sp = 0; while (cond) { __builtin_amdgcn_s_sleep(1); \
    if ((++_sp & 255u) == 0u) { if (xb_ld(&(bar)[XB_TMO])) break; if (_sp > XB_SPIN_CAP) { atomicAdd(&(bar)[XB_TMO], 1u); break; } } } } while (0)
struct XcdBarrier { unsigned* bar; unsigned x; volatile LAS unsigned* st; };
__device__ __forceinline__ XcdBarrier xcd_barrier_post(unsigned* bar, volatile LAS unsigned* st) {
    XcdBarrier b; b.bar = bar; b.x = xb_xcc_id(); b.st = st;
    if (threadIdx.x == 0) (void)xb_add(&bar[XB_XCNT(b.x)], 1u);
    return b;
}
__device__ __forceinline__ void xcd_barrier_complete(unsigned* bar, unsigned x, unsigned& nloc, unsigned& nx) {
    const unsigned G = gridDim.x * gridDim.y * gridDim.z;
    unsigned sum, cnt, mine, sp = 0u;
    for (;;) {
        sum = 0u; cnt = 0u; mine = 0u;
#pragma unroll
        for (unsigned j = 0; j < 16; ++j) { const unsigned c = xb_ld(&bar[XB_XCNT(j)]); sum += c; cnt += (c > 0u) ? 1u : 0u; mine = (j == x) ? c : mine; }
        if (sum == G) break;
        __builtin_amdgcn_s_sleep(1);
        if ((++sp & 255u) == 0u) { if (xb_ld(&bar[XB_TMO])) break; if (sp > XB_SPIN_CAP) { atomicAdd(&bar[XB_TMO], 1u); break; } }
    }
    nloc = mine > 0u ? mine : 1u; nx = cnt > 0u ? cnt : 1u;
}
__device__ __forceinline__ void xcd_barrier(const XcdBarrier& b) {
    asm volatile("s_waitcnt vmcnt(0)" ::: "memory");
    __syncthreads();
    if (threadIdx.x == 0) {
        unsigned* bar = b.bar;
        __builtin_amdgcn_s_waitcnt(0);
        unsigned nloc = b.st[0], nx = b.st[1];
        if (nloc == 0u) { xcd_barrier_complete(bar, b.x, nloc, nx); b.st[0] = nloc; b.st[1] = nx; }
        const unsigned old = xb_add(&bar[XB_XSUB(b.x)], 1u);
        const unsigned gen = old / nloc;
        if (old + 1u == (gen + 1u) * nloc) {
            __builtin_amdgcn_fence(__ATOMIC_RELEASE, "agent");
            asm volatile("s_waitcnt vmcnt(0)" ::: "memory");
            const unsigned og = xb_add(&bar[XB_TOP], 1u);
            const unsigned tg = og / nx;
            if (og + 1u == (tg + 1u) * nx) xb_add(&bar[XB_TOPGEN], 1u);
            else XB_SPIN(xb_ld(&bar[XB_TOPGEN]) == tg, bar);
            __builtin_amdgcn_fence(__ATOMIC_ACQUIRE, "agent");
            xb_add(&bar[XB_XGEN(b.x)], 1u);
            asm volatile("s_waitcnt vmcnt(0)" ::: "memory");
        } else {
            XB_SPIN(xb_ld(&bar[XB_XGEN(b.x)]) == gen, bar);
            __builtin_amdgcn_fence(__ATOMIC_ACQUIRE, "agent");
            asm volatile("s_waitcnt vmcnt(0)" ::: "memory");
        }
    }
    __syncthreads();
}
constexpr int MISC_OFF = LDS_BYTES - 128;

struct Args { const float* in[21]; float* out; unsigned char* ws; int ph_lo, ph_hi; };
enum { I_X = 0, I_C, I_CTX, I_CCTX, I_WMOD, I_BMOD, I_GMIX, I_GFFN, I_WIN, I_CONVW, I_ALOG, I_DTB, I_OGAIN, I_WOUT, I_POOLW, I_POOLS, I_WR, I_WG, I_WU, I_WD, I_FING };

struct Frame {
    LAS unsigned char* lds;
    int tid, lane, wave, G, vcu;
    const float* in[21]; float* out; unsigned char* ws;
};

__device__ __forceinline__ void tr_tile(const float* __restrict__ src, int ld_src, int n_valid, bf16_t* dst_row0, int ld_dst, int k0, LAS unsigned char* scr, int lane, float q8 = 0.f) {
    const int nq = lane & 15, g = lane >> 4;
    f32x4 v[2][8];
    const bool ok = 4 * nq < n_valid;
#pragma unroll
    for (int i1 = 0; i1 < 2; ++i1)
#pragma unroll
        for (int i2 = 0; i2 < 8; ++i2) { const int k = 32 * i1 + 8 * g + i2;
            v[i1][i2] = ok ? *(const f32x4*)(src + (size_t)(k0 + k) * ld_src + 4 * nq) : (f32x4){0.f, 0.f, 0.f, 0.f}; }
#ifdef EMU_FP8
    if (q8 > 0.f) { const float iq = 1.f / q8;
#pragma unroll
        for (int i1 = 0; i1 < 2; ++i1)
#pragma unroll
            for (int i2 = 0; i2 < 8; ++i2)
#pragma unroll
                for (int j = 0; j < 4; ++j) v[i1][i2][j] = rnd_fp8(v[i1][i2][j] * q8) * iq; }
#endif
#pragma unroll
    for (int j = 0; j < 4; ++j)
#pragma unroll
        for (int i1 = 0; i1 < 2; ++i1) {
            u32x4 w; w.x = pk2(v[i1][0][j], v[i1][1][j]); w.y = pk2(v[i1][2][j], v[i1][3][j]); w.z = pk2(v[i1][4][j], v[i1][5][j]); w.w = pk2(v[i1][6][j], v[i1][7][j]);
            const int n = 4 * nq + j, c = 4 * i1 + g;
            *(LAS u32x4*)(scr + n * 128 + ((c ^ (nq & 7)) * 16)) = w; }
    LDS_WAIT();
#pragma unroll
    for (int it = 0; it < 8; ++it) { const int n = (lane >> 3) + 8 * it, c = lane & 7;
        const u32x4 w = *(const LAS u32x4*)(scr + n * 128 + ((c ^ ((n >> 2) & 7)) * 16));
        *(u32x4*)(dst_row0 + (size_t)n * ld_dst + k0 + 8 * c) = w; }
    LDS_WAIT();
}

__device__ __forceinline__ void tr_tile8(const float* __restrict__ src, int ld_src, unsigned char* dst_row0, int ld_dst, int k0, LAS unsigned char* scr, int lane) {
    const int nq = lane & 15, g = lane >> 4;
    f32x4 v[4][8];
#pragma unroll
    for (int i1 = 0; i1 < 4; ++i1)
#pragma unroll
        for (int i2 = 0; i2 < 8; ++i2) { const int k = 32 * i1 + 8 * g + i2; v[i1][i2] = *(const f32x4*)(src + (size_t)(k0 + k) * ld_src + 4 * nq); }
#pragma unroll
    for (int j = 0; j < 4; ++j)
#pragma unroll
        for (int i1 = 0; i1 < 4; ++i1) {
            u32x2 w; w.x = pk4_fp8(v[i1][0][j] * 32.f, v[i1][1][j] * 32.f, v[i1][2][j] * 32.f, v[i1][3][j] * 32.f); w.y = pk4_fp8(v[i1][4][j] * 32.f, v[i1][5][j] * 32.f, v[i1][6][j] * 32.f, v[i1][7][j] * 32.f);
            const int n = 4 * nq + j, c = 4 * i1 + g;
            *(LAS u32x2*)(scr + n * 128 + ((((c >> 1) ^ (nq & 7))) << 4) + (c & 1) * 8) = w; }
    LDS_WAIT();
#pragma unroll
    for (int it = 0; it < 8; ++it) { const int n = (lane >> 3) + 8 * it, p = lane & 7;
        const u32x4 w = *(const LAS u32x4*)(scr + n * 128 + ((p ^ ((n >> 2) & 7)) << 4));
        *(u32x4*)(dst_row0 + (size_t)n * ld_dst + k0 + 16 * p) = w; }
    LDS_WAIT();
}

constexpr int TR_SMALL = 16 * 68 + 256 + 64;
__device__ __forceinline__ void tr_small_job(Frame& F, int t, LAS unsigned char* scr) {
    if (t < 1088) { const int nt = t / 16, kt = t % 16; int nv = NPROJ - 64 * nt; nv = nv < 0 ? 0 : (nv > 64 ? 64 : nv);
        tr_tile(F.in[I_WIN] + 64 * nt, NPROJ, nv, (bf16_t*)(F.ws + WS_WIN) + (size_t)64 * nt * D, D, 64 * kt, scr, F.lane); return; }
    t -= 1088;
    if (t < 256) { const int nt = t / 16, kt = t % 16;
        tr_tile(F.in[I_WOUT] + 64 * nt, D, 64, (bf16_t*)(F.ws + WS_WOUT) + (size_t)64 * nt * D, D, 64 * kt, scr, F.lane); return; }
    t -= 256;
    { const int gi = t / 16, nt = (t % 16) / 4, kt = t % 4;
        tr_tile(F.in[I_POOLW] + (size_t)gi * 65536 + 64 * nt, 256, 64, (bf16_t*)(F.ws + WS_POOLW) + (size_t)gi * 65536 + (size_t)64 * nt * 256, 256, 64 * kt, scr, F.lane); }
}
constexpr int TR_MOE = 12288;
#ifndef FILL_CONV
#define FILL_CONV 1
#endif
#ifndef FILL_PREP
#define FILL_PREP 2
#endif
#ifndef FILL_INPROJ
#define FILL_INPROJ 2
#endif
__device__ __forceinline__ void tr_moe_job(Frame& F, int l, int t, LAS unsigned char* scr, int lane) {
    if (t < 8192) { const int e = t / 512, r = t % 512, which = r / 256, r2 = r % 256, nt = r2 / 8, kp = r2 % 8;
        const float* src = F.in[which ? I_WU : I_WG] + (size_t)(l * NE + e) * D * DF + 64 * nt;
        unsigned char* dst = (unsigned char*)(F.ws + WS_WMOE) + (size_t)l * WMOE_LAYER + ((size_t)e * 4096 + (nt >> 1) * 256 + which * 128 + (nt & 1) * 64) * D;
        tr_tile8(src, DF, dst, D, 128 * kp, scr, lane); return; }
    t -= 8192;
    { const int e = t / 256, r = t % 256, nt = r / 16, kp = r % 16;
        const float* src = F.in[I_WD] + (size_t)(l * NE + e) * DF * D + 64 * nt;
        unsigned char* dst = (unsigned char*)(F.ws + WS_W2T) + (size_t)l * WMOE_LAYER + ((size_t)e * D + 64 * nt) * DF;
        tr_tile8(src, D, dst, DF, 128 * kp, scr, lane); }
}

__device__ __forceinline__ void moe_convert_wave(Frame& F, int n, LAS unsigned char* scr) {
    unsigned* ctr = (unsigned*)(F.ws + WS_CTL) + 16384;
    int lane; asm volatile("v_mbcnt_lo_u32_b32 %0, -1, 0\n\tv_mbcnt_hi_u32_b32 %0, -1, %0" : "=v"(lane));
    for (int i = 0; i < n; ++i) {
        unsigned t = 0u;
        if (lane == 0) t = __hip_atomic_fetch_add(ctr, 1u, __ATOMIC_RELAXED, __HIP_MEMORY_SCOPE_AGENT);
        t = (unsigned)__builtin_amdgcn_readfirstlane((int)t);
        if (t >= 2u * TR_MOE) break;
        tr_moe_job(F, t >= (unsigned)TR_MOE, (int)(t >= (unsigned)TR_MOE ? t - TR_MOE : t), scr, lane);
    }
}

__device__ __forceinline__ void mod_item(Frame& F, int item) {
    LAS float* act = (LAS float*)(F.lds + 65536);
    LAS float* part = (LAS float*)(F.lds + 65536 + 20480);
    const int l = item / 96, cgp = item % 96;
    for (int i = F.tid; i < 5 * D; i += NTHR) { const int r = i >> 10, k = i & 1023; const float x = r < 4 ? F.in[I_C][r * D + k] : F.in[I_CCTX][k]; act[i] = siluf(x); }
    __syncthreads();
    const int j = cgp * 64 + F.lane;
    const float* w = F.in[I_WMOD] + (size_t)l * D * 6144 + j;
    float a0 = 0.f, a1 = 0.f, a2 = 0.f, a3 = 0.f, a4 = 0.f;
    const int kb = F.wave * 128;
#pragma unroll 1
    for (int k0 = 0; k0 < 128; k0 += 32) {
        float wv[32];
#pragma unroll
        for (int k = 0; k < 32; ++k) wv[k] = w[(size_t)(kb + k0 + k) * 6144];
#pragma unroll
        for (int k = 0; k < 32; ++k) { const int kk = kb + k0 + k;
            a0 += act[kk] * wv[k]; a1 += act[D + kk] * wv[k]; a2 += act[2 * D + kk] * wv[k]; a3 += act[3 * D + kk] * wv[k]; a4 += act[4 * D + kk] * wv[k]; } }
    LAS float* pp = part + F.wave * 320 + F.lane;
    pp[0] = a0; pp[64] = a1; pp[128] = a2; pp[192] = a3; pp[256] = a4;
    __syncthreads();
    if (F.tid < 320) { const int r = F.tid >> 6, ln = F.tid & 63; float s = 0.f;
#pragma unroll
        for (int w8 = 0; w8 < 8; ++w8) s += part[w8 * 320 + r * 64 + ln];
        const int jj = cgp * 64 + ln;
        ((float*)(F.ws + WS_MOD))[(size_t)(l * 5 + r) * 6144 + jj] = s + F.in[I_BMOD][l * 6144 + jj]; }
    __syncthreads();
}

__device__ __forceinline__ void load_row(const float* p, int lane, f32x4 (&v)[4]) {
#pragma unroll
    for (int j = 0; j < 4; ++j) v[j] = ((const f32x4*)p)[lane + 64 * j];
}
__device__ __forceinline__ void load_row_bf16(const bf16_t* p, int lane, f32x4 (&v)[4]) {
#pragma unroll
    for (int j = 0; j < 4; ++j) { const u32x2 w = ((const u32x2*)p)[lane + 64 * j]; v[j] = (f32x4){bflo(w.x), bfhi(w.x), bflo(w.y), bfhi(w.y)}; }
}
__device__ __forceinline__ float row_rstd(const f32x4 (&v)[4]) {
    float s = 0.f;
#pragma unroll
    for (int j = 0; j < 4; ++j) s += (v[j][0] * v[j][0] + v[j][1] * v[j][1]) + (v[j][2] * v[j][2] + v[j][3] * v[j][3]);
    return rsqrtf(wave_sum(s) * (1.f / D) + EPS);
}
__device__ __forceinline__ void norm_mod(const f32x4 (&v)[4], float rstd, const float* g, const float* sh, const float* sc, int lane, f32x4 (&y)[4]) {
#pragma unroll
    for (int j = 0; j < 4; ++j) { const f32x4 gv = ((const f32x4*)g)[lane + 64 * j], shv = ((const f32x4*)sh)[lane + 64 * j], scv = ((const f32x4*)sc)[lane + 64 * j];
        y[j] = v[j] * rstd * gv * (1.f + scv) + shv; }
}
__device__ __forceinline__ void store_row_bf16(bf16_t* p, int lane, const f32x4 (&y)[4]) {
#pragma unroll
    for (int j = 0; j < 4; ++j) { u32x2 w; w.x = pk2(y[j][0], y[j][1]); w.y = pk2(y[j][2], y[j][3]); ((u32x2*)p)[lane + 64 * j] = w; }
}

__device__ __forceinline__ void phase_norm0(Frame& F) {
    const float* MOD = (const float*)(F.ws + WS_MOD);
    bf16_t* U = (bf16_t*)(F.ws + WS_U);
    for (int row = F.vcu * NWAVE + F.wave; row < MA; row += F.G * NWAVE) {
        const float* src; int mr;
        if (row < ML) { src = F.in[I_X] + (size_t)row * D; mr = row / T; } else { src = F.in[I_CTX] + (size_t)(row - ML) * D; mr = 4; }
        f32x4 v[4], y[4]; load_row(src, F.lane, v);
        const float rstd = row_rstd(v);
        const float* m = MOD + (size_t)mr * 6144;
        norm_mod(v, rstd, F.in[I_GMIX], m, m + D, F.lane, y);
        store_row_bf16(U + (size_t)row * D, F.lane, y);
    }
}

__device__ __forceinline__ void chunk_rows(int ci, int& row0, int& t0, int& slen) {
    if (ci < 256) { row0 = ci * 64; t0 = (ci & 63) * 64; slen = T; } else { const int cc = ci - 256; row0 = ML + cc * 64; t0 = (cc & 3) * 64; slen = TC; }
}
__device__ __forceinline__ void phase_conv(Frame& F) {
    const bf16_t* P = (const bf16_t*)(F.ws + WS_P);
    bf16_t* QKV = (bf16_t*)(F.ws + WS_QKV);
    bf16_t* KT = (bf16_t*)(F.ws + WS_KT);
    bf16_t* VT = (bf16_t*)(F.ws + WS_VT);
    LAS unsigned* kts = (LAS unsigned*)(F.lds + F.wave * 16896);
    LAS bf16_t* kts16 = (LAS bf16_t*)kts;
    const int lane = F.lane;
    for (int item = F.vcu * NWAVE + F.wave; item < NCHUNK * 24; item += F.G * NWAVE) {
        const int ci = item / 24, slab = item % 24;
        int row0, t0, slen; chunk_rows(ci, row0, t0, slen);
        const int col = slab * 128 + 2 * lane;
        float w0[5], w1[5];
#pragma unroll
        for (int j = 0; j < 5; ++j) { const f32x2 wv = *(const f32x2*)(F.in[I_CONVW] + (size_t)j * NQKV + col); w0[j] = wv[0]; w1[j] = wv[1]; }
        const bf16_t* src = P + (size_t)row0 * NP + col;
        unsigned rowsv[68];
#pragma unroll
        for (int j = 0; j < 68; ++j) { const int tt = j - 2; rowsv[j] = (t0 + tt >= 0 && t0 + tt < slen) ? *(const unsigned*)(src + (long)tt * NP) : 0u; }
        const int kind = slab >> 3;
#pragma unroll 1
        for (int t8 = 0; t8 < 64; t8 += 8) {
#pragma unroll
            for (int q = 0; q < 8; ++q) {
                const int tt = t8 + q;
                float y0 = 0.f, y1 = 0.f;
#pragma unroll
                for (int j = 0; j < 5; ++j) { y0 += w0[j] * bflo(rowsv[q + j]); y1 += w1[j] * bfhi(rowsv[q + j]); }
                y0 = siluf(y0); y1 = siluf(y1);
                if (kind < 2) { const float ss = wave_sum(y0 * y0 + y1 * y1); float sc = rsqrtf(ss + EPS); if (kind == 0) sc *= 0.08838834764831845f; y0 *= sc; y1 *= sc; }
                const unsigned pk = pk2(y0, y1);
                *(unsigned*)(QKV + (size_t)(row0 + tt) * NQKV + col) = pk;
                if (kind >= 1) { kts16[(2 * lane) * 66 + tt] = (bf16_t)(pk & 0xffffu); kts16[(2 * lane + 1) * 66 + tt] = (bf16_t)(pk >> 16); }
            }
#pragma unroll
            for (int j = 0; j < 60; ++j) rowsv[j] = rowsv[j + 8];
        }
        if (kind >= 1) {
            LDS_WAIT();
            unsigned* dst = (unsigned*)((kind == 1 ? KT : VT) + ((size_t)ci * NH + (slab & 7)) * 128 * 64);
#pragma unroll 8
            for (int it = 0; it < 64; ++it) { const int dk = 2 * it + (lane >> 5), dw = lane & 31; dst[dk * 32 + dw] = kts[dk * 33 + dw]; }
            LDS_WAIT();
        }
    }
#ifndef NO_FILL
    if (F.G == 256 && F.vcu * NWAVE + F.wave >= NCHUNK * 24 - 3 * 2048) moe_convert_wave(F, FILL_CONV, (LAS unsigned char*)kts);
#endif
}

__device__ __forceinline__ void chunk_gates(Frame& F, int row0, int h, int dir, int lane, float& gc, float& beta, float& gtot) {
    const float* ab = (const float*)(F.ws + WS_AB) + (size_t)(row0 + lane) * 32 + dir * 16 + h;
    const float a = ab[0], bb = ab[8];
    const float g = -__expf(F.in[I_ALOG][dir * NH + h]) * softplusf(a + F.in[I_DTB][dir * NH + h]);
    beta = sigmoidf(bb);
    float s = g;
#pragma unroll
    for (int o = 1; o < 64; o <<= 1) { const float t = __builtin_bit_cast(float, __builtin_amdgcn_ds_bpermute((lane - o) << 2, __builtin_bit_cast(int, s))); if (lane >= o) s += t; }
    gtot = __builtin_bit_cast(float, __builtin_amdgcn_readlane(__builtin_bit_cast(int, s), 63));
    gc = dir ? (gtot - s + g) : s;
}

template <int V> __device__ __forceinline__ void phase_prep(Frame& F) {
    const bf16_t* QKV = (const bf16_t*)(F.ws + WS_QKV);
    LAS float* As = (LAS float*)(F.lds + F.wave * 17408);
    LAS float* gs = (LAS float*)(F.lds + F.wave * 17408 + 16384);
#pragma unroll 1
    for (int item = F.vcu * NWAVE + F.wave; item < NCHUNK * NH * 2; item += F.G * NWAVE) {
        const int ci = item >> 4, h = (item >> 1) & 7, dir = item & 1;
        int row0, t0, slen; chunk_rows(ci, row0, t0, slen);
        asm volatile("" ::: "memory");
        int lane_v; asm volatile("v_mbcnt_lo_u32_b32 %0, -1, 0\n\tv_mbcnt_hi_u32_b32 %0, -1, %0" : "=v"(lane_v));
        const int lane = lane_v, fr = lane & 15, fq = lane >> 4;
        const int d4 = 4 * (lane_v >> 4) - (lane_v & 15);
        const size_t dt = (size_t)(dir * NCHUNK + ci) * NH + h;
        const bf16_t* KTg = (const bf16_t*)(F.ws + WS_KT) + ((size_t)ci * NH + h) * 8192; const bf16_t* VTg = (const bf16_t*)(F.ws + WS_VT) + ((size_t)ci * NH + h) * 8192;
        {
            bf16x8 kf[4][4], qf[4][4];
#pragma unroll
            for (int mt = 0; mt < 4; ++mt)
#pragma unroll
                for (int ks = 0; ks < 4; ++ks) { const bf16_t* rp = QKV + (size_t)(row0 + 16 * mt + fr) * NQKV + h * 128 + 32 * ks + 8 * fq; kf[mt][ks] = *(const bf16x8*)(rp + 1024); qf[mt][ks] = *(const bf16x8*)rp; }
            float gc, beta, gtot; chunk_gates(F, row0, h, dir, lane, gc, beta, gtot);
            gs[lane] = gc; gs[64 + lane] = beta;
            { float* gcb = (float*)(F.ws + WS_GCB) + dt * 128; gcb[lane] = gc; gcb[64 + lane] = beta; }
            LDS_WAIT();
#pragma unroll
            for (int mi = 0; mi < (V == 3 ? 0 : 4); ++mi)
#pragma unroll
                for (int nj = 0; nj < 4; ++nj) {
                    if (dir == 0 ? (mi < nj) : (mi > nj)) continue;
                    f32x4 acc = {0.f, 0.f, 0.f, 0.f};
#pragma unroll
                    for (int ks = 0; ks < 4; ++ks) acc = __builtin_amdgcn_mfma_f32_16x16x32_bf16(kf[mi][ks], kf[nj][ks], acc, 0, 0, 0);
                    const int j = 16 * nj + fr; const float gj = gs[j];
#pragma unroll
                    for (int r = 0; r < 4; ++r) { const int i = 16 * mi + 4 * fq + r; const float gi = gs[i], bi = gs[64 + i];
                        const bool keep = (mi != nj) || (dir == 0 ? (d4 + r > 0) : (d4 + r < 0));
                        const float val = keep ? bi * acc[r] * __expf(gi - gj) : 0.f;
                        const int il = dir ? 63 - i : i, jl = dir ? 63 - j : j;
                        As[il * 64 + jl] = val; }
                }
            bf16_t* AT = (bf16_t*)(F.ws + WS_ATT) + dt * 4096;
#pragma unroll
            for (int mi = 0; mi < (V == 3 ? 0 : 4); ++mi) {
#pragma unroll
                for (int nj = 0; nj < 4; ++nj) {
                    const bool none = dir == 0 ? (mi < nj) : (mi > nj);
                    f32x4 acc = {0.f, 0.f, 0.f, 0.f};
                    if (!none) {
#pragma unroll
                        for (int ks = 0; ks < 4; ++ks) acc = __builtin_amdgcn_mfma_f32_16x16x32_bf16(kf[nj][ks], qf[mi][ks], acc, 0, 0, 0);
                    }
                    const int i = 16 * mi + fr; const float gi = gs[i];
                    float val[4];
#pragma unroll
                    for (int r = 0; r < 4; ++r) { const int j = 16 * nj + 4 * fq + r; const float gj = gs[j];
                        const bool keep = !none && ((mi != nj) || (dir == 0 ? (d4 + r <= 0) : (d4 + r >= 0)));
                        val[r] = keep ? acc[r] * __expf(gi - gj) : 0.f; }
                    u32x2 w; w.x = pk2(val[0], val[1]); w.y = pk2(val[2], val[3]);
                    *(u32x2*)(AT + i * 64 + 16 * nj + 4 * fq) = w;
                }
            }
        }
        bf16x8 ktf[8][2];
#pragma unroll
        for (int m8 = 0; m8 < 8; ++m8)
#pragma unroll
            for (int ks = 0; ks < 2; ++ks) ktf[m8][ks] = *(const bf16x8*)(KTg + (64 * (m8 >> 2) + 16 * (fr >> 2) + 4 * (m8 & 3) + (fr & 3)) * 64 + 32 * ks + 8 * fq);
        LDS_WAIT();
        asm volatile("" ::: "memory");
        float t[64];
        const float lanef = (float)lane_v;
#pragma unroll
        for (int i = 0; i < 64; ++i) { float s0 = fmaxf(0.f, 1.f - fabsf(lanef - (float)i)), s1 = 0.f, s2 = 0.f, s3 = 0.f;
            asm volatile("" ::: "memory");
#pragma unroll
            for (int j = 0; j < (V == 1 ? 0 : i); ++j) { if (j == 32) asm volatile("" ::: "memory"); const float av = As[i * 64 + j];
                if ((j & 3) == 0) s0 -= av * t[j]; else if ((j & 3) == 1) s1 -= av * t[j]; else if ((j & 3) == 2) s2 -= av * t[j]; else s3 -= av * t[j]; }
            t[i] = (s0 + s1) + (s2 + s3); }
        bf16x8 vtf[8][2];
#pragma unroll
        for (int m8 = 0; m8 < 8; ++m8)
#pragma unroll
            for (int ks = 0; ks < 2; ++ks) vtf[m8][ks] = *(const bf16x8*)(VTg + (16 * m8 + fr) * 64 + 32 * ks + 8 * fq);
        {
            const int co = dir ? 63 - lane : lane;
            const float bco = gs[64 + co], sW = bco * __expf(gs[co]);
            LDS_WAIT();
            asm volatile("" ::: "memory");
            LAS unsigned char* Tl = (LAS unsigned char*)As;
#pragma unroll
            for (int i = 0; i < 64; ++i) { const int io = dir ? 63 - i : i;
                const int off = io * 128 + ((((co >> 3) ^ ((io >> 1) & 7))) << 4) + (co & 7) * 2;
                *(LAS bf16_t*)(Tl + off) = (bf16_t)f2bf(t[i] * sW); *(LAS bf16_t*)(Tl + 8192 + off) = (bf16_t)f2bf(t[i] * bco); }
            LDS_WAIT();
            asm volatile("" ::: "memory");
            bf16_t* Wg = (bf16_t*)(F.ws + WS_W) + dt * 8192; bf16_t* UTg = (bf16_t*)(F.ws + WS_UT) + dt * 8192;
            bf16x8 tf[4][2];
#pragma unroll
            for (int nt = 0; nt < 4; ++nt)
#pragma unroll
                for (int ks = 0; ks < 2; ++ks) { const int row = 16 * nt + fr, c = 4 * ks + fq; tf[nt][ks] = *(const LAS bf16x8*)(Tl + row * 128 + ((c ^ ((row >> 1) & 7)) << 4)); }
#pragma unroll
            for (int G = 0; G < (V == 2 ? 0 : 2); ++G)
#pragma unroll
                for (int nt = 0; nt < 4; ++nt) { u32x4 w0, w1;
#pragma unroll
                    for (int tau = 0; tau < 4; ++tau) { f32x4 acc = {0.f, 0.f, 0.f, 0.f};
                        acc = __builtin_amdgcn_mfma_f32_16x16x32_bf16(ktf[4 * G + tau][0], tf[nt][0], acc, 0, 0, 0); acc = __builtin_amdgcn_mfma_f32_16x16x32_bf16(ktf[4 * G + tau][1], tf[nt][1], acc, 0, 0, 0);
                        const unsigned lo = pk2(acc[0], acc[1]), hi = pk2(acc[2], acc[3]);
                        if (tau == 0) { w0.x = lo; w0.y = hi; } else if (tau == 1) { w0.z = lo; w0.w = hi; } else if (tau == 2) { w1.x = lo; w1.y = hi; } else { w1.z = lo; w1.w = hi; } }
                    u32x4* wp = (u32x4*)(Wg + (16 * nt + fr) * 128 + 64 * G + 16 * fq);
                    if (V == 4) asm volatile("" :: "v"(w0), "v"(w1)); else { wp[0] = w0; wp[1] = w1; } }
#pragma unroll
            for (int tau = 0; tau < 4; ++tau)
#pragma unroll
                for (int ks = 0; ks < 2; ++ks) { const int row = 16 * (fr >> 2) + 4 * tau + (fr & 3), c = 4 * ks + fq; tf[tau][ks] = *(const LAS bf16x8*)(Tl + 8192 + row * 128 + ((c ^ ((row >> 1) & 7)) << 4)); }
#pragma unroll
            for (int ntd = 0; ntd < (V == 2 ? 0 : 8); ++ntd) {
                const bf16x8 b0 = vtf[ntd][0], b1 = vtf[ntd][1];
                u32x4 w0, w1;
#pragma unroll
                for (int tau = 0; tau < 4; ++tau) { f32x4 acc = {0.f, 0.f, 0.f, 0.f};
                    acc = __builtin_amdgcn_mfma_f32_16x16x32_bf16(tf[tau][0], b0, acc, 0, 0, 0); acc = __builtin_amdgcn_mfma_f32_16x16x32_bf16(tf[tau][1], b1, acc, 0, 0, 0);
                    const unsigned lo = pk2(acc[0], acc[1]), hi = pk2(acc[2], acc[3]);
                    if (tau == 0) { w0.x = lo; w0.y = hi; } else if (tau == 1) { w0.z = lo; w0.w = hi; } else if (tau == 2) { w1.x = lo; w1.y = hi; } else { w1.z = lo; w1.w = hi; } }
                u32x4* up = (u32x4*)(UTg + (16 * ntd + fr) * 64 + 16 * fq);
                if (V == 4) asm volatile("" :: "v"(w0), "v"(w1)); else { up[0] = w0; up[1] = w1; }
            }
        }
        LDS_WAIT();
    }
#ifndef NO_FILL
    if (F.G == 256 && F.vcu * NWAVE + F.wave >= NCHUNK * NH * 2 - 2 * 2048) moe_convert_wave(F, FILL_PREP, F.lds + F.wave * 17408);
#endif
}

constexpr int SC_W = 0, SC_Q = 16384, SC_KT = 32768, SC_AT = 49152, SC_UT = 57344, SC_GC = 65536, SC_SLOT = 65792;
constexpr int SC_ST = 2 * SC_SLOT, ST_ROW = 272, SC_VN = SC_ST + 64 * ST_ROW, RT_ROW = 144, SC_END = SC_VN + 64 * RT_ROW;
static_assert(SC_END <= LDS_BYTES - 128, "scan LDS map");
#define SC_WAIT_V(n) asm volatile("s_waitcnt vmcnt(" #n ")" ::: "memory")
#define SC_BAR() do { asm volatile("s_waitcnt lgkmcnt(0)" ::: "memory"); __builtin_amdgcn_s_barrier(); asm volatile("" ::: "memory"); } while (0)
struct ScanCtx { int b, h, dir, half, mt, np, fr, fq, w, lane; unsigned offW[2], offQ[2], offK[2], offA; };
__device__ __forceinline__ int sc_chunk(const ScanCtx& c, int n) { return n < 4 ? 256 + c.b * 4 + (c.dir ? 3 - n : n) : c.b * 64 + (c.dir ? 67 - n : n - 4); }
__device__ __forceinline__ void sc_dma(Frame& F, const ScanCtx& c, int n, int slotoff) {
    const int ci = sc_chunk(c, n); int row0, t0, sl; chunk_rows(ci, row0, t0, sl);
    const size_t dt = ((size_t)(c.dir * NCHUNK + ci) * NH + c.h);
    const char* gW = (const char*)(F.ws + WS_W) + dt * 16384; const char* gQ = (const char*)(F.ws + WS_QKV) + ((size_t)row0 * NQKV + c.h * 128) * 2;
    const char* gK = (const char*)(F.ws + WS_KT) + ((size_t)ci * NH + c.h) * 16384; const char* gA = (const char*)(F.ws + WS_ATT) + dt * 8192;
    const char* gU = (const char*)(F.ws + WS_UT) + dt * 16384 + c.half * 8192; const char* gG = (const char*)(F.ws + WS_GCB) + dt * 512;
    LAS unsigned char* lds = F.lds + slotoff;
#pragma unroll
    for (int i = 0; i < 2; ++i) {
        __builtin_amdgcn_global_load_lds((const unsigned*)(gW + c.offW[i]), (LAS unsigned*)(lds + SC_W + (2 * c.w + i) * 1024), 16, 0, 0);
        __builtin_amdgcn_global_load_lds((const unsigned*)(gQ + c.offQ[i]), (LAS unsigned*)(lds + SC_Q + (2 * c.w + i) * 1024), 16, 0, 0);
        __builtin_amdgcn_global_load_lds((const unsigned*)(gK + c.offK[i]), (LAS unsigned*)(lds + SC_KT + (2 * c.w + i) * 1024), 16, 0, 0); }
    __builtin_amdgcn_global_load_lds((const unsigned*)(gA + c.offA), (LAS unsigned*)(lds + SC_AT + c.w * 1024), 16, 0, 0);
    __builtin_amdgcn_global_load_lds((const unsigned*)(gU + c.offA), (LAS unsigned*)(lds + SC_UT + c.w * 1024), 16, 0, 0);
    __builtin_amdgcn_global_load_lds((const unsigned*)(gG + c.lane * 4), (LAS unsigned*)(lds + SC_GC), 4, 0, 0);
}
__device__ __forceinline__ void sc_store_o(Frame& F, const ScanCtx& c, int n, const f32x4 (&o)[2]) {
    const int lc = c.dir ? 67 - n : n - 4;
    bf16_t* Obase = (bf16_t*)(F.ws + WS_O);
#pragma unroll
    for (int u = 0; u < 2; ++u) { u32x2 w; w.x = pk2(o[u][0], o[u][1]); w.y = pk2(o[u][2], o[u][3]);
        *(u32x2*)(Obase + ((size_t)c.dir * ML + (size_t)c.b * T + lc * 64 + 16 * c.mt + c.fr) * D + c.h * 128 + c.half * 64 + 16 * (2 * c.np + u) + 4 * c.fq) = w; }
}
__device__ __forceinline__ void moe_convert_queue(Frame& F) {
    unsigned* ctr = (unsigned*)(F.ws + WS_CTL) + 16384;
    LAS unsigned* slot = (LAS unsigned*)(F.lds + 65536);
    LAS unsigned char* scr = F.lds + F.wave * 8192;
    for (;;) {
        __syncthreads();
        if (F.tid == 0) slot[0] = __hip_atomic_fetch_add(ctr, 8u, __ATOMIC_RELAXED, __HIP_MEMORY_SCOPE_AGENT);
        __syncthreads();
        const unsigned t = slot[0] + (unsigned)F.wave;
        if (slot[0] >= 2u * TR_MOE) break;
        if (t < 2u * TR_MOE) tr_moe_job(F, t >= (unsigned)TR_MOE, (int)(t >= (unsigned)TR_MOE ? t - TR_MOE : t), scr, F.lane);
    }
    __syncthreads();
}
__device__ __forceinline__ void phase_scan(Frame& F) {
    const int xcd = F.vcu >> 5, jcu = F.vcu & 31;
    if (F.G != 256 || jcu >= 16) {
        moe_convert_queue(F);
        if (F.G == 256) return;
    }
    ScanCtx c;
    c.lane = F.lane; c.fr = c.lane & 15; c.fq = c.lane >> 4; c.w = F.wave; c.mt = c.w >> 1; c.np = c.w & 1;
#pragma unroll
    for (int i = 0; i < 2; ++i) {
        { const int I = 2 * c.w + i, row = 4 * I + (c.lane >> 4), cc = (c.lane & 15) ^ (row & 15); c.offW[i] = (unsigned)(row * 256 + cc * 16); c.offQ[i] = (unsigned)(row * (NQKV * 2) + cc * 16); }
        { const int I = 2 * c.w + i, row = 8 * I + (c.lane >> 3), cc = (c.lane & 7) ^ ((row >> 1) & 7); c.offK[i] = (unsigned)(row * 128 + cc * 16); }
    }
    { const int row = 8 * c.w + (c.lane >> 3), cc = (c.lane & 7) ^ ((row >> 1) & 7); c.offA = (unsigned)(row * 128 + cc * 16); }
    const int lane = c.lane, fr = c.fr, fq = c.fq, mt = c.mt, np = c.np;
    LAS unsigned char* const lds = F.lds;
    const int item0 = (F.G == 256) ? xcd * 16 + jcu : F.vcu, nitem = (F.G == 256) ? 128 : F.G;
    for (int item = item0; item < 128; item += nitem) {
        c.half = item & 1; c.dir = (item >> 1) & 1; c.h = (item >> 2) & 7; c.b = item >> 5;
        for (int i = F.tid; i < 64 * ST_ROW / 4; i += NTHR) ((LAS unsigned*)(lds + SC_ST))[i] = 0u;
        f32x4 Sacc[2][2];
#pragma unroll
        for (int ud = 0; ud < 2; ++ud)
#pragma unroll
            for (int uv = 0; uv < 2; ++uv) Sacc[ud][uv] = (f32x4){0.f, 0.f, 0.f, 0.f};
        f32x4 Oprev[2] = {{0.f, 0.f, 0.f, 0.f}, {0.f, 0.f, 0.f, 0.f}};
        sc_dma(F, c, 0, 0);
        SC_WAIT_V(0);
        SC_BAR();
        sc_dma(F, c, 1, SC_SLOT);
#pragma unroll 1
        for (int n = 0; n < 68; ++n) {
            const bool latent = n >= 4;
            const int so = (n & 1) * SC_SLOT;
            LAS unsigned char* const slot = lds + so;
            LAS unsigned char* const St = lds + SC_ST;
            f32x4 xacc[2], oacc[2];
#pragma unroll
            for (int u = 0; u < 2; ++u) { xacc[u] = (f32x4){0.f, 0.f, 0.f, 0.f}; oacc[u] = (f32x4){0.f, 0.f, 0.f, 0.f}; }
            const int arow = 16 * mt + fr;
#pragma unroll
            for (int ks = 0; ks < 4; ++ks) {
                const int co = (((4 * ks + fq) ^ fr) << 4);
                const bf16x8 aW = *(const LAS bf16x8*)(slot + SC_W + arow * 256 + co), aQ = *(const LAS bf16x8*)(slot + SC_Q + arow * 256 + co);
#pragma unroll
                for (int u = 0; u < 2; ++u) { const bf16x8 bS = *(const LAS bf16x8*)(St + (16 * (2 * np + u) + fr) * ST_ROW + (32 * ks + 8 * fq) * 2);
                    xacc[u] = __builtin_amdgcn_mfma_f32_16x16x32_bf16(aW, bS, xacc[u], 0, 0, 0);
                    oacc[u] = __builtin_amdgcn_mfma_f32_16x16x32_bf16(bS, aQ, oacc[u], 0, 0, 0); } }
            const float egl = __expf(*(const LAS float*)(slot + SC_GC + (16 * mt + fr) * 4));
            const float gtot = *(const LAS float*)(slot + SC_GC + (c.dir ? 0 : 63) * 4);
#pragma unroll
            for (int u = 0; u < 2; ++u) { const int urow = 16 * (2 * np + u) + fr, uc = 2 * mt + (fq >> 1);
              const u32x2 uw = *(const LAS u32x2*)(slot + SC_UT + urow * 128 + ((uc ^ ((urow >> 1) & 7)) << 4) + 8 * (fq & 1));
              u32x2 pw; pw.x = pk2(bflo(uw.x) - xacc[u][0], bfhi(uw.x) - xacc[u][1]); pw.y = pk2(bflo(uw.y) - xacc[u][2], bfhi(uw.y) - xacc[u][3]);
              *(LAS u32x2*)(lds + SC_VN + urow * RT_ROW + (16 * mt + 4 * fq) * 2) = pw; }
            bf16x8 aK[2][2], aA[2];
#pragma unroll
            for (int ks = 0; ks < 2; ++ks) {
                aA[ks] = *(const LAS bf16x8*)(slot + SC_AT + arow * 128 + ((((4 * ks + fq) ^ ((arow >> 1) & 7))) << 4));
                const f32x4 g0 = *(const LAS f32x4*)(slot + SC_GC + (32 * ks + 8 * fq) * 4), g1 = *(const LAS f32x4*)(slot + SC_GC + (32 * ks + 8 * fq + 4) * 4);
                float e[8];
#pragma unroll
                for (int j = 0; j < 4; ++j) { e[j] = __expf(gtot - g0[j]); e[4 + j] = __expf(gtot - g1[j]); }
#pragma unroll
                for (int ud = 0; ud < 2; ++ud) { const int krow = 16 * (2 * mt + ud) + fr;
                    const u32x4 kw = *(const LAS u32x4*)(slot + SC_KT + krow * 128 + ((((4 * ks + fq) ^ ((krow >> 1) & 7))) << 4));
                    u32x4 o; o.x = pk2(bflo(kw.x) * e[0], bfhi(kw.x) * e[1]); o.y = pk2(bflo(kw.y) * e[2], bfhi(kw.y) * e[3]); o.z = pk2(bflo(kw.z) * e[4], bfhi(kw.z) * e[5]); o.w = pk2(bflo(kw.w) * e[6], bfhi(kw.w) * e[7]);
                    aK[ud][ks] = __builtin_bit_cast(bf16x8, o); } }
            SC_BAR();
            if (n - 1 >= 4) sc_store_o(F, c, n - 1, Oprev);
            if (n + 2 < 68) sc_dma(F, c, n + 2, so);
            bf16x8 bV[2][2];
#pragma unroll
            for (int u = 0; u < 2; ++u)
#pragma unroll
                for (int ks = 0; ks < 2; ++ks) bV[u][ks] = *(const LAS bf16x8*)(lds + SC_VN + (16 * (2 * np + u) + fr) * RT_ROW + (32 * ks + 8 * fq) * 2);
            if (latent) {
#pragma unroll
                for (int u = 0; u < 2; ++u) {
                    oacc[u] *= egl;
#pragma unroll
                    for (int ks = 0; ks < 2; ++ks) oacc[u] = __builtin_amdgcn_mfma_f32_16x16x32_bf16(bV[u][ks], aA[ks], oacc[u], 0, 0, 0);
                    Oprev[u] = oacc[u];
                }
            }
            const float egt = __expf(gtot);
#pragma unroll
            for (int ud = 0; ud < 2; ++ud)
#pragma unroll
                for (int uv = 0; uv < 2; ++uv) {
                    Sacc[ud][uv] *= egt;
#pragma unroll
                    for (int ks = 0; ks < 2; ++ks) Sacc[ud][uv] = __builtin_amdgcn_mfma_f32_16x16x32_bf16(aK[ud][ks], bV[uv][ks], Sacc[ud][uv], 0, 0, 0);
                    u32x2 pw; pw.x = pk2(Sacc[ud][uv][0], Sacc[ud][uv][1]); pw.y = pk2(Sacc[ud][uv][2], Sacc[ud][uv][3]);
                    *(LAS u32x2*)(St + (16 * (2 * np + uv) + fr) * ST_ROW + (16 * (2 * mt + ud) + 4 * fq) * 2) = pw;
                }
            if (n + 2 < 68) SC_WAIT_V(9); else SC_WAIT_V(0);
            SC_BAR();
        }
        sc_store_o(F, c, 67, Oprev);
        SC_WAIT_V(0);
        SC_BAR();
    }
    if (F.G == 256) moe_convert_queue(F);
}

__device__ __forceinline__ void phase_gdn_out(Frame& F) {
    const bf16_t* O0 = (const bf16_t*)(F.ws + WS_O); const bf16_t* O1 = O0 + (size_t)ML * D;
    const bf16_t* P = (const bf16_t*)(F.ws + WS_P);
    bf16_t* ON = (bf16_t*)(F.ws + WS_ON);
    const int lane = F.lane;
    const f32x4 gain = *(const f32x4*)(F.in[I_OGAIN] + ((4 * lane) & 127));
    f32x4 an[4], bn[4];
    { const int r0 = F.vcu * NWAVE + F.wave; if (r0 < ML) { load_row_bf16(O0 + (size_t)r0 * D, lane, an); load_row_bf16(O1 + (size_t)r0 * D, lane, bn); } }
    for (int row = F.vcu * NWAVE + F.wave; row < ML; row += F.G * NWAVE) {
        f32x4 a[4], b[4];
#pragma unroll
        for (int j = 0; j < 4; ++j) { a[j] = an[j]; b[j] = bn[j]; }
        { const int nr = row + F.G * NWAVE; if (nr < ML) { load_row_bf16(O0 + (size_t)nr * D, lane, an); load_row_bf16(O1 + (size_t)nr * D, lane, bn); } }
        f32x4 y[4];
#pragma unroll
        for (int j = 0; j < 4; ++j) { const f32x4 o = a[j] + b[j];
            float ss = (o[0] * o[0] + o[1] * o[1]) + (o[2] * o[2] + o[3] * o[3]);
            ss = row16_sum(ss); ss += __shfl_xor(ss, 16);
            const float rs = rsqrtf(ss * (1.f / DH) + EPS);
            const u32x2 zw = ((const u32x2*)(P + (size_t)row * NP + NQKV))[lane + 64 * j];
            const float z0 = bflo(zw.x), z1 = bfhi(zw.x), z2 = bflo(zw.y), z3 = bfhi(zw.y);
            y[j][0] = o[0] * rs * gain[0] * siluf(z0); y[j][1] = o[1] * rs * gain[1] * siluf(z1); y[j][2] = o[2] * rs * gain[2] * siluf(z2); y[j][3] = o[3] * rs * gain[3] * siluf(z3); }
        store_row_bf16(ON + (size_t)row * D, lane, y);
    }
}

#define DPP_MAX(v, ctrl) fmaxf((v), __builtin_bit_cast(float, __builtin_amdgcn_update_dpp(0, __builtin_bit_cast(int, (v)), (ctrl), 0xf, 0xf, true)))
__device__ __forceinline__ float row16_max(float v) { v = DPP_MAX(v, 0xB1); v = DPP_MAX(v, 0x4E); v = DPP_MAX(v, 0x141); v = DPP_MAX(v, 0x140); return v; }
__device__ __forceinline__ float router_softmax(float (&lg)[16], int lane) {
    float mine = 0.f;
#pragma unroll
    for (int e = 0; e < 16; ++e) { const float s = row16_sum(lg[e]); mine = ((lane & 15) == e) ? s : mine; }
    mine += __shfl_xor(mine, 16); mine += __shfl_xor(mine, 32);
    const float mx = row16_max(mine), ex = __expf(mine - mx), den = row16_sum(ex);
    return ex * __builtin_amdgcn_rcpf(den);
}
__device__ __forceinline__ void phase_moe_pre(Frame& F, int l) {
    const float* MOD = (const float*)(F.ws + WS_MOD) + (size_t)l * 5 * 6144;
    const bf16_t* H = (const bf16_t*)(F.ws + WS_H);
    bf16_t* U = (bf16_t*)(F.ws + WS_U);
    float* AFF = (float*)(F.ws + WS_AFF);
    LAS float* wr = (LAS float*)F.lds;
    const float* wsrc = F.in[I_WR] + (size_t)l * D * NE;
    for (int i = F.tid; i < D * NE / 4; i += NTHR) { const int c = i >> 2, q = i & 3; *(LAS f32x4*)(wr + c * 16 + 4 * q + (c >> 2) * 4) = ((const f32x4*)wsrc)[i]; }
    __syncthreads();
    const int lane = F.lane, stride = F.G * NWAVE;
    for (int row = F.vcu * NWAVE + F.wave; row < ML; row += 2 * stride) {
        const int row1 = row + stride; const bool has1 = row1 < ML;
        f32x4 v0[4], v1[4], y0[4], y1[4];
        load_row_bf16(H + (size_t)row * D, lane, v0); load_row_bf16(H + (size_t)(has1 ? row1 : row) * D, lane, v1);
        const float rs0 = row_rstd(v0), rs1 = row_rstd(v1);
        norm_mod(v0, rs0, F.in[I_GFFN] + l * D, MOD + (size_t)(row / T) * 6144 + 3 * D, MOD + (size_t)(row / T) * 6144 + 4 * D, lane, y0);
        { const int r1 = has1 ? row1 : row; norm_mod(v1, rs1, F.in[I_GFFN] + l * D, MOD + (size_t)(r1 / T) * 6144 + 3 * D, MOD + (size_t)(r1 / T) * 6144 + 4 * D, lane, y1); }
#pragma unroll
        for (int j = 0; j < 4; ++j) { ((unsigned*)((unsigned char*)U + (size_t)row * D))[lane + 64 * j] = pk4_fp8(y0[j][0], y0[j][1], y0[j][2], y0[j][3]);
            if (has1) ((unsigned*)((unsigned char*)U + (size_t)row1 * D))[lane + 64 * j] = pk4_fp8(y1[j][0], y1[j][1], y1[j][2], y1[j][3]); }
        float lg0[16], lg1[16];
#pragma unroll
        for (int e = 0; e < 16; ++e) { lg0[e] = 0.f; lg1[e] = 0.f; }
#pragma unroll
        for (int j = 0; j < 4; ++j) {
            asm volatile("" ::: "memory");
#pragma unroll
            for (int i = 0; i < 4; ++i) { const int c = 4 * lane + 256 * j + i; const float a = y0[j][i], bq = y1[j][i];
#pragma unroll
                for (int q = 0; q < 4; ++q) { const f32x4 wv = *(const LAS f32x4*)(wr + c * 16 + 4 * q + (c >> 2) * 4);
                    lg0[4 * q] += a * wv[0]; lg0[4 * q + 1] += a * wv[1]; lg0[4 * q + 2] += a * wv[2]; lg0[4 * q + 3] += a * wv[3];
                    lg1[4 * q] += bq * wv[0]; lg1[4 * q + 1] += bq * wv[1]; lg1[4 * q + 2] += bq * wv[2]; lg1[4 * q + 3] += bq * wv[3]; } } }
        const float a0 = router_softmax(lg0, lane), a1 = router_softmax(lg1, lane);
        if (lane < 16) { AFF[((size_t)(row / T) * NE + lane) * T + row % T] = a0; if (has1) AFF[((size_t)(row1 / T) * NE + lane) * T + row1 % T] = a1; }
    }
    __syncthreads();
}

__device__ __forceinline__ void phase_topk(Frame& F) {
    LAS unsigned* cnt = (LAS unsigned*)F.lds;
    const float* AFF = (const float*)(F.ws + WS_AFF);
    int* SLOT = (int*)(F.ws + WS_SLOT); int* IDX = (int*)(F.ws + WS_IDX); float* GATE = (float*)(F.ws + WS_GATE);
    for (int item = F.vcu; item < NB * NE; item += F.G) {
        const int b = item / NE, e = item % NE;
        unsigned key[8];
        { const u32x4* p = (const u32x4*)(AFF + (size_t)item * T + F.tid * 8); const u32x4 k0 = p[0], k1 = p[1];
          key[0] = k0.x; key[1] = k0.y; key[2] = k0.z; key[3] = k0.w; key[4] = k1.x; key[5] = k1.y; key[6] = k1.z; key[7] = k1.w; }
        unsigned thr = 0u;
        int par = 0;
        for (int bit = 30; bit >= 0; --bit) {
            const unsigned cand = thr | (1u << bit);
            int c = 0;
#pragma unroll
            for (int i = 0; i < 8; ++i) c += (key[i] >= cand) ? 1 : 0;
#pragma unroll
            for (int o = 1; o < 64; o <<= 1) c += __shfl_xor(c, o);
            if (F.lane == 0) cnt[par * 8 + F.wave] = (unsigned)c;
            __syncthreads();
            unsigned tot = 0;
#pragma unroll
            for (int w8 = 0; w8 < 8; ++w8) tot += cnt[par * 8 + w8];
            if (tot >= (unsigned)CAP) thr = cand;
            par ^= 1;
        }
        __syncthreads();
        int cg_ = 0, ce_ = 0;
#pragma unroll
        for (int i = 0; i < 8; ++i) { cg_ += key[i] > thr; ce_ += key[i] == thr; }
        unsigned pk = (unsigned)cg_ | ((unsigned)ce_ << 16), inc = pk;
#pragma unroll
        for (int o = 1; o < 64; o <<= 1) { const unsigned t = __shfl_up(inc, o); if (F.lane >= o) inc += t; }
        LAS unsigned* wtot = cnt + 64;
        if (F.lane == 63) wtot[F.wave] = inc;
        __syncthreads();
        unsigned base = 0, total = 0;
#pragma unroll
        for (int w8 = 0; w8 < 8; ++w8) { const unsigned v = wtot[w8]; if (w8 < F.wave) base += v; total += v; }
        const unsigned excl = base + inc - pk;
        int gt_before = excl & 0xffffu, eq_before = excl >> 16;
        const int need_eq = CAP - (int)(total & 0xffffu);
#pragma unroll
        for (int i = 0; i < 8; ++i) {
            const int t = F.tid * 8 + i;
            const bool isg = key[i] > thr, ise = key[i] == thr;
            const bool sel = isg || (ise && eq_before < need_eq);
            const int slot = gt_before + (eq_before < need_eq ? eq_before : need_eq);
            SLOT[(size_t)item * T + t] = sel ? slot : -1;
            if (sel) { IDX[item * CAP + slot] = t; GATE[(size_t)e * 2048 + b * CAP + slot] = __uint_as_float(key[i]); }
            gt_before += isg; eq_before += ise;
        }
        __syncthreads();
    }
}

__device__ __forceinline__ void phase_gather(Frame& F) {
    const unsigned char* U = (const unsigned char*)(F.ws + WS_U); unsigned char* XS = (unsigned char*)(F.ws + WS_XS); const int* IDX = (const int*)(F.ws + WS_IDX);
    for (int r = F.vcu * NWAVE + F.wave; r < MX; r += F.G * NWAVE) {
        const int e = r / 2048, b = (r % 2048) / CAP, s = r % CAP;
        const int t = IDX[(b * NE + e) * CAP + s];
        ((u32x4*)(XS + (size_t)r * D))[F.lane] = ((const u32x4*)(U + ((size_t)b * T + t) * D))[F.lane];
    }
}

__device__ __forceinline__ void phase_combine(Frame& F, int l) {
    const float* MOD = (const float*)(F.ws + WS_MOD);
    bf16_t* H = (bf16_t*)(F.ws + WS_H); const bf16_t* YS = (const bf16_t*)(F.ws + WS_YS); const int* SLOT = (const int*)(F.ws + WS_SLOT);
    bf16_t* U = (bf16_t*)(F.ws + WS_U);
    const int lane = F.lane, stride = F.G * NWAVE;
    int row = F.vcu * NWAVE + F.wave;
    f32x4 vn[4]; int slotn = -1;
    if (row < ML) { load_row_bf16(H + (size_t)row * D, lane, vn); slotn = lane < NE ? SLOT[((size_t)(row / T) * NE + lane) * T + row % T] : -1; }
    for (; row < ML; row += stride) {
        const int b = row / T;
        f32x4 v[4]; const int myslot = slotn;
#pragma unroll
        for (int j = 0; j < 4; ++j) v[j] = vn[j];
        { const int nr = row + stride; if (nr < ML) { load_row_bf16(H + (size_t)nr * D, lane, vn); slotn = lane < NE ? SLOT[((size_t)(nr / T) * NE + lane) * T + nr % T] : -1; } }
        f32x4 acc[4];
#pragma unroll
        for (int j = 0; j < 4; ++j) acc[j] = (f32x4){0.f, 0.f, 0.f, 0.f};
        unsigned long long mask = __ballot(myslot >= 0);
        while (mask) {
            u32x2 yv[4][4]; bool have[4];
#pragma unroll
            for (int k = 0; k < 4; ++k) { have[k] = mask != 0ull;
                if (have[k]) { const int e = __builtin_ctzll(mask); mask &= mask - 1ull; const int sl = __builtin_amdgcn_readlane(myslot, e);
                    const u32x2* yp = (const u32x2*)(YS + ((size_t)e * 2048 + b * CAP + sl) * D);
#pragma unroll
                    for (int j = 0; j < 4; ++j) yv[k][j] = yp[lane + 64 * j]; } }
#pragma unroll
            for (int k = 0; k < 4; ++k) if (have[k]) {
#pragma unroll
                for (int j = 0; j < 4; ++j) { const u32x2 w = yv[k][j]; acc[j][0] += bflo(w.x); acc[j][1] += bfhi(w.x); acc[j][2] += bflo(w.y); acc[j][3] += bfhi(w.y); } }
        }
        const float* gtf = MOD + ((size_t)l * 5 + b) * 6144 + 5 * D;
#pragma unroll
        for (int j = 0; j < 4; ++j) v[j] += ((const f32x4*)gtf)[lane + 64 * j] * acc[j];
        const float rstd = row_rstd(v);
        if (l == 0) {
#pragma unroll
            for (int j = 0; j < 4; ++j) { u32x2 w; w.x = pk2(v[j][0], v[j][1]); w.y = pk2(v[j][2], v[j][3]); ((u32x2*)(H + (size_t)row * D))[lane + 64 * j] = w; }
            const float* m = MOD + ((size_t)5 + b) * 6144; f32x4 y[4];
            norm_mod(v, rstd, F.in[I_GMIX] + D, m, m + D, lane, y);
            store_row_bf16(U + (size_t)row * D, lane, y);
        } else {
#pragma unroll
            for (int j = 0; j < 4; ++j) ((f32x4*)(F.out + (size_t)row * D))[lane + 64 * j] = v[j] * rstd * ((const f32x4*)F.in[I_FING])[lane + 64 * j];
        }
    }
}

template <int GI>
__device__ __forceinline__ void pool_item(Frame& F, int b, int r, LAS float* Vs, int cp, int cgp) {
    constexpr int W = 2 << GI, LO = W >> 1, HI = W - LO;
    const bf16_t* U = (const bf16_t*)(F.ws + WS_U); bf16_t* PD = (bf16_t*)(F.ws + WS_ON);
    const int r_lo = r - LO < 0 ? 0 : r - LO, r_hi = r + HI > 64 ? 64 : r + HI;
    float s0[16], s1[16]; unsigned self[16];
#pragma unroll
    for (int i = 0; i < 16; ++i) { s0[i] = 0.f; s1[i] = 0.f; }
    const bf16_t* base = U + ((size_t)b * T + cgp * 16) * D + GI * 256 + 2 * cp;
    int rr = r_lo;
    for (; rr + 4 <= r_hi; rr += 4) {
        unsigned x[4][16];
#pragma unroll
        for (int q = 0; q < 4; ++q)
#pragma unroll
            for (int i = 0; i < 16; ++i) x[q][i] = *(const unsigned*)(base + ((size_t)(rr + q) * 64 + i) * D);
#pragma unroll
        for (int q = 0; q < 4; ++q)
#pragma unroll
            for (int i = 0; i < 16; ++i) { s0[i] += bflo(x[q][i]); s1[i] += bfhi(x[q][i]); }
    }
    for (; rr < r_hi; ++rr) {
#pragma unroll
        for (int i = 0; i < 16; ++i) { const unsigned x = *(const unsigned*)(base + ((size_t)rr * 64 + i) * D); s0[i] += bflo(x); s1[i] += bfhi(x); }
    }
#pragma unroll
    for (int i = 0; i < 16; ++i) { self[i] = *(const unsigned*)(base + ((size_t)r * 64 + i) * D); *(LAS f32x2*)(Vs + (8 + cgp * 16 + i) * 256 + 2 * cp) = (f32x2){s0[i], s1[i]}; }
    __syncthreads();
    const float inv_r = 1.f / (float)(r_hi - r_lo);
    const int c0 = cgp * 16;
    f32x2 first[W], add[15], sub[15];
#pragma unroll
    for (int k = 0; k < W; ++k) first[k] = *(const LAS f32x2*)(Vs + (8 + c0 - LO + k) * 256 + 2 * cp);
#pragma unroll
    for (int i = 1; i < 16; ++i) { add[i - 1] = *(const LAS f32x2*)(Vs + (8 + c0 + i + HI - 1) * 256 + 2 * cp); sub[i - 1] = *(const LAS f32x2*)(Vs + (8 + c0 + i - LO - 1) * 256 + 2 * cp); }
    f32x2 run = {0.f, 0.f};
#pragma unroll
    for (int k = 0; k < W; ++k) run += first[k];
#pragma unroll
    for (int i = 0; i < 16; ++i) { const int c = c0 + i;
        if (i > 0) run += add[i - 1] - sub[i - 1];
        const int c_lo = c - LO < 0 ? 0 : c - LO, c_hi = c + HI > 64 ? 64 : c + HI;
        const float sc = inv_r / (float)(c_hi - c_lo);
        *(unsigned*)(PD + ((size_t)b * T + r * 64 + c) * D + GI * 256 + 2 * cp) = pk2(run[0] * sc - bflo(self[i]), run[1] * sc - bfhi(self[i])); }
    __syncthreads();
}
__device__ __forceinline__ void phase_pool(Frame& F) {
    LAS float* Vs = (LAS float*)F.lds;
    const int cp = F.tid & 127, cgp = F.tid >> 7;
    for (int i = F.tid; i < 8 * 256; i += NTHR) { Vs[i] = 0.f; Vs[72 * 256 + i] = 0.f; }
    __syncthreads();
    for (int item = F.vcu; item < 1024; item += F.G) {
        const int gi = item >> 8, b = (item >> 6) & 3, r = item & 63;
        if (gi == 0) pool_item<0>(F, b, r, Vs, cp, cgp); else if (gi == 1) pool_item<1>(F, b, r, Vs, cp, cgp); else if (gi == 2) pool_item<2>(F, b, r, Vs, cp, cgp); else pool_item<3>(F, b, r, Vs, cp, cgp);
    }
}

constexpr int NPHASE = 22;
__global__ void __launch_bounds__(NTHR, 2) mega_fwd(Args args) {
    extern __shared__ __attribute__((aligned(16))) unsigned char lds_raw[];
    Frame F;
    F.lds = (LAS unsigned char*)lds_raw;
    F.tid = threadIdx.x; F.lane = F.tid & 63; F.wave = __builtin_amdgcn_readfirstlane(F.tid >> 6);
    F.G = gridDim.x; { const int bx = blockIdx.x; F.vcu = (F.G % 8 == 0) ? (bx % 8) * (F.G / 8) + bx / 8 : bx; }
#pragma unroll
    for (int i = 0; i < 21; ++i) F.in[i] = args.in[i];
    F.out = args.out; F.ws = args.ws;
    const int lo = args.ph_lo, hi = args.ph_hi;
    if (F.tid < 32) ((LAS unsigned*)(F.lds + MISC_OFF))[F.tid] = 0u;
    __syncthreads();
    XcdBarrier bar = xcd_barrier_post((unsigned*)(F.ws + WS_CTL) + 4096, (volatile LAS unsigned*)(F.lds + MISC_OFF));
#ifndef PHMASK
#define PHMASK 0x3fffff
#endif
#define IN(k) ((((PHMASK) >> (k)) & 1) && lo <= (k) && (k) < hi)
#define SEAM(k) do { if (IN(k) && IN((k) + 1)) { xcd_barrier(bar); } F.tid = threadIdx.x; asm volatile("" : "+v"(F.tid)); F.lane = F.tid & 63; F.wave = __builtin_amdgcn_readfirstlane(F.tid >> 6); } while (0)
    const int c = (int)blockIdx.x;

#ifndef REP_PHASE
#define REP_PHASE (-1)
#endif
#ifndef REP_N
#define REP_N 2
#endif
#define RUN(k, ...) for (int _r = 0; _r < ((k) == REP_PHASE ? 1 + REP_N : 1); ++_r) { if (IN(k)) { __VA_ARGS__ } SEAM(k); }
    RUN(0, {
        if (F.vcu < 192) mod_item(F, F.vcu);
        LAS unsigned char* scr = F.lds + F.wave * 8192;
        const int gw = F.vcu * NWAVE + F.wave, NGW = F.G * NWAVE;
        for (int t = gw; t < TR_SMALL; t += NGW) tr_small_job(F, t, scr);
    })
    RUN(1, phase_norm0(F);)
    RUN(2, {
        pg8::Gemm g{(const bf16_t*)(F.ws + WS_U), (const bf16_t*)(F.ws + WS_WIN), D, D};
        pg8::DenseOrder S; S.init(MA / 256, NPROJ_PAD / 256, F.G, c);
        pg8::EpiInProj E{(bf16_t*)(F.ws + WS_P), (float*)(F.ws + WS_AB)};
        pg8::gemm_phase(F.lds, g, S, E);
#ifndef NO_FILL
        if (F.G == 256 && c >= (MA / 256) * (NPROJ_PAD / 256) - 4 * 256) moe_convert_wave(F, FILL_INPROJ, F.lds + F.wave * 8192);
#endif
    })
    RUN(3, phase_conv(F);)
#ifndef PREPV
    RUN(4, phase_prep<0>(F);)
#else
    RUN(4, phase_prep<PREPV>(F); __syncthreads(); phase_prep<PREPV>(F); __syncthreads(); phase_prep<0>(F);)
#endif
    RUN(5, phase_scan(F);)
    RUN(6, phase_gdn_out(F);)
    RUN(7, {
        pg8::Gemm g{(const bf16_t*)(F.ws + WS_ON), (const bf16_t*)(F.ws + WS_WOUT), D, D};
        pg8::DenseOrder S; S.init(ML / 256, D / 256, F.G, c);
        pg8::EpiOutProj E{F.in[I_X], (bf16_t*)(F.ws + WS_H), (const float*)(F.ws + WS_MOD) + 2 * D};
        pg8::gemm_phase(F.lds, g, S, E);
    })
#pragma unroll
    for (int l = 0; l < 2; ++l) {
        if (l == 1) {
            RUN(14, phase_pool(F);)
            RUN(15, {
                pg8::Gemm g{(const bf16_t*)(F.ws + WS_ON), (const bf16_t*)(F.ws + WS_POOLW), D, 256};
                pg8::PoolOrder S{F.G, c};
                pg8::EpiPool E{(bf16_t*)(F.ws + WS_H), (const float*)(F.ws + WS_MOD) + 5 * 6144 + 2 * D, F.in[I_POOLS]};
                pg8::gemm_phase(F.lds, g, S, E);
            })
        }
        const int p0 = l == 0 ? 8 : 16;
        RUN(p0, {
            phase_moe_pre(F, l);

        })
        RUN(p0 + 1, phase_topk(F);)
        RUN(p0 + 2, phase_gather(F);)
        RUN(p0 + 3, {
            pg8::Gemm g{(const bf16_t*)(F.ws + WS_XS), (const bf16_t*)(F.ws + WS_WMOE + (size_t)l * WMOE_LAYER), D, D};
            pg8::MoeUpOrder S{F.G, c};
            pg8::EpiSwiglu E{(unsigned char*)(F.ws + WS_HID)};
            pg8::gemm_phase<pg8::EpiSwiglu, pg8::MoeUpOrder, true>(F.lds, g, S, E);
        })
        RUN(p0 + 4, {
            pg8::Gemm g{(const bf16_t*)(F.ws + WS_HID), (const bf16_t*)(F.ws + WS_W2T + (size_t)l * WMOE_LAYER), DF, DF};
            pg8::MoeDownOrder S{F.G, c};
            pg8::EpiDown E{(bf16_t*)(F.ws + WS_YS), (const float*)(F.ws + WS_GATE)};
            pg8::gemm_phase<pg8::EpiDown, pg8::MoeDownOrder, true>(F.lds, g, S, E);
        })
        RUN(p0 + 5, phase_combine(F, l);)
    }
#undef IN
#undef SEAM
#undef RUN
}

extern "C" void kernel_launch(void* const* d_in, const int* in_sizes, int n_in, void* d_out, int out_size, void* d_ws, size_t ws_size, hipStream_t stream) {
    static int grid = 0;
    if (grid == 0) {
        if (n_in != 21 || ws_size < WS_END) { fprintf(stderr, "kernel_launch: unexpected inputs (n_in %d, ws %zu)\n", n_in, ws_size); grid = -1; return; }
        int dev = 0, cus = 0, per_cu = 0;
        hipGetDevice(&dev);
        hipDeviceGetAttribute(&cus, hipDeviceAttributeMultiprocessorCount, dev);
        hipFuncSetAttribute((const void*)mega_fwd, hipFuncAttributeMaxDynamicSharedMemorySize, LDS_BYTES);
        hipOccupancyMaxActiveBlocksPerMultiprocessor(&per_cu, (const void*)mega_fwd, NTHR, LDS_BYTES);
        if (per_cu < 1) { fprintf(stderr, "kernel_launch: occupancy query says %d blocks per CU\n", per_cu); per_cu = 1; }
        grid = cus;
        (void)hipGetLastError();
    }
    if (grid < 0) return;
    hipMemsetAsync((char*)d_ws + WS_CTL, 0, 1 * MiB, stream);
    Args a{};
    for (int i = 0; i < 21; ++i) a.in[i] = (const float*)d_in[i];
    a.out = (float*)d_out; a.ws = (unsigned char*)d_ws;
#if MK_N_LAUNCHES == 1
    a.ph_lo = 0; a.ph_hi = NPHASE;
    void* params[] = {&a};
    (void)params;
    hipLaunchKernelGGL(mega_fwd, dim3(grid), dim3(NTHR), LDS_BYTES, stream, a);
    hipError_t e = hipPeekAtLastError();
    if (e != hipSuccess) fprintf(stderr, "launch failed: %s (grid %d)\n", hipGetErrorString(e), grid);
#else
    for (int p = 0; p < NPHASE; ++p) {
        a.ph_lo = p; a.ph_hi = p + 1;
        void* params[] = {&a};
        hipError_t e = hipLaunchCooperativeKernel((const void*)mega_fwd, dim3(grid), dim3(NTHR), params, LDS_BYTES, stream);
        if (e != hipSuccess) { fprintf(stderr, "launch %d failed: %s (grid %d)\n", p, hipGetErrorString(e), grid); break; }
    }
#endif
}
```

```cpp
#include <hip/hip_runtime.h>
#include <hip/hip_cooperative_groups.h>
#include <cstdio>
namespace cg = cooperative_groups;

#ifndef MK_N_LAUNCHES
#define MK_N_LAUNCHES 1
#endif

#define LAS __attribute__((address_space(3)))
typedef unsigned short bf16_t;
typedef short bf16x8 __attribute__((ext_vector_type(8)));
typedef float f32x4 __attribute__((ext_vector_type(4)));
typedef float f32x2 __attribute__((ext_vector_type(2)));
typedef unsigned u32x4 __attribute__((ext_vector_type(4)));
typedef unsigned u32x2 __attribute__((ext_vector_type(2)));

constexpr int NB = 4, T = 4096, D = 1024, TC = 256, NH = 8, DH = 128, NE = 16, CAP = 512, DF = 2048;
constexpr int ML = NB * T;
constexpr int MC = NB * TC;
constexpr int MA = ML + MC;
constexpr int NPROJ = 4128, NPROJ_PAD = 4352, NQKV = 3072, NP = 4096;
constexpr int NCHUNK = MA / 64;
constexpr int MX = NB * NE * CAP;
constexpr float EPS = 1e-6f;
constexpr int NTHR = 512, NWAVE = 8;

constexpr size_t MiB = 1u << 20;
constexpr size_t WS_CTL = 0;
constexpr size_t WS_MOD = 1 * MiB;
constexpr size_t WS_AB = 2 * MiB;
constexpr size_t WS_GCB = 5 * MiB;
constexpr size_t WS_AFF = 5 * MiB;
constexpr size_t WS_SLOT = 6 * MiB;
constexpr size_t WS_IDX = 7 * MiB;
constexpr size_t WS_GATE = 7 * MiB + 256 * 1024;
constexpr size_t WS_WIN = 8 * MiB;
constexpr size_t WS_WOUT = 17 * MiB;
constexpr size_t WS_POOLW = 19 * MiB;
constexpr size_t WS_WMOE = 20 * MiB;
constexpr size_t WS_W2T = WS_WMOE + 64 * MiB;
constexpr size_t WMOE_LAYER = 96 * MiB;
constexpr size_t WS_H = 212 * MiB;
constexpr size_t WS_U = 276 * MiB;
constexpr size_t WS_ON = 310 * MiB;
constexpr size_t WS_G = 342 * MiB;
constexpr size_t WS_P = WS_G;
constexpr size_t WS_QKV = WS_G + 136 * MiB;
constexpr size_t WS_KT = WS_G + 238 * MiB;
constexpr size_t WS_VT = WS_G + 272 * MiB;
constexpr size_t WS_W = WS_G + 306 * MiB;
constexpr size_t WS_UT = WS_G + 374 * MiB;
constexpr size_t WS_ATT = WS_G + 442 * MiB;
constexpr size_t WS_O = WS_G + 476 * MiB;
constexpr size_t WS_XS = WS_G;
constexpr size_t WS_HID = WS_G + 64 * MiB;
constexpr size_t WS_YS = WS_G + 192 * MiB;
constexpr size_t WS_END = WS_G + 604 * MiB;

constexpr int LDS_BYTES = 163840;

typedef __bf16 bf16v2 __attribute__((ext_vector_type(2)));
__device__ __forceinline__ unsigned pk2(float lo, float hi) { const f32x2 v = {lo, hi}; return __builtin_bit_cast(unsigned, __builtin_convertvector(v, bf16v2)); }
__device__ __forceinline__ unsigned f2bf(float f) { return pk2(f, 0.f) & 0xffffu; }
__device__ __forceinline__ float bflo(unsigned w) { return __uint_as_float(w << 16); }
__device__ __forceinline__ float bfhi(unsigned w) { return __uint_as_float(w & 0xffff0000u); }
__device__ __forceinline__ float bf1(bf16_t b) { return __uint_as_float(((unsigned)b) << 16); }
#define DPP_ADD(v, ctrl) ((v) + __builtin_bit_cast(float, __builtin_amdgcn_update_dpp(0, __builtin_bit_cast(int, (v)), (ctrl), 0xf, 0xf, true)))
__device__ __forceinline__ float row16_sum(float v) {
    v = DPP_ADD(v, 0xB1); v = DPP_ADD(v, 0x4E); v = DPP_ADD(v, 0x141); v = DPP_ADD(v, 0x140); return v;
}
__device__ __forceinline__ float wave_sum(float v) { v = row16_sum(v); v += __shfl_xor(v, 16); v += __shfl_xor(v, 32); return v; }
__device__ __forceinline__ float siluf(float x) { return x * __builtin_amdgcn_rcpf(1.f + __expf(-x)); }
__device__ __forceinline__ float sigmoidf(float x) { return __builtin_amdgcn_rcpf(1.f + __expf(-x)); }
__device__ __forceinline__ float softplusf(float x) { return fmaxf(x, 0.f) + log1pf(__expf(-fabsf(x))); }
__device__ __forceinline__ float rnd_fp8(float x) { const int p = __builtin_amdgcn_cvt_pk_fp8_f32(x, x, 0, false); return __builtin_amdgcn_cvt_f32_fp8(p, 0); }
__device__ __forceinline__ unsigned pk4_fp8(float a, float b, float c, float d) { int p = __builtin_amdgcn_cvt_pk_fp8_f32(a, b, 0, false); p = __builtin_amdgcn_cvt_pk_fp8_f32(c, d, p, true); return (unsigned)p; }
#define LDS_WAIT() asm volatile("s_waitcnt lgkmcnt(0)" ::: "memory")

namespace pg8 {
constexpr int BM = 256, BK = 64, HALF = 128, HTB = HALF * BK * 2, STAGE_BYTES = 8 * HTB;
__device__ __forceinline__ int lds_byte(int r, int c) { const int st = (r >> 4) * 2 + (c >> 5), rr = r & 15, cc = c & 31, ob = rr * 64 + cc * 2; return st * 1024 + (ob ^ (((ob >> 9) & 1) << 5)); }
__device__ __forceinline__ void stage_rc(int b, int& R, int& C) { const int st = b / 1024, sb = b % 1024, swz = sb ^ (((sb >> 9) & 1) << 5); R = (st >> 1) * 16 + swz / 64; C = (st & 1) * 32 + (swz % 64) / 2; }

struct Unit { int pm, pn, pb, ak; };
struct Gemm { const bf16_t* A; const bf16_t* Bt; int lda, K; const int* idx; };

#ifndef PG8_SP2
#define PG8_SP2 true
#endif
#ifndef PG8_ALIGN
#define PG8_ALIGN true
#endif
typedef int v8i32 __attribute__((ext_vector_type(8)));
__device__ __forceinline__ v8i32 cat8(const bf16x8 lo, const bf16x8 hi) { const u32x4 a = __builtin_bit_cast(u32x4, lo), b = __builtin_bit_cast(u32x4, hi); return (v8i32){(int)a.x, (int)a.y, (int)a.z, (int)a.w, (int)b.x, (int)b.y, (int)b.z, (int)b.w}; }
template <class Epi, class Sched, bool FP8 = false, bool GATHER = false, bool ALIGN_EPI = PG8_ALIGN, bool SP2 = PG8_SP2>
__device__ __forceinline__ void gemm_phase(LAS unsigned char* lds, const Gemm g, const Sched& S, const Epi& E) {
    constexpr int ES = FP8 ? 1 : 2;
    int tid = threadIdx.x; asm volatile("" : "+v"(tid));
    const int wid = __builtin_amdgcn_readfirstlane(tid >> 6), lane = tid & 63, wr = wid >> 2, wc = wid & 3, fr = lane & 15, fq = lane >> 4;
    int K = g.K, lda = g.lda; asm volatile("" : "+s"(K), "+s"(lda));
    const int nt = K * ES / (BK * 2);
    unsigned voffA[2], voffB[2];
#pragma unroll
    for (int i = 0; i < 2; ++i) { int R, C; stage_rc(tid * 16 + i * 8192, R, C); voffA[i] = (unsigned)(R * lda * ES + C * 2); voffB[i] = (unsigned)(R * K * ES + C * 2); }
    const size_t kstep = (size_t)(BK * 2);
    const size_t hsA = (size_t)HALF * lda * ES, hsB = (size_t)HALF * K * ES;
    const unsigned ldsw = (unsigned)wid * 1024u;
    const int aoff0 = FP8 ? lds_byte(wr * 64 + fr, fq * 16) : lds_byte(wr * 64 + fr, fq * 8), aoff1 = FP8 ? aoff0 + 16 : aoff0 + 1024;
    const int boff0 = FP8 ? lds_byte(wc * 32 + fr, fq * 16) : lds_byte(wc * 32 + fr, fq * 8), boff1 = FP8 ? boff0 + 16 : boff0 + 1024;
#define PG8_SA(b, h) (((b) * 2 + (h)) * HTB)
#define PG8_SB(b, h) ((4 + (b) * 2 + (h)) * HTB)
#define PG8_STAGE(bufoff, gbase, voff) do { _Pragma("unroll") for (int _i = 0; _i < 2; ++_i) \
        __builtin_amdgcn_global_load_lds((const unsigned*)((const char*)(gbase) + (voff)[_i]), (LAS unsigned*)(lds + (bufoff) + ldsw + _i * 8192), 16, 0, 0); } while (0)
    unsigned voffAc[2][2], voffAn[2][2];
#define PG8_GOFF(dst, u) do { if constexpr (GATHER) { const int _e = (u).pm >> 3, _r0 = ((u).pm & 7) * 256; _Pragma("unroll") for (int _h = 0; _h < 2; ++_h) _Pragma("unroll") for (int _i = 0; _i < 2; ++_i) { \
        int _R, _C; stage_rc(tid * 16 + _i * 8192, _R, _C); const int _r = _r0 + 128 * _h + _R, _b = _r >> 9, _s = _r & 511; \
        const int _tok = g.idx[(_b * 16 + _e) * 512 + _s]; dst[_h][_i] = (unsigned)((_b * 4096 + _tok) * lda * ES + _C * 2); } } } while (0)
#define PG8_STAGE_A(bufoff, gbase, h, usenext) do { if constexpr (GATHER) { _Pragma("unroll") for (int _i = 0; _i < 2; ++_i) \
        __builtin_amdgcn_global_load_lds((const unsigned*)((const char*)(gbase) + ((usenext) ? voffAn[h][_i] : voffAc[h][_i])), (LAS unsigned*)(lds + (bufoff) + ldsw + _i * 8192), 16, 0, 0); } \
        else { PG8_STAGE(bufoff, (gbase) + (h) * hsA, voffA); } } while (0)
#define PG8_LD2(dst, off0, off1) do { if constexpr (FP8) { dst.v = *(const LAS v8i32*)(lds + (off0)); } else { const u32x4 _lo = *(const LAS u32x4*)(lds + (off0)), _hi = *(const LAS u32x4*)(lds + (off1)); \
        dst.v = (v8i32){(int)_lo.x, (int)_lo.y, (int)_lo.z, (int)_lo.w, (int)_hi.x, (int)_hi.y, (int)_hi.z, (int)_hi.w}; } } while (0)
#define PG8_LDA(dst, b, h) do { if constexpr (FP8) { _Pragma("unroll") for (int m = 0; m < 4; ++m) PG8_INS8(A32, m, *(const LAS v8i32*)(lds + PG8_SA(b, h) + aoff0 + m * 2048)); } \
        else { _Pragma("unroll") for (int m = 0; m < 4; ++m) PG8_LD2(dst[m], PG8_SA(b, h) + aoff0 + m * 2048, PG8_SA(b, h) + aoff1 + m * 2048); } } while (0)
#define PG8_LDB(dst, b, h) do { if constexpr (FP8) { _Pragma("unroll") for (int n = 0; n < 2; ++n) PG8_INS8(B32, 2 * (h) + n, *(const LAS v8i32*)(lds + PG8_SB(b, h) + boff0 + n * 2048)); } \
        else { _Pragma("unroll") for (int n = 0; n < 2; ++n) PG8_LD2(dst[n], PG8_SB(b, h) + boff0 + n * 2048, PG8_SB(b, h) + boff1 + n * 2048); } } while (0)
#define PG8_MMA(ai, bj, At, Bt) do { __builtin_amdgcn_s_setprio(1); _Pragma("unroll") for (int m = 0; m < 4; ++m) _Pragma("unroll") for (int n = 0; n < 2; ++n) { \
        if constexpr (FP8) { const v8i32 _b = PG8_SUB8(B32, 2 * (bj) + n), _a = PG8_SUB8(A32, m); \
            asm volatile("v_mfma_scale_f32_16x16x128_f8f6f4 %0, %1, %2, %0, %3, %3 op_sel_hi:[0,0,0]" : "+v"(acc[ai][bj][m][n]) : "v"(_b), "v"(_a), "v"(sc1)); } \
        else { acc[ai][bj][m][n] = __builtin_amdgcn_mfma_f32_16x16x32_bf16(Bt[n].lo(), At[m].lo(), acc[ai][bj][m][n], 0, 0, 0); acc[ai][bj][m][n] = __builtin_amdgcn_mfma_f32_16x16x32_bf16(Bt[n].hi(), At[m].hi(), acc[ai][bj][m][n], 0, 0, 0); } } \
        __builtin_amdgcn_s_setprio(0); } while (0)
#define PG8_WAIT_V(n) asm volatile("s_waitcnt vmcnt(" #n ")" ::: "memory")
#define PG8_WAIT_L(n) asm volatile("s_waitcnt lgkmcnt(" #n ")" ::: "memory")
#define PG8_BAR __builtin_amdgcn_s_barrier()
#define PG8_SCHED __builtin_amdgcn_sched_barrier(0)
    Unit cur, nxt; int ui = 0;
    if (!S.next(0, cur)) return;
    f32x4 acc[2][2][4][2];
#pragma unroll
    for (int a = 0; a < 2; ++a)
#pragma unroll
        for (int b = 0; b < 2; ++b)
#pragma unroll
            for (int m = 0; m < 4; ++m)
#pragma unroll
                for (int n = 0; n < 2; ++n) acc[a][b][m][n] = (f32x4){0.f, 0.f, 0.f, 0.f};
    struct Frag2 { v8i32 v;
        __device__ __forceinline__ bf16x8 lo() const { const u32x4 t = {(unsigned)v[0], (unsigned)v[1], (unsigned)v[2], (unsigned)v[3]}; return __builtin_bit_cast(bf16x8, t); }
        __device__ __forceinline__ bf16x8 hi() const { const u32x4 t = {(unsigned)v[4], (unsigned)v[5], (unsigned)v[6], (unsigned)v[7]}; return __builtin_bit_cast(bf16x8, t); } };
    Frag2 At[4], B0[2], B1[2];
    typedef int v32i32 __attribute__((ext_vector_type(32)));
    int sc1 = 0x7f7f7f7f; asm volatile("" : "+v"(sc1));
    v32i32 A32, B32;
#define PG8_SUB8(V, i) ((v8i32){V[8 * (i)], V[8 * (i) + 1], V[8 * (i) + 2], V[8 * (i) + 3], V[8 * (i) + 4], V[8 * (i) + 5], V[8 * (i) + 6], V[8 * (i) + 7]})
#define PG8_INS8(V, i, X) do { const v8i32 _x = (X); _Pragma("unroll") for (int _e = 0; _e < 8; ++_e) V[8 * (i) + _e] = _x[_e]; } while (0)
    const char* cA = GATHER ? (const char*)g.A : (const char*)g.A + ((size_t)cur.pm * BM * lda + cur.ak) * ES; const char* cB = (const char*)g.Bt + (size_t)cur.pb * BM * K * ES;
    PG8_GOFF(voffAc, cur);
    if constexpr (SP2) {
        PG8_STAGE(PG8_SB(0, 0), cB, voffB); PG8_STAGE(PG8_SB(0, 1), cB + hsB, voffB); PG8_STAGE_A(PG8_SA(0, 0), cA, 0, false); PG8_STAGE_A(PG8_SA(0, 1), cA, 1, false);
        if (wr == 1) PG8_BAR;
        PG8_WAIT_V(2); PG8_BAR;
        PG8_STAGE(PG8_SB(1, 0), cB + kstep, voffB); PG8_STAGE_A(PG8_SA(1, 0), cA + kstep, 0, false); PG8_STAGE(PG8_SB(1, 1), cB + hsB + kstep, voffB);
        PG8_WAIT_V(6); PG8_BAR;
    } else {
        PG8_STAGE(PG8_SB(0, 0), cB, voffB); PG8_STAGE_A(PG8_SA(0, 0), cA, 0, false); PG8_STAGE(PG8_SB(0, 1), cB + hsB, voffB); PG8_STAGE_A(PG8_SA(0, 1), cA, 1, false);
        if (wr == 1) PG8_BAR;
        PG8_WAIT_V(4); PG8_BAR;
        PG8_STAGE(PG8_SB(1, 0), cB + kstep, voffB); PG8_STAGE_A(PG8_SA(1, 0), cA + kstep, 0, false); PG8_STAGE(PG8_SB(1, 1), cB + hsB + kstep, voffB);
        PG8_WAIT_V(6); PG8_BAR;
    }
    for (;;) {
        const bool has_next = S.next(ui + 1, nxt);
        const char* nA = GATHER ? cA : (has_next ? (const char*)g.A + ((size_t)nxt.pm * BM * lda + nxt.ak) * ES : cA); const char* nB = has_next ? (const char*)g.Bt + (size_t)nxt.pb * BM * K * ES : cB;
        if (has_next) PG8_GOFF(voffAn, nxt); else { _Pragma("unroll") for (int _h = 0; _h < 2; ++_h) _Pragma("unroll") for (int _i = 0; _i < 2; ++_i) voffAn[_h][_i] = voffAc[_h][_i]; }
#pragma unroll 1
        for (int t = 0; t < nt; t += 2) {
            const bool last = (t == nt - 2);
            const char* a1 = cA + (size_t)(t + 1) * kstep;
            const char* a2 = last ? nA : cA + (size_t)(t + 2) * kstep; const char* b2 = last ? nB : cB + (size_t)(t + 2) * kstep;
            const char* a3 = a2 + kstep; const char* b3 = b2 + kstep;
            if constexpr (SP2) {
            PG8_LDB(B0, 0, 0); PG8_LDB(B1, 0, 1); PG8_SCHED; PG8_LDA(At, 0, 0); PG8_STAGE_A(PG8_SA(1, 1), a1, 1, false);
            PG8_WAIT_V(8); PG8_WAIT_L(0); PG8_BAR; PG8_MMA(0, 0, At, B0); PG8_MMA(0, 1, At, B1); PG8_BAR; PG8_SCHED;
            PG8_LDA(At, 0, 1); PG8_STAGE(PG8_SB(0, 0), b2, voffB); PG8_STAGE(PG8_SB(0, 1), b2 + hsB, voffB); PG8_STAGE_A(PG8_SA(0, 0), a2, 0, last);
            PG8_WAIT_V(8); PG8_WAIT_L(0); PG8_BAR; PG8_MMA(1, 0, At, B0); PG8_MMA(1, 1, At, B1); PG8_BAR; PG8_SCHED;
            PG8_LDB(B0, 1, 0); PG8_LDB(B1, 1, 1); PG8_SCHED; PG8_LDA(At, 1, 0); PG8_STAGE_A(PG8_SA(0, 1), a2, 1, last);
            PG8_WAIT_V(8); PG8_WAIT_L(0); PG8_BAR; PG8_MMA(0, 0, At, B0); PG8_MMA(0, 1, At, B1); PG8_BAR; PG8_SCHED;
            PG8_LDA(At, 1, 1); PG8_STAGE(PG8_SB(1, 0), b3, voffB); PG8_STAGE(PG8_SB(1, 1), b3 + hsB, voffB); PG8_STAGE_A(PG8_SA(1, 0), a3, 0, last);
            PG8_WAIT_V(8); PG8_WAIT_L(0); PG8_BAR; PG8_MMA(1, 0, At, B0); PG8_MMA(1, 1, At, B1); PG8_BAR; PG8_SCHED;
            } else {
            PG8_LDB(B0, 0, 0); PG8_SCHED; PG8_LDA(At, 0, 0); PG8_STAGE_A(PG8_SA(1, 1), a1, 1, false);
            PG8_WAIT_L(8); PG8_BAR; PG8_WAIT_L(0); PG8_MMA(0, 0, At, B0); PG8_BAR; PG8_SCHED;
            PG8_LDB(B1, 0, 1); PG8_STAGE(PG8_SB(0, 0), b2, voffB);
            PG8_BAR; PG8_WAIT_L(0); PG8_MMA(0, 1, At, B1); PG8_BAR;
            PG8_LDA(At, 0, 1); PG8_STAGE_A(PG8_SA(0, 0), a2, 0, last);
            PG8_BAR; PG8_WAIT_L(0); PG8_MMA(1, 0, At, B0); PG8_BAR; PG8_SCHED;
            PG8_STAGE(PG8_SB(0, 1), b2 + hsB, voffB);
            PG8_WAIT_V(6); PG8_BAR; PG8_MMA(1, 1, At, B1); PG8_BAR;
            PG8_LDB(B0, 1, 0); PG8_SCHED; PG8_LDA(At, 1, 0); PG8_STAGE_A(PG8_SA(0, 1), a2, 1, last);
            PG8_WAIT_L(8); PG8_BAR; PG8_WAIT_L(0); PG8_MMA(0, 0, At, B0); PG8_BAR; PG8_SCHED;
            PG8_LDB(B1, 1, 1); PG8_STAGE(PG8_SB(1, 0), b3, voffB);
            PG8_BAR; PG8_WAIT_L(0); PG8_MMA(0, 1, At, B1); PG8_BAR;
            PG8_LDA(At, 1, 1); PG8_STAGE_A(PG8_SA(1, 0), a3, 0, last);
            PG8_BAR; PG8_WAIT_L(0); PG8_MMA(1, 0, At, B0); PG8_BAR; PG8_SCHED;
            PG8_STAGE(PG8_SB(1, 1), b3 + hsB, voffB);
            PG8_WAIT_V(6); PG8_BAR; PG8_MMA(1, 1, At, B1); PG8_BAR;
            }
        }
        if constexpr (ALIGN_EPI) { if (wr == 0) PG8_BAR; }
        if constexpr (FP8) asm volatile("s_nop 15\n\ts_nop 15" ::: "memory");
        E(acc, cur, wr, wc, fr, fq);
        if (!has_next) break;
#pragma unroll
        for (int a = 0; a < 2; ++a)
#pragma unroll
            for (int b = 0; b < 2; ++b)
#pragma unroll
                for (int m = 0; m < 4; ++m)
#pragma unroll
                    for (int n = 0; n < 2; ++n) acc[a][b][m][n] = (f32x4){0.f, 0.f, 0.f, 0.f};
        cur = nxt; cA = nA; cB = nB; ++ui;
#pragma unroll
        for (int _h = 0; _h < 2; ++_h)
#pragma unroll
            for (int _i = 0; _i < 2; ++_i) voffAc[_h][_i] = voffAn[_h][_i];
        if constexpr (ALIGN_EPI) { if (wr == 1) PG8_BAR; }
    }
    PG8_WAIT_V(0);
    if constexpr (!ALIGN_EPI) { if (wr == 0) PG8_BAR; }
    PG8_BAR;
#undef PG8_SA
#undef PG8_SB
#undef PG8_STAGE
#undef PG8_LDA
#undef PG8_LDB
#undef PG8_MMA
#undef PG8_WAIT_V
#undef PG8_WAIT_L
#undef PG8_BAR
#undef PG8_SCHED
#undef PG8_GOFF
#undef PG8_STAGE_A
#undef PG8_SUB8
#undef PG8_INS8
}

struct DenseOrder {
    int nM, nN, nwg, G, c;
    __device__ __forceinline__ void init(int nM_, int nN_, int G_, int c_) { nM = nM_; nN = nN_; nwg = nM * nN; G = G_; c = c_; }
    __device__ __forceinline__ bool next(int i, Unit& u) const {
        const long L = (long)i * G + c; if (L >= nwg) return false;
        int wgid = (int)L; { const int q = nwg / 8, r = nwg % 8, xcd = wgid % 8, off = wgid / 8; wgid = (xcd < r ? xcd * (q + 1) : r * (q + 1) + (xcd - r) * q) + off; }
        const int nig = 8 * nN, gid = wgid / nig, fm = gid * 8, gsz = (nM - fm) < 8 ? (nM - fm) : 8;
        u.pm = fm + ((wgid % nig) % gsz); u.pn = (wgid % nig) / gsz; u.pb = u.pn; u.ak = 0; return true;
    }
};
struct MoeUpOrder {
    int G, c;
    __device__ __forceinline__ bool next(int i, Unit& u) const {
        const int L = i * G + c; if (L >= 2048) return false;
        const int r = L / 256, cc = L % 256, x = cc % 8, j = cc / 8;
        const int e = 2 * x + (r >> 2); u.pm = e * 8 + (j & 7); u.pn = 4 * (r & 3) + (j >> 3); u.pb = e * 16 + u.pn; u.ak = 0; return true;
    }
};
struct MoeDownOrder {
    int G, c;
    __device__ __forceinline__ bool next(int i, Unit& u) const {
        const int L = i * G + c; if (L >= 512) return false;
        const int r = L / 256, cc = L % 256, x = cc % 8, j = cc / 8;
        const int e = 8 * r + x; u.pm = e * 8 + (j & 7); u.pn = j >> 3; u.pb = e * 4 + u.pn; u.ak = 0; return true;
    }
};
struct PoolOrder {
    int G, c;
    __device__ __forceinline__ bool next(int i, Unit& u) const {
        const int L = i * G + c; if (L >= 256) return false;
        const int x = L % 8, j = L / 8; u.pm = x * 8 + (j & 7); u.pn = j >> 3; u.pb = u.pn; u.ak = u.pn * 256; return true;
    }
};

struct EpiInProj {
    bf16_t* P; float* AB;
    __device__ __forceinline__ void operator()(const f32x4 (&acc)[2][2][4][2], const Unit& u, int wr, int wc, int fr, int fq) const {
        const int row0 = u.pm * BM + wr * 64 + fr;
        if (u.pn < 16) {
            const int col0 = u.pn * BM + wc * 32 + 4 * fq;
#pragma unroll
            for (int ai = 0; ai < 2; ++ai)
#pragma unroll
                for (int m = 0; m < 4; ++m) { bf16_t* rowp = P + (size_t)(row0 + ai * HALF + m * 16) * NP + col0;
#pragma unroll
                    for (int bj = 0; bj < 2; ++bj)
#pragma unroll
                        for (int n = 0; n < 2; ++n) { const f32x4 v = acc[ai][bj][m][n]; u32x2 w; w.x = pk2(v[0], v[1]); w.y = pk2(v[2], v[3]); *(u32x2*)(rowp + bj * HALF + n * 16) = w; } }
        } else if (wc == 0) {
#pragma unroll
            for (int ai = 0; ai < 2; ++ai)
#pragma unroll
                for (int m = 0; m < 4; ++m) { float* rowp = AB + (size_t)(row0 + ai * HALF + m * 16) * 32 + 4 * fq;
#pragma unroll
                    for (int n = 0; n < 2; ++n) *(f32x4*)(rowp + n * 16) = acc[ai][0][m][n]; }
        }
    }
};
struct EpiOutProj {
    const float* X; bf16_t* H; const float* gate;
    __device__ __forceinline__ void operator()(const f32x4 (&acc)[2][2][4][2], const Unit& u, int wr, int wc, int fr, int fq) const {
        const int row0 = u.pm * BM + wr * 64 + fr, col0 = u.pn * BM + wc * 32 + 4 * fq;
        const float* gp = gate + (size_t)(u.pm * BM / T) * 6144 + col0;
        f32x4 gv[2][2];
#pragma unroll
        for (int bj = 0; bj < 2; ++bj)
#pragma unroll
            for (int n = 0; n < 2; ++n) gv[bj][n] = *(const f32x4*)(gp + bj * HALF + n * 16);
#pragma unroll
        for (int ai = 0; ai < 2; ++ai)
#pragma unroll
            for (int m = 0; m < 4; ++m) { const size_t off = (size_t)(row0 + ai * HALF + m * 16) * D + col0;
#pragma unroll
                for (int bj = 0; bj < 2; ++bj)
#pragma unroll
                    for (int n = 0; n < 2; ++n) { const f32x4 xv = *(const f32x4*)(X + off + bj * HALF + n * 16); const f32x4 hv = xv + gv[bj][n] * acc[ai][bj][m][n];
                        u32x2 w; w.x = pk2(hv[0], hv[1]); w.y = pk2(hv[2], hv[3]); *(u32x2*)(H + off + bj * HALF + n * 16) = w; }
                asm volatile("" ::: "memory"); }
    }
};
struct EpiSwiglu {
    unsigned char* HID;
    __device__ __forceinline__ void operator()(const f32x4 (&acc)[2][2][4][2], const Unit& u, int wr, int wc, int fr, int fq) const {
        asm volatile("" : "+v"(fr), "+v"(fq));
        const int row0 = u.pm * BM + wr * 64 + fr, col0 = u.pn * HALF + wc * 32 + 4 * fq;
#pragma unroll
        for (int ai = 0; ai < 2; ++ai)
#pragma unroll
            for (int m = 0; m < 4; ++m) { unsigned char* rowp = HID + (size_t)(row0 + ai * HALF + m * 16) * DF + col0;
#pragma unroll
                for (int n = 0; n < 2; ++n) { const f32x4 g = acc[ai][0][m][n], up = acc[ai][1][m][n]; float h[4];
#pragma unroll
                    for (int j = 0; j < 4; ++j) h[j] = siluf(g[j] * 0.03125f) * (up[j] * 0.03125f);
                    *(unsigned*)(rowp + n * 16) = pk4_fp8(h[0], h[1], h[2], h[3]); } }
    }
};
struct EpiDown {
    bf16_t* YS; const float* gates;
    __device__ __forceinline__ void operator()(const f32x4 (&acc)[2][2][4][2], const Unit& u, int wr, int wc, int fr, int fq) const {
        asm volatile("" : "+v"(fr), "+v"(fq));
        const int row0 = u.pm * BM + wr * 64 + fr, col0 = u.pn * BM + wc * 32 + 4 * fq;
#pragma unroll
        for (int ai = 0; ai < 2; ++ai)
#pragma unroll
            for (int m = 0; m < 4; ++m) { const int row = row0 + ai * HALF + m * 16; const float gt = gates[row] * 0.03125f; bf16_t* rowp = YS + (size_t)row * D + col0;
#pragma unroll
                for (int bj = 0; bj < 2; ++bj)
#pragma unroll
                    for (int n = 0; n < 2; ++n) { const f32x4 v = acc[ai][bj][m][n] * gt; u32x2 w; w.x = pk2(v[0], v[1]); w.y = pk2(v[2], v[3]); *(u32x2*)(rowp + bj * HALF + n * 16) = w; } }
    }
};
struct EpiPool {
    bf16_t* H; const float* gate; const float* scale;
    __device__ __forceinline__ void operator()(const f32x4 (&acc)[2][2][4][2], const Unit& u, int wr, int wc, int fr, int fq) const {
        const int row0 = u.pm * BM + wr * 64 + fr, col0 = u.pn * BM + wc * 32 + 4 * fq;
        const float* gp = gate + (size_t)(u.pm * BM / T) * 6144 + col0;
        f32x4 gv[2][2];
#pragma unroll
        for (int bj = 0; bj < 2; ++bj)
#pragma unroll
            for (int n = 0; n < 2; ++n) gv[bj][n] = *(const f32x4*)(gp + bj * HALF + n * 16) * *(const f32x4*)(scale + col0 + bj * HALF + n * 16);
#pragma unroll
        for (int ai = 0; ai < 2; ++ai)
#pragma unroll
            for (int m = 0; m < 4; ++m) { const size_t off = (size_t)(row0 + ai * HALF + m * 16) * D + col0;
#pragma unroll
                for (int bj = 0; bj < 2; ++bj)
#pragma unroll
                    for (int n = 0; n < 2; ++n) { bf16_t* p = H + off + bj * HALF + n * 16; const u32x2 hw = *(const u32x2*)p; const f32x4 hv = (f32x4){bflo(hw.x), bfhi(hw.x), bflo(hw.y), bfhi(hw.y)} + gv[bj][n] * acc[ai][bj][m][n];
                        u32x2 w; w.x = pk2(hv[0], hv[1]); w.y = pk2(hv[2], hv[3]); *(u32x2*)p = w; }
                asm volatile("" ::: "memory"); }
    }
};
}


#define XB_TMO      128
#define XB_XCNT(j)  (256  + 64 * (j))
#define XB_XSUB(j)  (1280 + 64 * (j))
#define XB_XGEN(j)  (2304 + 64 * (j))
#define XB_TOP      3328
#define XB_TOPGEN   3392
#define XCD_BAR_WORDS 3456
#define XB_SPIN_CAP (1u << 20)
__device__ __forceinline__ unsigned xb_ld(unsigned* p)              { return __hip_atomic_load(p, __ATOMIC_RELAXED, __HIP_MEMORY_SCOPE_AGENT); }
__device__ __forceinline__ unsigned xb_add(unsigned* p, unsigned v) { return __hip_atomic_fetch_add(p, v, __ATOMIC_RELAXED, __HIP_MEMORY_SCOPE_AGENT); }
__device__ __forceinline__ unsigned xb_xcc_id() { return (unsigned)__builtin_amdgcn_s_getreg((3 << 11) | 20) & 0xFu; }
#define XB_SPIN(cond, bar) do { unsigned _sp = 0; while (cond) { __builtin_amdgcn_s_sleep(1); \
    if ((++_sp & 255u) == 0u) { if (xb_ld(&(bar)[XB_TMO])) break; if (_sp > XB_SPIN_CAP) { atomicAdd(&(bar)[XB_TMO], 1u); break; } } } } while (0)
struct XcdBarrier { unsigned* bar; unsigned x; volatile LAS unsigned* st; };
__device__ __forceinline__ XcdBarrier xcd_barrier_post(unsigned* bar, volatile LAS unsigned* st) {
    XcdBarrier b; b.bar = bar; b.x = xb_xcc_id(); b.st = st;
    if (threadIdx.x == 0) (void)xb_add(&bar[XB_XCNT(b.x)], 1u);
    return b;
}
__device__ __forceinline__ void xcd_barrier_complete(unsigned* bar, unsigned x, unsigned& nloc, unsigned& nx) {
    const unsigned G = gridDim.x * gridDim.y * gridDim.z;
    unsigned sum, cnt, mine, sp = 0u;
    for (;;) {
        sum = 0u; cnt = 0u; mine = 0u;
#pragma unroll
        for (unsigned j = 0; j < 16; ++j) { const unsigned c = xb_ld(&bar[XB_XCNT(j)]); sum += c; cnt += (c > 0u) ? 1u : 0u; mine = (j == x) ? c : mine; }
        if (sum == G) break;
        __builtin_amdgcn_s_sleep(1);
        if ((++sp & 255u) == 0u) { if (xb_ld(&bar[XB_TMO])) break; if (sp > XB_SPIN_CAP) { atomicAdd(&bar[XB_TMO], 1u); break; } }
    }
    nloc = mine > 0u ? mine : 1u; nx = cnt > 0u ? cnt : 1u;
}
__device__ __forceinline__ void xcd_barrier(const XcdBarrier& b) {
    asm volatile("s_waitcnt vmcnt(0)" ::: "memory");
    __syncthreads();
    if (threadIdx.x == 0) {
        unsigned* bar = b.bar;
        __builtin_amdgcn_s_waitcnt(0);
        unsigned nloc = b.st[0], nx = b.st[1];
        if (nloc == 0u) { xcd_barrier_complete(bar, b.x, nloc, nx); b.st[0] = nloc; b.st[1] = nx; }
        const unsigned old = xb_add(&bar[XB_XSUB(b.x)], 1u);
        const unsigned gen = old / nloc;
        if (old + 1u == (gen + 1u) * nloc) {
            __builtin_amdgcn_fence(__ATOMIC_RELEASE, "agent");
            asm volatile("s_waitcnt vmcnt(0)" ::: "memory");
            const unsigned og = xb_add(&bar[XB_TOP], 1u);
            const unsigned tg = og / nx;
            if (og + 1u == (tg + 1u) * nx) xb_add(&bar[XB_TOPGEN], 1u);
            else XB_SPIN(xb_ld(&bar[XB_TOPGEN]) == tg, bar);
            __builtin_amdgcn_fence(__ATOMIC_ACQUIRE, "agent");
            xb_add(&bar[XB_XGEN(b.x)], 1u);
            asm volatile("s_waitcnt vmcnt(0)" ::: "memory");
        } else {
            XB_SPIN(xb_ld(&bar[XB_XGEN(b.x)]) == gen, bar);
            __builtin_amdgcn_fence(__ATOMIC_ACQUIRE, "agent");
            asm volatile("s_waitcnt vmcnt(0)" ::: "memory");
        }
    }
    __syncthreads();
}
constexpr int MISC_OFF = LDS_BYTES - 128;

struct Args { const float* in[21]; float* out; unsigned char* ws; int ph_lo, ph_hi; };
enum { I_X = 0, I_C, I_CTX, I_CCTX, I_WMOD, I_BMOD, I_GMIX, I_GFFN, I_WIN, I_CONVW, I_ALOG, I_DTB, I_OGAIN, I_WOUT, I_POOLW, I_POOLS, I_WR, I_WG, I_WU, I_WD, I_FING };

struct Frame {
    LAS unsigned char* lds;
    int tid, lane, wave, G, vcu;
    const float* in[21]; float* out; unsigned char* ws;
};

__device__ __forceinline__ void tr_tile(const float* __restrict__ src, int ld_src, int n_valid, bf16_t* dst_row0, int ld_dst, int k0, LAS unsigned char* scr, int lane, float q8 = 0.f) {
    const int nq = lane & 15, g = lane >> 4;
    f32x4 v[2][8];
    const bool ok = 4 * nq < n_valid;
#pragma unroll
    for (int i1 = 0; i1 < 2; ++i1)
#pragma unroll
        for (int i2 = 0; i2 < 8; ++i2) { const int k = 32 * i1 + 8 * g + i2;
            v[i1][i2] = ok ? *(const f32x4*)(src + (size_t)(k0 + k) * ld_src + 4 * nq) : (f32x4){0.f, 0.f, 0.f, 0.f}; }
#ifdef EMU_FP8
    if (q8 > 0.f) { const float iq = 1.f / q8;
#pragma unroll
        for (int i1 = 0; i1 < 2; ++i1)
#pragma unroll
            for (int i2 = 0; i2 < 8; ++i2)
#pragma unroll
                for (int j = 0; j < 4; ++j) v[i1][i2][j] = rnd_fp8(v[i1][i2][j] * q8) * iq; }
#endif
#pragma unroll
    for (int j = 0; j < 4; ++j)
#pragma unroll
        for (int i1 = 0; i1 < 2; ++i1) {
            u32x4 w; w.x = pk2(v[i1][0][j], v[i1][1][j]); w.y = pk2(v[i1][2][j], v[i1][3][j]); w.z = pk2(v[i1][4][j], v[i1][5][j]); w.w = pk2(v[i1][6][j], v[i1][7][j]);
            const int n = 4 * nq + j, c = 4 * i1 + g;
            *(LAS u32x4*)(scr + n * 128 + ((c ^ (nq & 7)) * 16)) = w; }
    LDS_WAIT();
#pragma unroll
    for (int it = 0; it < 8; ++it) { const int n = (lane >> 3) + 8 * it, c = lane & 7;
        const u32x4 w = *(const LAS u32x4*)(scr + n * 128 + ((c ^ ((n >> 2) & 7)) * 16));
        *(u32x4*)(dst_row0 + (size_t)n * ld_dst + k0 + 8 * c) = w; }
    LDS_WAIT();
}

__device__ __forceinline__ void tr_tile8(const float* __restrict__ src, int ld_src, unsigned char* dst_row0, int ld_dst, int k0, LAS unsigned char* scr, int lane) {
    const int nq = lane & 15, g = lane >> 4;
    f32x4 v[4][8];
#pragma unroll
    for (int i1 = 0; i1 < 4; ++i1)
#pragma unroll
        for (int i2 = 0; i2 < 8; ++i2) { const int k = 32 * i1 + 8 * g + i2; v[i1][i2] = __builtin_nontemporal_load((const f32x4*)(src + (size_t)(k0 + k) * ld_src + 4 * nq)); }
#pragma unroll
    for (int j = 0; j < 4; ++j)
#pragma unroll
        for (int i1 = 0; i1 < 4; ++i1) {
            u32x2 w; w.x = pk4_fp8(v[i1][0][j] * 32.f, v[i1][1][j] * 32.f, v[i1][2][j] * 32.f, v[i1][3][j] * 32.f); w.y = pk4_fp8(v[i1][4][j] * 32.f, v[i1][5][j] * 32.f, v[i1][6][j] * 32.f, v[i1][7][j] * 32.f);
            const int n = 4 * nq + j, c = 4 * i1 + g;
            *(LAS u32x2*)(scr + n * 128 + ((((c >> 1) ^ (nq & 7))) << 4) + (c & 1) * 8) = w; }
    LDS_WAIT();
#pragma unroll
    for (int it = 0; it < 8; ++it) { const int n = (lane >> 3) + 8 * it, p = lane & 7;
        const u32x4 w = *(const LAS u32x4*)(scr + n * 128 + ((p ^ ((n >> 2) & 7)) << 4));
        __builtin_nontemporal_store(w, (u32x4*)(dst_row0 + (size_t)n * ld_dst + k0 + 16 * p)); }
    LDS_WAIT();
}

constexpr int TR_SMALL = 16 * 68 + 256 + 64;
__device__ __forceinline__ void tr_small_job(Frame& F, int t, LAS unsigned char* scr) {
    if (t < 1088) { const int nt = t / 16, kt = t % 16; int nv = NPROJ - 64 * nt; nv = nv < 0 ? 0 : (nv > 64 ? 64 : nv);
        tr_tile(F.in[I_WIN] + 64 * nt, NPROJ, nv, (bf16_t*)(F.ws + WS_WIN) + (size_t)64 * nt * D, D, 64 * kt, scr, F.lane); return; }
    t -= 1088;
    if (t < 256) { const int nt = t / 16, kt = t % 16;
        tr_tile(F.in[I_WOUT] + 64 * nt, D, 64, (bf16_t*)(F.ws + WS_WOUT) + (size_t)64 * nt * D, D, 64 * kt, scr, F.lane); return; }
    t -= 256;
    { const int gi = t / 16, nt = (t % 16) / 4, kt = t % 4;
        tr_tile(F.in[I_POOLW] + (size_t)gi * 65536 + 64 * nt, 256, 64, (bf16_t*)(F.ws + WS_POOLW) + (size_t)gi * 65536 + (size_t)64 * nt * 256, 256, 64 * kt, scr, F.lane); }
}
constexpr int TR_MOE = 12288;
#ifndef FILL_CONV
#define FILL_CONV 1
#endif
#ifndef FILL_PREP
#define FILL_PREP 2
#endif
#ifndef FILL_INPROJ
#define FILL_INPROJ 2
#endif
__device__ __forceinline__ void tr_moe_job(Frame& F, int l, int t, LAS unsigned char* scr, int lane) {
    if (t < 8192) { const int e = t / 512, r = t % 512, which = r / 256, r2 = r % 256, nt = r2 / 8, kp = r2 % 8;
        const float* src = F.in[which ? I_WU : I_WG] + (size_t)(l * NE + e) * D * DF + 64 * nt;
        unsigned char* dst = (unsigned char*)(F.ws + WS_WMOE) + (size_t)l * WMOE_LAYER + ((size_t)e * 4096 + (nt >> 1) * 256 + which * 128 + (nt & 1) * 64) * D;
        tr_tile8(src, DF, dst, D, 128 * kp, scr, lane); return; }
    t -= 8192;
    { const int e = t / 256, r = t % 256, nt = r / 16, kp = r % 16;
        const float* src = F.in[I_WD] + (size_t)(l * NE + e) * DF * D + 64 * nt;
        unsigned char* dst = (unsigned char*)(F.ws + WS_W2T) + (size_t)l * WMOE_LAYER + ((size_t)e * D + 64 * nt) * DF;
        tr_tile8(src, D, dst, DF, 128 * kp, scr, lane); }
}

__device__ __forceinline__ void moe_convert_wave(Frame& F, int n, LAS unsigned char* scr) {
    unsigned* ctr = (unsigned*)(F.ws + WS_CTL) + 16384;
    int lane; asm volatile("v_mbcnt_lo_u32_b32 %0, -1, 0\n\tv_mbcnt_hi_u32_b32 %0, -1, %0" : "=v"(lane));
    for (int i = 0; i < n; ++i) {
        unsigned t = 0u;
        if (lane == 0) t = __hip_atomic_fetch_add(ctr, 1u, __ATOMIC_RELAXED, __HIP_MEMORY_SCOPE_AGENT);
        t = (unsigned)__builtin_amdgcn_readfirstlane((int)t);
        if (t >= 2u * TR_MOE) break;
        tr_moe_job(F, t >= (unsigned)TR_MOE, (int)(t >= (unsigned)TR_MOE ? t - TR_MOE : t), scr, lane);
    }
}

__device__ __forceinline__ void mod_item(Frame& F, int item) {
    LAS float* act = (LAS float*)(F.lds + 65536);
    LAS float* part = (LAS float*)(F.lds + 65536 + 20480);
    const int l = item / 96, cgp = item % 96;
    for (int i = F.tid; i < 5 * D; i += NTHR) { const int r = i >> 10, k = i & 1023; const float x = r < 4 ? F.in[I_C][r * D + k] : F.in[I_CCTX][k]; act[i] = siluf(x); }
    __syncthreads();
    const int j = cgp * 64 + F.lane;
    const float* w = F.in[I_WMOD] + (size_t)l * D * 6144 + j;
    float a0 = 0.f, a1 = 0.f, a2 = 0.f, a3 = 0.f, a4 = 0.f;
    const int kb = F.wave * 128;
#pragma unroll 1
    for (int k0 = 0; k0 < 128; k0 += 32) {
        float wv[32];
#pragma unroll
        for (int k = 0; k < 32; ++k) wv[k] = __builtin_nontemporal_load(w + (size_t)(kb + k0 + k) * 6144);
#pragma unroll
        for (int k = 0; k < 32; ++k) { const int kk = kb + k0 + k;
            a0 += act[kk] * wv[k]; a1 += act[D + kk] * wv[k]; a2 += act[2 * D + kk] * wv[k]; a3 += act[3 * D + kk] * wv[k]; a4 += act[4 * D + kk] * wv[k]; } }
    LAS float* pp = part + F.wave * 320 + F.lane;
    pp[0] = a0; pp[64] = a1; pp[128] = a2; pp[192] = a3; pp[256] = a4;
    __syncthreads();
    if (F.tid < 320) { const int r = F.tid >> 6, ln = F.tid & 63; float s = 0.f;
#pragma unroll
        for (int w8 = 0; w8 < 8; ++w8) s += part[w8 * 320 + r * 64 + ln];
        const int jj = cgp * 64 + ln;
        ((float*)(F.ws + WS_MOD))[(size_t)(l * 5 + r) * 6144 + jj] = s + F.in[I_BMOD][l * 6144 + jj]; }
    __syncthreads();
}

__device__ __forceinline__ void load_row(const float* p, int lane, f32x4 (&v)[4]) {
#pragma unroll
    for (int j = 0; j < 4; ++j) v[j] = ((const f32x4*)p)[lane + 64 * j];
}
__device__ __forceinline__ void load_row_bf16(const bf16_t* p, int lane, f32x4 (&v)[4]) {
#pragma unroll
    for (int j = 0; j < 4; ++j) { const u32x2 w = ((const u32x2*)p)[lane + 64 * j]; v[j] = (f32x4){bflo(w.x), bfhi(w.x), bflo(w.y), bfhi(w.y)}; }
}
__device__ __forceinline__ float row_rstd(const f32x4 (&v)[4]) {
    float s = 0.f;
#pragma unroll
    for (int j = 0; j < 4; ++j) s += (v[j][0] * v[j][0] + v[j][1] * v[j][1]) + (v[j][2] * v[j][2] + v[j][3] * v[j][3]);
    return rsqrtf(wave_sum(s) * (1.f / D) + EPS);
}
__device__ __forceinline__ void norm_mod(const f32x4 (&v)[4], float rstd, const float* g, const float* sh, const float* sc, int lane, f32x4 (&y)[4]) {
#pragma unroll
    for (int j = 0; j < 4; ++j) { const f32x4 gv = ((const f32x4*)g)[lane + 64 * j], shv = ((const f32x4*)sh)[lane + 64 * j], scv = ((const f32x4*)sc)[lane + 64 * j];
        y[j] = v[j] * rstd * gv * (1.f + scv) + shv; }
}
__device__ __forceinline__ void store_row_bf16(bf16_t* p, int lane, const f32x4 (&y)[4]) {
#pragma unroll
    for (int j = 0; j < 4; ++j) { u32x2 w; w.x = pk2(y[j][0], y[j][1]); w.y = pk2(y[j][2], y[j][3]); ((u32x2*)p)[lane + 64 * j] = w; }
}

__device__ __forceinline__ void phase_norm0(Frame& F) {
    const float* MOD = (const float*)(F.ws + WS_MOD);
    bf16_t* U = (bf16_t*)(F.ws + WS_U);
    for (int row = F.vcu * NWAVE + F.wave; row < MA; row += F.G * NWAVE) {
        const float* src; int mr;
        if (row < ML) { src = F.in[I_X] + (size_t)row * D; mr = row / T; } else { src = F.in[I_CTX] + (size_t)(row - ML) * D; mr = 4; }
        f32x4 v[4], y[4]; load_row(src, F.lane, v);
        const float rstd = row_rstd(v);
        const float* m = MOD + (size_t)mr * 6144;
        norm_mod(v, rstd, F.in[I_GMIX], m, m + D, F.lane, y);
        store_row_bf16(U + (size_t)row * D, F.lane, y);
    }
}

__device__ __forceinline__ void chunk_rows(int ci, int& row0, int& t0, int& slen) {
    if (ci < 256) { row0 = ci * 64; t0 = (ci & 63) * 64; slen = T; } else { const int cc = ci - 256; row0 = ML + cc * 64; t0 = (cc & 3) * 64; slen = TC; }
}
__device__ __forceinline__ void phase_conv(Frame& F) {
    const bf16_t* P = (const bf16_t*)(F.ws + WS_P);
    bf16_t* QKV = (bf16_t*)(F.ws + WS_QKV);
    bf16_t* KT = (bf16_t*)(F.ws + WS_KT);
    bf16_t* VT = (bf16_t*)(F.ws + WS_VT);
    LAS unsigned* kts = (LAS unsigned*)(F.lds + F.wave * 16896);
    LAS bf16_t* kts16 = (LAS bf16_t*)kts;
    const int lane = F.lane;
    for (int item = F.vcu * NWAVE + F.wave; item < NCHUNK * 24; item += F.G * NWAVE) {
        const int ci = item / 24, slab = item % 24;
        int row0, t0, slen; chunk_rows(ci, row0, t0, slen);
        const int col = slab * 128 + 2 * lane;
        float w0[5], w1[5];
#pragma unroll
        for (int j = 0; j < 5; ++j) { const f32x2 wv = *(const f32x2*)(F.in[I_CONVW] + (size_t)j * NQKV + col); w0[j] = wv[0]; w1[j] = wv[1]; }
        const bf16_t* src = P + (size_t)row0 * NP + col;
        unsigned rowsv[68];
#pragma unroll
        for (int j = 0; j < 68; ++j) { const int tt = j - 2; rowsv[j] = (t0 + tt >= 0 && t0 + tt < slen) ? *(const unsigned*)(src + (long)tt * NP) : 0u; }
        const int kind = slab >> 3;
#pragma unroll 1
        for (int t8 = 0; t8 < 64; t8 += 8) {
#pragma unroll
            for (int q = 0; q < 8; ++q) {
                const int tt = t8 + q;
                float y0 = 0.f, y1 = 0.f;
#pragma unroll
                for (int j = 0; j < 5; ++j) { y0 += w0[j] * bflo(rowsv[q + j]); y1 += w1[j] * bfhi(rowsv[q + j]); }
                y0 = siluf(y0); y1 = siluf(y1);
                if (kind < 2) { const float ss = wave_sum(y0 * y0 + y1 * y1); float sc = rsqrtf(ss + EPS); if (kind == 0) sc *= 0.08838834764831845f; y0 *= sc; y1 *= sc; }
                const unsigned pk = pk2(y0, y1);
                *(unsigned*)(QKV + (size_t)(row0 + tt) * NQKV + col) = pk;
                if (kind >= 1) { kts16[(2 * lane) * 66 + tt] = (bf16_t)(pk & 0xffffu); kts16[(2 * lane + 1) * 66 + tt] = (bf16_t)(pk >> 16); }
            }
#pragma unroll
            for (int j = 0; j < 60; ++j) rowsv[j] = rowsv[j + 8];
        }
        if (kind >= 1) {
            LDS_WAIT();
            unsigned* dst = (unsigned*)((kind == 1 ? KT : VT) + ((size_t)ci * NH + (slab & 7)) * 128 * 64);
#pragma unroll 8
            for (int it = 0; it < 64; ++it) { const int dk = 2 * it + (lane >> 5), dw = lane & 31; dst[dk * 32 + dw] = kts[dk * 33 + dw]; }
            LDS_WAIT();
        }
    }
#ifndef NO_FILL
    if (F.G == 256 && F.vcu * NWAVE + F.wave >= NCHUNK * 24 - 3 * 2048) moe_convert_wave(F, FILL_CONV, (LAS unsigned char*)kts);
#endif
}

__device__ __forceinline__ void chunk_gates(Frame& F, int row0, int h, int dir, int lane, float& gc, float& beta, float& gtot) {
    const float* ab = (const float*)(F.ws + WS_AB) + (size_t)(row0 + lane) * 32 + dir * 16 + h;
    const float a = ab[0], bb = ab[8];
    const float g = -__expf(F.in[I_ALOG][dir * NH + h]) * softplusf(a + F.in[I_DTB][dir * NH + h]);
    beta = sigmoidf(bb);
    float s = g;
#pragma unroll
    for (int o = 1; o < 64; o <<= 1) { const float t = __builtin_bit_cast(float, __builtin_amdgcn_ds_bpermute((lane - o) << 2, __builtin_bit_cast(int, s))); if (lane >= o) s += t; }
    gtot = __builtin_bit_cast(float, __builtin_amdgcn_readlane(__builtin_bit_cast(int, s), 63));
    gc = dir ? (gtot - s + g) : s;
}

template <int V> __device__ __forceinline__ void phase_prep(Frame& F) {
    const bf16_t* QKV = (const bf16_t*)(F.ws + WS_QKV);
    LAS float* As = (LAS float*)(F.lds + F.wave * 17408);
    LAS float* gs = (LAS float*)(F.lds + F.wave * 17408 + 16384);
#pragma unroll 1
    for (int item = F.vcu * NWAVE + F.wave; item < NCHUNK * NH * 2; item += F.G * NWAVE) {
        const int ci = item >> 4, h = (item >> 1) & 7, dir = item & 1;
        int row0, t0, slen; chunk_rows(ci, row0, t0, slen);
        asm volatile("" ::: "memory");
        int lane_v; asm volatile("v_mbcnt_lo_u32_b32 %0, -1, 0\n\tv_mbcnt_hi_u32_b32 %0, -1, %0" : "=v"(lane_v));
        const int lane = lane_v, fr = lane & 15, fq = lane >> 4;
        const int d4 = 4 * (lane_v >> 4) - (lane_v & 15);
        const size_t dt = (size_t)(dir * NCHUNK + ci) * NH + h;
        const bf16_t* KTg = (const bf16_t*)(F.ws + WS_KT) + ((size_t)ci * NH + h) * 8192; const bf16_t* VTg = (const bf16_t*)(F.ws + WS_VT) + ((size_t)ci * NH + h) * 8192;
        {
            bf16x8 kf[4][4], qf[4][4];
#pragma unroll
            for (int mt = 0; mt < 4; ++mt)
#pragma unroll
                for (int ks = 0; ks < 4; ++ks) { const bf16_t* rp = QKV + (size_t)(row0 + 16 * mt + fr) * NQKV + h * 128 + 32 * ks + 8 * fq; kf[mt][ks] = *(const bf16x8*)(rp + 1024); qf[mt][ks] = *(const bf16x8*)rp; }
            float gc, beta, gtot; chunk_gates(F, row0, h, dir, lane, gc, beta, gtot);
            gs[lane] = gc; gs[64 + lane] = beta;
            { float* gcb = (float*)(F.ws + WS_GCB) + dt * 128; gcb[lane] = gc; gcb[64 + lane] = beta; }
            LDS_WAIT();
#pragma unroll
            for (int mi = 0; mi < (V == 3 ? 0 : 4); ++mi)
#pragma unroll
                for (int nj = 0; nj < 4; ++nj) {
                    if (dir == 0 ? (mi < nj) : (mi > nj)) continue;
                    f32x4 acc = {0.f, 0.f, 0.f, 0.f};
#pragma unroll
                    for (int ks = 0; ks < 4; ++ks) acc = __builtin_amdgcn_mfma_f32_16x16x32_bf16(kf[mi][ks], kf[nj][ks], acc, 0, 0, 0);
                    const int j = 16 * nj + fr; const float gj = gs[j];
#pragma unroll
                    for (int r = 0; r < 4; ++r) { const int i = 16 * mi + 4 * fq + r; const float gi = gs[i], bi = gs[64 + i];
                        const bool keep = (mi != nj) || (dir == 0 ? (d4 + r > 0) : (d4 + r < 0));
                        const float val = keep ? bi * acc[r] * __expf(gi - gj) : 0.f;
                        const int il = dir ? 63 - i : i, jl = dir ? 63 - j : j;
                        As[il * 64 + jl] = val; }
                }
            bf16_t* AT = (bf16_t*)(F.ws + WS_ATT) + dt * 4096;
#pragma unroll
            for (int mi = 0; mi < (V == 3 ? 0 : 4); ++mi) {
#pragma unroll
                for (int nj = 0; nj < 4; ++nj) {
                    const bool none = dir == 0 ? (mi < nj) : (mi > nj);
                    f32x4 acc = {0.f, 0.f, 0.f, 0.f};
                    if (!none) {
#pragma unroll
                        for (int ks = 0; ks < 4; ++ks) acc = __builtin_amdgcn_mfma_f32_16x16x32_bf16(kf[nj][ks], qf[mi][ks], acc, 0, 0, 0);
                    }
                    const int i = 16 * mi + fr; const float gi = gs[i];
                    float val[4];
#pragma unroll
                    for (int r = 0; r < 4; ++r) { const int j = 16 * nj + 4 * fq + r; const float gj = gs[j];
                        const bool keep = !none && ((mi != nj) || (dir == 0 ? (d4 + r <= 0) : (d4 + r >= 0)));
                        val[r] = keep ? acc[r] * __expf(gi - gj) : 0.f; }
                    u32x2 w; w.x = pk2(val[0], val[1]); w.y = pk2(val[2], val[3]);
                    *(u32x2*)(AT + i * 64 + 16 * nj + 4 * fq) = w;
                }
            }
        }
        bf16x8 ktf[8][2];
#pragma unroll
        for (int m8 = 0; m8 < 8; ++m8)
#pragma unroll
            for (int ks = 0; ks < 2; ++ks) ktf[m8][ks] = *(const bf16x8*)(KTg + (64 * (m8 >> 2) + 16 * (fr >> 2) + 4 * (m8 & 3) + (fr & 3)) * 64 + 32 * ks + 8 * fq);
        LDS_WAIT();
        asm volatile("" ::: "memory");
        float t[64];
        const float lanef = (float)lane_v;
#pragma unroll
        for (int i = 0; i < 64; ++i) { float s0 = fmaxf(0.f, 1.f - fabsf(lanef - (float)i)), s1 = 0.f, s2 = 0.f, s3 = 0.f;
            asm volatile("" ::: "memory");
#pragma unroll
            for (int j = 0; j < (V == 1 ? 0 : i); ++j) { if (j == 32) asm volatile("" ::: "memory"); const float av = As[i * 64 + j];
                if ((j & 3) == 0) s0 -= av * t[j]; else if ((j & 3) == 1) s1 -= av * t[j]; else if ((j & 3) == 2) s2 -= av * t[j]; else s3 -= av * t[j]; }
            t[i] = (s0 + s1) + (s2 + s3); }
        bf16x8 vtf[8][2];
#pragma unroll
        for (int m8 = 0; m8 < 8; ++m8)
#pragma unroll
            for (int ks = 0; ks < 2; ++ks) vtf[m8][ks] = *(const bf16x8*)(VTg + (16 * m8 + fr) * 64 + 32 * ks + 8 * fq);
        {
            const int co = dir ? 63 - lane : lane;
            const float bco = gs[64 + co], sW = bco * __expf(gs[co]);
            LDS_WAIT();
            asm volatile("" ::: "memory");
            LAS unsigned char* Tl = (LAS unsigned char*)As;
#pragma unroll
            for (int i = 0; i < 64; ++i) { const int io = dir ? 63 - i : i;
                const int off = io * 128 + ((((co >> 3) ^ ((io >> 1) & 7))) << 4) + (co & 7) * 2;
                *(LAS bf16_t*)(Tl + off) = (bf16_t)f2bf(t[i] * sW); *(LAS bf16_t*)(Tl + 8192 + off) = (bf16_t)f2bf(t[i] * bco); }
            LDS_WAIT();
            asm volatile("" ::: "memory");
            bf16_t* Wg = (bf16_t*)(F.ws + WS_W) + dt * 8192; bf16_t* UTg = (bf16_t*)(F.ws + WS_UT) + dt * 8192;
            bf16x8 tf[4][2];
#pragma unroll
            for (int nt = 0; nt < 4; ++nt)
#pragma unroll
                for (int ks = 0; ks < 2; ++ks) { const int row = 16 * nt + fr, c = 4 * ks + fq; tf[nt][ks] = *(const LAS bf16x8*)(Tl + row * 128 + ((c ^ ((row >> 1) & 7)) << 4)); }
#pragma unroll
            for (int G = 0; G < (V == 2 ? 0 : 2); ++G)
#pragma unroll
                for (int nt = 0; nt < 4; ++nt) { u32x4 w0, w1;
#pragma unroll
                    for (int tau = 0; tau < 4; ++tau) { f32x4 acc = {0.f, 0.f, 0.f, 0.f};
                        acc = __builtin_amdgcn_mfma_f32_16x16x32_bf16(ktf[4 * G + tau][0], tf[nt][0], acc, 0, 0, 0); acc = __builtin_amdgcn_mfma_f32_16x16x32_bf16(ktf[4 * G + tau][1], tf[nt][1], acc, 0, 0, 0);
                        const unsigned lo = pk2(acc[0], acc[1]), hi = pk2(acc[2], acc[3]);
                        if (tau == 0) { w0.x = lo; w0.y = hi; } else if (tau == 1) { w0.z = lo; w0.w = hi; } else if (tau == 2) { w1.x = lo; w1.y = hi; } else { w1.z = lo; w1.w = hi; } }
                    u32x4* wp = (u32x4*)(Wg + (16 * nt + fr) * 128 + 64 * G + 16 * fq);
                    if (V == 4) asm volatile("" :: "v"(w0), "v"(w1)); else { wp[0] = w0; wp[1] = w1; } }
#pragma unroll
            for (int tau = 0; tau < 4; ++tau)
#pragma unroll
                for (int ks = 0; ks < 2; ++ks) { const int row = 16 * (fr >> 2) + 4 * tau + (fr & 3), c = 4 * ks + fq; tf[tau][ks] = *(const LAS bf16x8*)(Tl + 8192 + row * 128 + ((c ^ ((row >> 1) & 7)) << 4)); }
#pragma unroll
            for (int ntd = 0; ntd < (V == 2 ? 0 : 8); ++ntd) {
                const bf16x8 b0 = vtf[ntd][0], b1 = vtf[ntd][1];
                u32x4 w0, w1;
#pragma unroll
                for (int tau = 0; tau < 4; ++tau) { f32x4 acc = {0.f, 0.f, 0.f, 0.f};
                    acc = __builtin_amdgcn_mfma_f32_16x16x32_bf16(tf[tau][0], b0, acc, 0, 0, 0); acc = __builtin_amdgcn_mfma_f32_16x16x32_bf16(tf[tau][1], b1, acc, 0, 0, 0);
                    const unsigned lo = pk2(acc[0], acc[1]), hi = pk2(acc[2], acc[3]);
                    if (tau == 0) { w0.x = lo; w0.y = hi; } else if (tau == 1) { w0.z = lo; w0.w = hi; } else if (tau == 2) { w1.x = lo; w1.y = hi; } else { w1.z = lo; w1.w = hi; } }
                u32x4* up = (u32x4*)(UTg + (16 * ntd + fr) * 64 + 16 * fq);
                if (V == 4) asm volatile("" :: "v"(w0), "v"(w1)); else { up[0] = w0; up[1] = w1; }
            }
        }
        LDS_WAIT();
    }
#ifndef NO_FILL
    if (F.G == 256 && F.vcu * NWAVE + F.wave >= NCHUNK * NH * 2 - 2 * 2048) moe_convert_wave(F, FILL_PREP, F.lds + F.wave * 17408);
#endif
}

constexpr int SC_W = 0, SC_Q = 16384, SC_KT = 32768, SC_AT = 49152, SC_UT = 57344, SC_GC = 65536, SC_SLOT = 65792;
constexpr int SC_ST = 2 * SC_SLOT, ST_ROW = 272, SC_VN = SC_ST + 64 * ST_ROW, RT_ROW = 144, SC_END = SC_VN + 64 * RT_ROW;
static_assert(SC_END <= LDS_BYTES - 128, "scan LDS map");
#define SC_WAIT_V(n) asm volatile("s_waitcnt vmcnt(" #n ")" ::: "memory")
#define SC_BAR() do { asm volatile("s_waitcnt lgkmcnt(0)" ::: "memory"); __builtin_amdgcn_s_barrier(); asm volatile("" ::: "memory"); } while (0)
struct ScanCtx { int b, h, dir, half, mt, np, fr, fq, w, lane; unsigned offW[2], offQ[2], offK[2], offA; };
__device__ __forceinline__ int sc_chunk(const ScanCtx& c, int n) { return n < 4 ? 256 + c.b * 4 + (c.dir ? 3 - n : n) : c.b * 64 + (c.dir ? 67 - n : n - 4); }
__device__ __forceinline__ void sc_dma(Frame& F, const ScanCtx& c, int n, int slotoff) {
    const int ci = sc_chunk(c, n); int row0, t0, sl; chunk_rows(ci, row0, t0, sl);
    const size_t dt = ((size_t)(c.dir * NCHUNK + ci) * NH + c.h);
    const char* gW = (const char*)(F.ws + WS_W) + dt * 16384; const char* gQ = (const char*)(F.ws + WS_QKV) + ((size_t)row0 * NQKV + c.h * 128) * 2;
    const char* gK = (const char*)(F.ws + WS_KT) + ((size_t)ci * NH + c.h) * 16384; const char* gA = (const char*)(F.ws + WS_ATT) + dt * 8192;
    const char* gU = (const char*)(F.ws + WS_UT) + dt * 16384 + c.half * 8192; const char* gG = (const char*)(F.ws + WS_GCB) + dt * 512;
    LAS unsigned char* lds = F.lds + slotoff;
#pragma unroll
    for (int i = 0; i < 2; ++i) {
        __builtin_amdgcn_global_load_lds((const unsigned*)(gW + c.offW[i]), (LAS unsigned*)(lds + SC_W + (2 * c.w + i) * 1024), 16, 0, 0);
        __builtin_amdgcn_global_load_lds((const unsigned*)(gQ + c.offQ[i]), (LAS unsigned*)(lds + SC_Q + (2 * c.w + i) * 1024), 16, 0, 0);
        __builtin_amdgcn_global_load_lds((const unsigned*)(gK + c.offK[i]), (LAS unsigned*)(lds + SC_KT + (2 * c.w + i) * 1024), 16, 0, 0); }
    __builtin_amdgcn_global_load_lds((const unsigned*)(gA + c.offA), (LAS unsigned*)(lds + SC_AT + c.w * 1024), 16, 0, 0);
    __builtin_amdgcn_global_load_lds((const unsigned*)(gU + c.offA), (LAS unsigned*)(lds + SC_UT + c.w * 1024), 16, 0, 0);
    __builtin_amdgcn_global_load_lds((const unsigned*)(gG + c.lane * 4), (LAS unsigned*)(lds + SC_GC), 4, 0, 0);
}
__device__ __forceinline__ void sc_store_o(Frame& F, const ScanCtx& c, int n, const f32x4 (&o)[2]) {
    const int lc = c.dir ? 67 - n : n - 4;
    bf16_t* Obase = (bf16_t*)(F.ws + WS_O);
#pragma unroll
    for (int u = 0; u < 2; ++u) { u32x2 w; w.x = pk2(o[u][0], o[u][1]); w.y = pk2(o[u][2], o[u][3]);
        *(u32x2*)(Obase + ((size_t)c.dir * ML + (size_t)c.b * T + lc * 64 + 16 * c.mt + c.fr) * D + c.h * 128 + c.half * 64 + 16 * (2 * c.np + u) + 4 * c.fq) = w; }
}
__device__ __forceinline__ void moe_convert_queue(Frame& F) {
    unsigned* ctr = (unsigned*)(F.ws + WS_CTL) + 16384;
    LAS unsigned* slot = (LAS unsigned*)(F.lds + 65536);
    LAS unsigned char* scr = F.lds + F.wave * 8192;
    for (;;) {
        __syncthreads();
        if (F.tid == 0) slot[0] = __hip_atomic_fetch_add(ctr, 8u, __ATOMIC_RELAXED, __HIP_MEMORY_SCOPE_AGENT);
        __syncthreads();
        const unsigned t = slot[0] + (unsigned)F.wave;
        if (slot[0] >= 2u * TR_MOE) break;
        if (t < 2u * TR_MOE) tr_moe_job(F, t >= (unsigned)TR_MOE, (int)(t >= (unsigned)TR_MOE ? t - TR_MOE : t), scr, F.lane);
    }
    __syncthreads();
}
__device__ __forceinline__ void phase_scan(Frame& F) {
    const int xcd = F.vcu >> 5, jcu = F.vcu & 31;
    if (F.G != 256 || jcu >= 16) {
        moe_convert_queue(F);
        if (F.G == 256) return;
    }
    ScanCtx c;
    c.lane = F.lane; c.fr = c.lane & 15; c.fq = c.lane >> 4; c.w = F.wave; c.mt = c.w >> 1; c.np = c.w & 1;
#pragma unroll
    for (int i = 0; i < 2; ++i) {
        { const int I = 2 * c.w + i, row = 4 * I + (c.lane >> 4), cc = (c.lane & 15) ^ (row & 15); c.offW[i] = (unsigned)(row * 256 + cc * 16); c.offQ[i] = (unsigned)(row * (NQKV * 2) + cc * 16); }
        { const int I = 2 * c.w + i, row = 8 * I + (c.lane >> 3), cc = (c.lane & 7) ^ ((row >> 1) & 7); c.offK[i] = (unsigned)(row * 128 + cc * 16); }
    }
    { const int row = 8 * c.w + (c.lane >> 3), cc = (c.lane & 7) ^ ((row >> 1) & 7); c.offA = (unsigned)(row * 128 + cc * 16); }
    const int lane = c.lane, fr = c.fr, fq = c.fq, mt = c.mt, np = c.np;
    LAS unsigned char* const lds = F.lds;
    const int item0 = (F.G == 256) ? xcd * 16 + jcu : F.vcu, nitem = (F.G == 256) ? 128 : F.G;
    for (int item = item0; item < 128; item += nitem) {
        c.half = item & 1; c.dir = (item >> 1) & 1; c.h = (item >> 2) & 7; c.b = item >> 5;
        for (int i = F.tid; i < 64 * ST_ROW / 4; i += NTHR) ((LAS unsigned*)(lds + SC_ST))[i] = 0u;
        f32x4 Sacc[2][2];
#pragma unroll
        for (int ud = 0; ud < 2; ++ud)
#pragma unroll
            for (int uv = 0; uv < 2; ++uv) Sacc[ud][uv] = (f32x4){0.f, 0.f, 0.f, 0.f};
        f32x4 Oprev[2] = {{0.f, 0.f, 0.f, 0.f}, {0.f, 0.f, 0.f, 0.f}};
        sc_dma(F, c, 0, 0);
        SC_WAIT_V(0);
        SC_BAR();
        sc_dma(F, c, 1, SC_SLOT);
#pragma unroll 1
        for (int n = 0; n < 68; ++n) {
            const bool latent = n >= 4;
            const int so = (n & 1) * SC_SLOT;
            LAS unsigned char* const slot = lds + so;
            LAS unsigned char* const St = lds + SC_ST;
            f32x4 xacc[2], oacc[2];
#pragma unroll
            for (int u = 0; u < 2; ++u) { xacc[u] = (f32x4){0.f, 0.f, 0.f, 0.f}; oacc[u] = (f32x4){0.f, 0.f, 0.f, 0.f}; }
            const int arow = 16 * mt + fr;
#pragma unroll
            for (int ks = 0; ks < 4; ++ks) {
                const int co = (((4 * ks + fq) ^ fr) << 4);
                const bf16x8 aW = *(const LAS bf16x8*)(slot + SC_W + arow * 256 + co), aQ = *(const LAS bf16x8*)(slot + SC_Q + arow * 256 + co);
#pragma unroll
                for (int u = 0; u < 2; ++u) { const bf16x8 bS = *(const LAS bf16x8*)(St + (16 * (2 * np + u) + fr) * ST_ROW + (32 * ks + 8 * fq) * 2);
                    xacc[u] = __builtin_amdgcn_mfma_f32_16x16x32_bf16(aW, bS, xacc[u], 0, 0, 0);
                    oacc[u] = __builtin_amdgcn_mfma_f32_16x16x32_bf16(bS, aQ, oacc[u], 0, 0, 0); } }
            const float egl = __expf(*(const LAS float*)(slot + SC_GC + (16 * mt + fr) * 4));
            const float gtot = *(const LAS float*)(slot + SC_GC + (c.dir ? 0 : 63) * 4);
#pragma unroll
            for (int u = 0; u < 2; ++u) { const int urow = 16 * (2 * np + u) + fr, uc = 2 * mt + (fq >> 1);
              const u32x2 uw = *(const LAS u32x2*)(slot + SC_UT + urow * 128 + ((uc ^ ((urow >> 1) & 7)) << 4) + 8 * (fq & 1));
              u32x2 pw; pw.x = pk2(bflo(uw.x) - xacc[u][0], bfhi(uw.x) - xacc[u][1]); pw.y = pk2(bflo(uw.y) - xacc[u][2], bfhi(uw.y) - xacc[u][3]);
              *(LAS u32x2*)(lds + SC_VN + urow * RT_ROW + (16 * mt + 4 * fq) * 2) = pw; }
            bf16x8 aK[2][2], aA[2];
#pragma unroll
            for (int ks = 0; ks < 2; ++ks) {
                aA[ks] = *(const LAS bf16x8*)(slot + SC_AT + arow * 128 + ((((4 * ks + fq) ^ ((arow >> 1) & 7))) << 4));
                const f32x4 g0 = *(const LAS f32x4*)(slot + SC_GC + (32 * ks + 8 * fq) * 4), g1 = *(const LAS f32x4*)(slot + SC_GC + (32 * ks + 8 * fq + 4) * 4);
                float e[8];
#pragma unroll
                for (int j = 0; j < 4; ++j) { e[j] = __expf(gtot - g0[j]); e[4 + j] = __expf(gtot - g1[j]); }
#pragma unroll
                for (int ud = 0; ud < 2; ++ud) { const int krow = 16 * (2 * mt + ud) + fr;
                    const u32x4 kw = *(const LAS u32x4*)(slot + SC_KT + krow * 128 + ((((4 * ks + fq) ^ ((krow >> 1) & 7))) << 4));
                    u32x4 o; o.x = pk2(bflo(kw.x) * e[0], bfhi(kw.x) * e[1]); o.y = pk2(bflo(kw.y) * e[2], bfhi(kw.y) * e[3]); o.z = pk2(bflo(kw.z) * e[4], bfhi(kw.z) * e[5]); o.w = pk2(bflo(kw.w) * e[6], bfhi(kw.w) * e[7]);
                    aK[ud][ks] = __builtin_bit_cast(bf16x8, o); } }
            SC_BAR();
            if (n - 1 >= 4) sc_store_o(F, c, n - 1, Oprev);
            if (n + 2 < 68) sc_dma(F, c, n + 2, so);
            bf16x8 bV[2][2];
#pragma unroll
            for (int u = 0; u < 2; ++u)
#pragma unroll
                for (int ks = 0; ks < 2; ++ks) bV[u][ks] = *(const LAS bf16x8*)(lds + SC_VN + (16 * (2 * np + u) + fr) * RT_ROW + (32 * ks + 8 * fq) * 2);
            if (latent) {
#pragma unroll
                for (int u = 0; u < 2; ++u) {
                    oacc[u] *= egl;
#pragma unroll
                    for (int ks = 0; ks < 2; ++ks) oacc[u] = __builtin_amdgcn_mfma_f32_16x16x32_bf16(bV[u][ks], aA[ks], oacc[u], 0, 0, 0);
                    Oprev[u] = oacc[u];
                }
            }
            const float egt = __expf(gtot);
#pragma unroll
            for (int ud = 0; ud < 2; ++ud)
#pragma unroll
                for (int uv = 0; uv < 2; ++uv) {
                    Sacc[ud][uv] *= egt;
#pragma unroll
                    for (int ks = 0; ks < 2; ++ks) Sacc[ud][uv] = __builtin_amdgcn_mfma_f32_16x16x32_bf16(aK[ud][ks], bV[uv][ks], Sacc[ud][uv], 0, 0, 0);
                    u32x2 pw; pw.x = pk2(Sacc[ud][uv][0], Sacc[ud][uv][1]); pw.y = pk2(Sacc[ud][uv][2], Sacc[ud][uv][3]);
                    *(LAS u32x2*)(St + (16 * (2 * np + uv) + fr) * ST_ROW + (16 * (2 * mt + ud) + 4 * fq) * 2) = pw;
                }
            if (n + 2 < 68) SC_WAIT_V(9); else SC_WAIT_V(0);
            SC_BAR();
        }
        sc_store_o(F, c, 67, Oprev);
        SC_WAIT_V(0);
        SC_BAR();
    }
    if (F.G == 256) moe_convert_queue(F);
}

__device__ __forceinline__ void phase_gdn_out(Frame& F) {
    const bf16_t* O0 = (const bf16_t*)(F.ws + WS_O); const bf16_t* O1 = O0 + (size_t)ML * D;
    const bf16_t* P = (const bf16_t*)(F.ws + WS_P);
    bf16_t* ON = (bf16_t*)(F.ws + WS_ON);
    const int lane = F.lane;
    const f32x4 gain = *(const f32x4*)(F.in[I_OGAIN] + ((4 * lane) & 127));
    f32x4 an[4], bn[4];
    { const int r0 = F.vcu * NWAVE + F.wave; if (r0 < ML) { load_row_bf16(O0 + (size_t)r0 * D, lane, an); load_row_bf16(O1 + (size_t)r0 * D, lane, bn); } }
    for (int row = F.vcu * NWAVE + F.wave; row < ML; row += F.G * NWAVE) {
        f32x4 a[4], b[4];
#pragma unroll
        for (int j = 0; j < 4; ++j) { a[j] = an[j]; b[j] = bn[j]; }
        { const int nr = row + F.G * NWAVE; if (nr < ML) { load_row_bf16(O0 + (size_t)nr * D, lane, an); load_row_bf16(O1 + (size_t)nr * D, lane, bn); } }
        f32x4 y[4];
#pragma unroll
        for (int j = 0; j < 4; ++j) { const f32x4 o = a[j] + b[j];
            float ss = (o[0] * o[0] + o[1] * o[1]) + (o[2] * o[2] + o[3] * o[3]);
            ss = row16_sum(ss); ss += __shfl_xor(ss, 16);
            const float rs = rsqrtf(ss * (1.f / DH) + EPS);
            const u32x2 zw = ((const u32x2*)(P + (size_t)row * NP + NQKV))[lane + 64 * j];
            const float z0 = bflo(zw.x), z1 = bfhi(zw.x), z2 = bflo(zw.y), z3 = bfhi(zw.y);
            y[j][0] = o[0] * rs * gain[0] * siluf(z0); y[j][1] = o[1] * rs * gain[1] * siluf(z1); y[j][2] = o[2] * rs * gain[2] * siluf(z2); y[j][3] = o[3] * rs * gain[3] * siluf(z3); }
        store_row_bf16(ON + (size_t)row * D, lane, y);
    }
}

#define DPP_MAX(v, ctrl) fmaxf((v), __builtin_bit_cast(float, __builtin_amdgcn_update_dpp(0, __builtin_bit_cast(int, (v)), (ctrl), 0xf, 0xf, true)))
__device__ __forceinline__ float row16_max(float v) { v = DPP_MAX(v, 0xB1); v = DPP_MAX(v, 0x4E); v = DPP_MAX(v, 0x141); v = DPP_MAX(v, 0x140); return v; }
__device__ __forceinline__ float router_softmax(float (&lg)[16], int lane) {
    float mine = 0.f;
#pragma unroll
    for (int e = 0; e < 16; ++e) { const float s = row16_sum(lg[e]); mine = ((lane & 15) == e) ? s : mine; }
    mine += __shfl_xor(mine, 16); mine += __shfl_xor(mine, 32);
    const float mx = row16_max(mine), ex = __expf(mine - mx), den = row16_sum(ex);
    return ex * __builtin_amdgcn_rcpf(den);
}
__device__ __forceinline__ void phase_moe_pre(Frame& F, int l) {
    const float* MOD = (const float*)(F.ws + WS_MOD) + (size_t)l * 5 * 6144;
    const bf16_t* H = (const bf16_t*)(F.ws + WS_H);
    bf16_t* U = (bf16_t*)(F.ws + WS_U);
    float* AFF = (float*)(F.ws + WS_AFF);
    LAS float* wr = (LAS float*)F.lds;
    const float* wsrc = F.in[I_WR] + (size_t)l * D * NE;
    for (int i = F.tid; i < D * NE / 4; i += NTHR) { const int c = i >> 2, q = i & 3; *(LAS f32x4*)(wr + c * 16 + 4 * q + (c >> 2) * 4) = ((const f32x4*)wsrc)[i]; }
    __syncthreads();
    const int lane = F.lane, stride = F.G * NWAVE;
    for (int row = F.vcu * NWAVE + F.wave; row < ML; row += 2 * stride) {
        const int row1 = row + stride; const bool has1 = row1 < ML;
        f32x4 v0[4], v1[4], y0[4], y1[4];
        load_row_bf16(H + (size_t)row * D, lane, v0); load_row_bf16(H + (size_t)(has1 ? row1 : row) * D, lane, v1);
        const float rs0 = row_rstd(v0), rs1 = row_rstd(v1);
        norm_mod(v0, rs0, F.in[I_GFFN] + l * D, MOD + (size_t)(row / T) * 6144 + 3 * D, MOD + (size_t)(row / T) * 6144 + 4 * D, lane, y0);
        { const int r1 = has1 ? row1 : row; norm_mod(v1, rs1, F.in[I_GFFN] + l * D, MOD + (size_t)(r1 / T) * 6144 + 3 * D, MOD + (size_t)(r1 / T) * 6144 + 4 * D, lane, y1); }
#pragma unroll
        for (int j = 0; j < 4; ++j) { ((unsigned*)((unsigned char*)U + (size_t)row * D))[lane + 64 * j] = pk4_fp8(y0[j][0], y0[j][1], y0[j][2], y0[j][3]);
            if (has1) ((unsigned*)((unsigned char*)U + (size_t)row1 * D))[lane + 64 * j] = pk4_fp8(y1[j][0], y1[j][1], y1[j][2], y1[j][3]); }
        float lg0[16], lg1[16];
#pragma unroll
        for (int e = 0; e < 16; ++e) { lg0[e] = 0.f; lg1[e] = 0.f; }
#pragma unroll
        for (int j = 0; j < 4; ++j) {
            asm volatile("" ::: "memory");
#pragma unroll
            for (int i = 0; i < 4; ++i) { const int c = 4 * lane + 256 * j + i; const float a = y0[j][i], bq = y1[j][i];
#pragma unroll
                for (int q = 0; q < 4; ++q) { const f32x4 wv = *(const LAS f32x4*)(wr + c * 16 + 4 * q + (c >> 2) * 4);
                    lg0[4 * q] += a * wv[0]; lg0[4 * q + 1] += a * wv[1]; lg0[4 * q + 2] += a * wv[2]; lg0[4 * q + 3] += a * wv[3];
                    lg1[4 * q] += bq * wv[0]; lg1[4 * q + 1] += bq * wv[1]; lg1[4 * q + 2] += bq * wv[2]; lg1[4 * q + 3] += bq * wv[3]; } } }
        const float a0 = router_softmax(lg0, lane), a1 = router_softmax(lg1, lane);
        if (lane < 16) { AFF[((size_t)(row / T) * NE + lane) * T + row % T] = a0; if (has1) AFF[((size_t)(row1 / T) * NE + lane) * T + row1 % T] = a1; }
    }
    __syncthreads();
}

__device__ __forceinline__ void phase_topk(Frame& F) {
    LAS unsigned* cnt = (LAS unsigned*)F.lds;
    const float* AFF = (const float*)(F.ws + WS_AFF);
    int* SLOT = (int*)(F.ws + WS_SLOT); int* IDX = (int*)(F.ws + WS_IDX); float* GATE = (float*)(F.ws + WS_GATE);
    for (int item = F.vcu; item < NB * NE; item += F.G) {
        const int b = item / NE, e = item % NE;
        unsigned key[8];
        { const u32x4* p = (const u32x4*)(AFF + (size_t)item * T + F.tid * 8); const u32x4 k0 = p[0], k1 = p[1];
          key[0] = k0.x; key[1] = k0.y; key[2] = k0.z; key[3] = k0.w; key[4] = k1.x; key[5] = k1.y; key[6] = k1.z; key[7] = k1.w; }
        unsigned thr = 0u;
        int par = 0;
        for (int bit = 30; bit >= 0; --bit) {
            const unsigned cand = thr | (1u << bit);
            int c = 0;
#pragma unroll
            for (int i = 0; i < 8; ++i) c += (key[i] >= cand) ? 1 : 0;
#pragma unroll
            for (int o = 1; o < 64; o <<= 1) c += __shfl_xor(c, o);
            if (F.lane == 0) cnt[par * 8 + F.wave] = (unsigned)c;
            __syncthreads();
            unsigned tot = 0;
#pragma unroll
            for (int w8 = 0; w8 < 8; ++w8) tot += cnt[par * 8 + w8];
            if (tot >= (unsigned)CAP) thr = cand;
            par ^= 1;
        }
        __syncthreads();
        int cg_ = 0, ce_ = 0;
#pragma unroll
        for (int i = 0; i < 8; ++i) { cg_ += key[i] > thr; ce_ += key[i] == thr; }
        unsigned pk = (unsigned)cg_ | ((unsigned)ce_ << 16), inc = pk;
#pragma unroll
        for (int o = 1; o < 64; o <<= 1) { const unsigned t = __shfl_up(inc, o); if (F.lane >= o) inc += t; }
        LAS unsigned* wtot = cnt + 64;
        if (F.lane == 63) wtot[F.wave] = inc;
        __syncthreads();
        unsigned base = 0, total = 0;
#pragma unroll
        for (int w8 = 0; w8 < 8; ++w8) { const unsigned v = wtot[w8]; if (w8 < F.wave) base += v; total += v; }
        const unsigned excl = base + inc - pk;
        int gt_before = excl & 0xffffu, eq_before = excl >> 16;
        const int need_eq = CAP - (int)(total & 0xffffu);
#pragma unroll
        for (int i = 0; i < 8; ++i) {
            const int t = F.tid * 8 + i;
            const bool isg = key[i] > thr, ise = key[i] == thr;
            const bool sel = isg || (ise && eq_before < need_eq);
            const int slot = gt_before + (eq_before < need_eq ? eq_before : need_eq);
            SLOT[(size_t)item * T + t] = sel ? slot : -1;
            if (sel) { IDX[item * CAP + slot] = t; GATE[(size_t)e * 2048 + b * CAP + slot] = __uint_as_float(key[i]); }
            gt_before += isg; eq_before += ise;
        }
        __syncthreads();
    }
}

__device__ __forceinline__ void phase_gather(Frame& F) {
    const unsigned char* U = (const unsigned char*)(F.ws + WS_U); unsigned char* XS = (unsigned char*)(F.ws + WS_XS); const int* IDX = (const int*)(F.ws + WS_IDX);
    for (int r = F.vcu * NWAVE + F.wave; r < MX; r += F.G * NWAVE) {
        const int e = r / 2048, b = (r % 2048) / CAP, s = r % CAP;
        const int t = IDX[(b * NE + e) * CAP + s];
        ((u32x4*)(XS + (size_t)r * D))[F.lane] = ((const u32x4*)(U + ((size_t)b * T + t) * D))[F.lane];
    }
}

__device__ __forceinline__ void phase_combine(Frame& F, int l) {
    const float* MOD = (const float*)(F.ws + WS_MOD);
    bf16_t* H = (bf16_t*)(F.ws + WS_H); const bf16_t* YS = (const bf16_t*)(F.ws + WS_YS); const int* SLOT = (const int*)(F.ws + WS_SLOT);
    bf16_t* U = (bf16_t*)(F.ws + WS_U);
    const int lane = F.lane, stride = F.G * NWAVE;
    int row = F.vcu * NWAVE + F.wave;
    f32x4 vn[4]; int slotn = -1;
    if (row < ML) { load_row_bf16(H + (size_t)row * D, lane, vn); slotn = lane < NE ? SLOT[((size_t)(row / T) * NE + lane) * T + row % T] : -1; }
    for (; row < ML; row += stride) {
        const int b = row / T;
        f32x4 v[4]; const int myslot = slotn;
#pragma unroll
        for (int j = 0; j < 4; ++j) v[j] = vn[j];
        { const int nr = row + stride; if (nr < ML) { load_row_bf16(H + (size_t)nr * D, lane, vn); slotn = lane < NE ? SLOT[((size_t)(nr / T) * NE + lane) * T + nr % T] : -1; } }
        f32x4 acc[4];
#pragma unroll
        for (int j = 0; j < 4; ++j) acc[j] = (f32x4){0.f, 0.f, 0.f, 0.f};
        unsigned long long mask = __ballot(myslot >= 0);
        while (mask) {
            u32x2 yv[4][4]; bool have[4];
#pragma unroll
            for (int k = 0; k < 4; ++k) { have[k] = mask != 0ull;
                if (have[k]) { const int e = __builtin_ctzll(mask); mask &= mask - 1ull; const int sl = __builtin_amdgcn_readlane(myslot, e);
                    const u32x2* yp = (const u32x2*)(YS + ((size_t)e * 2048 + b * CAP + sl) * D);
#pragma unroll
                    for (int j = 0; j < 4; ++j) yv[k][j] = yp[lane + 64 * j]; } }
#pragma unroll
            for (int k = 0; k < 4; ++k) if (have[k]) {
#pragma unroll
                for (int j = 0; j < 4; ++j) { const u32x2 w = yv[k][j]; acc[j][0] += bflo(w.x); acc[j][1] += bfhi(w.x); acc[j][2] += bflo(w.y); acc[j][3] += bfhi(w.y); } }
        }
        const float* gtf = MOD + ((size_t)l * 5 + b) * 6144 + 5 * D;
#pragma unroll
        for (int j = 0; j < 4; ++j) v[j] += ((const f32x4*)gtf)[lane + 64 * j] * acc[j];
        const float rstd = row_rstd(v);
        if (l == 0) {
#pragma unroll
            for (int j = 0; j < 4; ++j) { u32x2 w; w.x = pk2(v[j][0], v[j][1]); w.y = pk2(v[j][2], v[j][3]); ((u32x2*)(H + (size_t)row * D))[lane + 64 * j] = w; }
            const float* m = MOD + ((size_t)5 + b) * 6144; f32x4 y[4];
            norm_mod(v, rstd, F.in[I_GMIX] + D, m, m + D, lane, y);
            store_row_bf16(U + (size_t)row * D, lane, y);
        } else {
#pragma unroll
            for (int j = 0; j < 4; ++j) __builtin_nontemporal_store(v[j] * rstd * ((const f32x4*)F.in[I_FING])[lane + 64 * j], (f32x4*)(F.out + (size_t)row * D) + lane + 64 * j);
        }
    }
}

template <int GI>
__device__ __forceinline__ void pool_item(Frame& F, int b, int r, LAS float* Vs, int cp, int cgp) {
    constexpr int W = 2 << GI, LO = W >> 1, HI = W - LO;
    const bf16_t* U = (const bf16_t*)(F.ws + WS_U); bf16_t* PD = (bf16_t*)(F.ws + WS_ON);
    const int r_lo = r - LO < 0 ? 0 : r - LO, r_hi = r + HI > 64 ? 64 : r + HI;
    float s0[16], s1[16]; unsigned self[16];
#pragma unroll
    for (int i = 0; i < 16; ++i) { s0[i] = 0.f; s1[i] = 0.f; }
    const bf16_t* base = U + ((size_t)b * T + cgp * 16) * D + GI * 256 + 2 * cp;
    int rr = r_lo;
    for (; rr + 4 <= r_hi; rr += 4) {
        unsigned x[4][16];
#pragma unroll
        for (int q = 0; q < 4; ++q)
#pragma unroll
            for (int i = 0; i < 16; ++i) x[q][i] = *(const unsigned*)(base + ((size_t)(rr + q) * 64 + i) * D);
#pragma unroll
        for (int q = 0; q < 4; ++q)
#pragma unroll
            for (int i = 0; i < 16; ++i) { s0[i] += bflo(x[q][i]); s1[i] += bfhi(x[q][i]); }
    }
    for (; rr < r_hi; ++rr) {
#pragma unroll
        for (int i = 0; i < 16; ++i) { const unsigned x = *(const unsigned*)(base + ((size_t)rr * 64 + i) * D); s0[i] += bflo(x); s1[i] += bfhi(x); }
    }
#pragma unroll
    for (int i = 0; i < 16; ++i) { self[i] = *(const unsigned*)(base + ((size_t)r * 64 + i) * D); *(LAS f32x2*)(Vs + (8 + cgp * 16 + i) * 256 + 2 * cp) = (f32x2){s0[i], s1[i]}; }
    __syncthreads();
    const float inv_r = 1.f / (float)(r_hi - r_lo);
    const int c0 = cgp * 16;
    f32x2 first[W], add[15], sub[15];
#pragma unroll
    for (int k = 0; k < W; ++k) first[k] = *(const LAS f32x2*)(Vs + (8 + c0 - LO + k) * 256 + 2 * cp);
#pragma unroll
    for (int i = 1; i < 16; ++i) { add[i - 1] = *(const LAS f32x2*)(Vs + (8 + c0 + i + HI - 1) * 256 + 2 * cp); sub[i - 1] = *(const LAS f32x2*)(Vs + (8 + c0 + i - LO - 1) * 256 + 2 * cp); }
    f32x2 run = {0.f, 0.f};
#pragma unroll
    for (int k = 0; k < W; ++k) run += first[k];
#pragma unroll
    for (int i = 0; i < 16; ++i) { const int c = c0 + i;
        if (i > 0) run += add[i - 1] - sub[i - 1];
        const int c_lo = c - LO < 0 ? 0 : c - LO, c_hi = c + HI > 64 ? 64 : c + HI;
        const float sc = inv_r / (float)(c_hi - c_lo);
        *(unsigned*)(PD + ((size_t)b * T + r * 64 + c) * D + GI * 256 + 2 * cp) = pk2(run[0] * sc - bflo(self[i]), run[1] * sc - bfhi(self[i])); }
    __syncthreads();
}
__device__ __forceinline__ void phase_pool(Frame& F) {
    LAS float* Vs = (LAS float*)F.lds;
    const int cp = F.tid & 127, cgp = F.tid >> 7;
    for (int i = F.tid; i < 8 * 256; i += NTHR) { Vs[i] = 0.f; Vs[72 * 256 + i] = 0.f; }
    __syncthreads();
    for (int item = F.vcu; item < 1024; item += F.G) {
        const int gi = item >> 8, b = (item >> 6) & 3, r = item & 63;
        if (gi == 0) pool_item<0>(F, b, r, Vs, cp, cgp); else if (gi == 1) pool_item<1>(F, b, r, Vs, cp, cgp); else if (gi == 2) pool_item<2>(F, b, r, Vs, cp, cgp); else pool_item<3>(F, b, r, Vs, cp, cgp);
    }
}

constexpr int NPHASE = 22;
__global__ void __launch_bounds__(NTHR, 2) mega_fwd(Args args) {
    extern __shared__ __attribute__((aligned(16))) unsigned char lds_raw[];
    Frame F;
    F.lds = (LAS unsigned char*)lds_raw;
    F.tid = threadIdx.x; F.lane = F.tid & 63; F.wave = __builtin_amdgcn_readfirstlane(F.tid >> 6);
    F.G = gridDim.x; { const int bx = blockIdx.x; F.vcu = (F.G % 8 == 0) ? (bx % 8) * (F.G / 8) + bx / 8 : bx; }
#pragma unroll
    for (int i = 0; i < 21; ++i) F.in[i] = args.in[i];
    F.out = args.out; F.ws = args.ws;
    const int lo = args.ph_lo, hi = args.ph_hi;
    if (F.tid < 32) ((LAS unsigned*)(F.lds + MISC_OFF))[F.tid] = 0u;
    __syncthreads();
    XcdBarrier bar = xcd_barrier_post((unsigned*)(F.ws + WS_CTL) + 4096, (volatile LAS unsigned*)(F.lds + MISC_OFF));
#ifndef PHMASK
#define PHMASK 0x3fffff
#endif
#define IN(k) ((((PHMASK) >> (k)) & 1) && lo <= (k) && (k) < hi)
#define SEAM(k) do { if (IN(k) && IN((k) + 1)) { xcd_barrier(bar); } F.tid = threadIdx.x; asm volatile("" : "+v"(F.tid)); F.lane = F.tid & 63; F.wave = __builtin_amdgcn_readfirstlane(F.tid >> 6); } while (0)
    const int c = (int)blockIdx.x;

#ifndef REP_PHASE
#define REP_PHASE (-1)
#endif
#ifndef REP_N
#define REP_N 2
#endif
#define RUN(k, ...) for (int _r = 0; _r < ((k) == REP_PHASE ? 1 + REP_N : 1); ++_r) { if (IN(k)) { __VA_ARGS__ } SEAM(k); }
    RUN(0, {
        if (F.vcu < 192) mod_item(F, F.vcu);
        LAS unsigned char* scr = F.lds + F.wave * 8192;
        const int gw = F.vcu * NWAVE + F.wave, NGW = F.G * NWAVE;
        for (int t = gw; t < TR_SMALL; t += NGW) tr_small_job(F, t, scr);
    })
    RUN(1, phase_norm0(F);)
    RUN(2, {
        pg8::Gemm g{(const bf16_t*)(F.ws + WS_U), (const bf16_t*)(F.ws + WS_WIN), D, D};
        pg8::DenseOrder S; S.init(MA / 256, NPROJ_PAD / 256, F.G, c);
        pg8::EpiInProj E{(bf16_t*)(F.ws + WS_P), (float*)(F.ws + WS_AB)};
        pg8::gemm_phase(F.lds, g, S, E);
#ifndef NO_FILL
        if (F.G == 256 && c >= (MA / 256) * (NPROJ_PAD / 256) - 4 * 256) moe_convert_wave(F, FILL_INPROJ, F.lds + F.wave * 8192);
#endif
    })
    RUN(3, phase_conv(F);)
#ifndef PREPV
    RUN(4, phase_prep<0>(F);)
#else
    RUN(4, phase_prep<PREPV>(F); __syncthreads(); phase_prep<PREPV>(F); __syncthreads(); phase_prep<0>(F);)
#endif
    RUN(5, phase_scan(F);)
    RUN(6, phase_gdn_out(F);)
    RUN(7, {
        pg8::Gemm g{(const bf16_t*)(F.ws + WS_ON), (const bf16_t*)(F.ws + WS_WOUT), D, D};
        pg8::DenseOrder S; S.init(ML / 256, D / 256, F.G, c);
        pg8::EpiOutProj E{F.in[I_X], (bf16_t*)(F.ws + WS_H), (const float*)(F.ws + WS_MOD) + 2 * D};
        pg8::gemm_phase(F.lds, g, S, E);
    })
#pragma unroll
    for (int l = 0; l < 2; ++l) {
        if (l == 1) {
            RUN(14, phase_pool(F);)
            RUN(15, {
                pg8::Gemm g{(const bf16_t*)(F.ws + WS_ON), (const bf16_t*)(F.ws + WS_POOLW), D, 256};
                pg8::PoolOrder S{F.G, c};
                pg8::EpiPool E{(bf16_t*)(F.ws + WS_H), (const float*)(F.ws + WS_MOD) + 5 * 6144 + 2 * D, F.in[I_POOLS]};
                pg8::gemm_phase(F.lds, g, S, E);
            })
        }
        const int p0 = l == 0 ? 8 : 16;
        RUN(p0, {
            phase_moe_pre(F, l);

        })
        RUN(p0 + 1, phase_topk(F);)
        RUN(p0 + 3, {
            pg8::Gemm g{(const bf16_t*)(F.ws + WS_U), (const bf16_t*)(F.ws + WS_WMOE + (size_t)l * WMOE_LAYER), D, D, (const int*)(F.ws + WS_IDX)};
            pg8::MoeUpOrder S{F.G, c};
            pg8::EpiSwiglu E{(unsigned char*)(F.ws + WS_HID)};
            pg8::gemm_phase<pg8::EpiSwiglu, pg8::MoeUpOrder, true, true>(F.lds, g, S, E);
        })
        RUN(p0 + 4, {
            pg8::Gemm g{(const bf16_t*)(F.ws + WS_HID), (const bf16_t*)(F.ws + WS_W2T + (size_t)l * WMOE_LAYER), DF, DF};
            pg8::MoeDownOrder S{F.G, c};
            pg8::EpiDown E{(bf16_t*)(F.ws + WS_YS), (const float*)(F.ws + WS_GATE)};
            pg8::gemm_phase<pg8::EpiDown, pg8::MoeDownOrder, true, false>(F.lds, g, S, E);
        })
        RUN(p0 + 5, phase_combine(F, l);)
    }
#undef IN
#undef SEAM
#undef RUN
}

extern "C" void kernel_launch(void* const* d_in, const int* in_sizes, int n_in, void* d_out, int out_size, void* d_ws, size_t ws_size, hipStream_t stream) {
    static int grid = 0;
    if (grid == 0) {
        if (n_in != 21 || ws_size < WS_END) { fprintf(stderr, "kernel_launch: unexpected inputs (n_in %d, ws %zu)\n", n_in, ws_size); grid = -1; return; }
        int dev = 0, cus = 0, per_cu = 0;
        hipGetDevice(&dev);
        hipDeviceGetAttribute(&cus, hipDeviceAttributeMultiprocessorCount, dev);
        hipFuncSetAttribute((const void*)mega_fwd, hipFuncAttributeMaxDynamicSharedMemorySize, LDS_BYTES);
        hipOccupancyMaxActiveBlocksPerMultiprocessor(&per_cu, (const void*)mega_fwd, NTHR, LDS_BYTES);
        if (per_cu < 1) { fprintf(stderr, "kernel_launch: occupancy query says %d blocks per CU\n", per_cu); per_cu = 1; }
        grid = cus;
        (void)hipGetLastError();
    }
    if (grid < 0) return;
    hipMemsetAsync((char*)d_ws + WS_CTL, 0, 1 * MiB, stream);
    Args a{};
    for (int i = 0; i < 21; ++i) a.in[i] = (const float*)d_in[i];
    a.out = (float*)d_out; a.ws = (unsigned char*)d_ws;
#if MK_N_LAUNCHES == 1
    a.ph_lo = 0; a.ph_hi = NPHASE;
    void* params[] = {&a};
    (void)params;
    hipLaunchKernelGGL(mega_fwd, dim3(grid), dim3(NTHR), LDS_BYTES, stream, a);
    hipError_t e = hipPeekAtLastError();
    if (e != hipSuccess) fprintf(stderr, "launch failed: %s (grid %d)\n", hipGetErrorString(e), grid);
#else
    for (int p = 0; p < NPHASE; ++p) {
        a.ph_lo = p; a.ph_hi = p + 1;
        void* params[] = {&a};
        hipError_t e = hipLaunchCooperativeKernel((const void*)mega_fwd, dim3(grid), dim3(NTHR), params, LDS_BYTES, stream);
        if (e != hipSuccess) { fprintf(stderr, "launch %d failed: %s (grid %d)\n", p, hipGetErrorString(e), grid); break; }
    }
#endif
}
```
